# Optimizing an MI355X kernel written in HIP

```python
import jax, jax.numpy as jnp
from jax import lax
import numpy as np

D_MODEL = 1024
BATCH = 8
SEQ = 4096
DEPTH = 1
DEC_BATCH = 16
DEC_SEQ = 32
PAST_LEN = 1024

CHUNK = 64
Q_BLOCK = 128
N_ATTN_HEADS = 8
ATTN_HEAD_DIM = 64
D_ATTN = N_ATTN_HEADS * ATTN_HEAD_DIM
ATTN_SCALE = ATTN_HEAD_DIM ** -0.5
D_RNN = 512
N_RNN_BLOCKS = 8
RNN_BLOCK = D_RNN // N_RNN_BLOCKS
CONV_WIDTH = 4
LRU_C = 8.0
N_KEYS = 128
N_EXPERTS = N_KEYS * N_KEYS
PEER_HEADS = 8
PEER_TOPK = 16
PEER_KEY_DIM = 256
PEER_HALF = PEER_KEY_DIM // 2
PEER_TOKEN_BLOCK = 128
DN_ALPHA = (2 * DEPTH) ** 0.25
DN_BETA = (8 * DEPTH) ** -0.25
LN_EPS = 1e-5
IN_WIDTHS = (D_ATTN, D_ATTN, D_ATTN, N_ATTN_HEADS, D_RNN, D_RNN, D_MODEL, D_MODEL)
D_IN = sum(IN_WIDTHS)
IN_SPLITS = tuple(int(s) for s in np.cumsum(IN_WIDTHS)[:-1])

kernel_name = "fox_rglru_peer_streaming_step"


def layer_norm(x, g, b):
    xf = x.astype(jnp.float32)
    mu = jnp.mean(xf, axis=-1, keepdims=True)
    var = jnp.mean(jnp.square(xf - mu), axis=-1, keepdims=True)
    return ((xf - mu) * lax.rsqrt(var + LN_EPS) * g + b).astype(x.dtype)


def fox_block(q, k, v, f_q, f_k, q_pos, k_pos):
    s = jnp.einsum("bqhd,bkhd->bhqk", q, k).astype(jnp.float32) * ATTN_SCALE
    s = s + jnp.transpose(f_q, (0, 2, 1))[..., :, None] - jnp.transpose(f_k, (0, 2, 1))[..., None, :]
    mask = k_pos[None, :] <= q_pos[:, None]
    p = jax.nn.softmax(jnp.where(mask, s, -jnp.inf), axis=-1)
    return jnp.einsum("bhqk,bkhd->bqhd", p.astype(v.dtype), v)


def fox_attention(q, k, v, f_q, f_k, q_pos, k_pos):
    t_q = q.shape[1]
    if t_q <= Q_BLOCK:
        return fox_block(q, k, v, f_q, f_k, q_pos, k_pos)
    nb = t_q // Q_BLOCK
    b, _, h, d = q.shape
    qb = q.reshape(b, nb, Q_BLOCK, h, d).swapaxes(0, 1)
    fb = f_q.reshape(b, nb, Q_BLOCK, h).swapaxes(0, 1)
    pb = q_pos.reshape(nb, Q_BLOCK)
    out = lax.map(lambda a: fox_block(a[0], k, v, a[1], f_k, a[2], k_pos), (qb, fb, pb))
    return out.swapaxes(0, 1).reshape(b, t_q, h, d)


def _combine(c1, c2):
    a1, b1 = c1
    a2, b2 = c2
    return a1 * a2, a2 * b1 + b2


def linear_recurrence(a, b, h0):
    bsz, t, c = a.shape
    nc = -(-t // CHUNK)
    pad = nc * CHUNK - t
    a = jnp.pad(a, ((0, 0), (0, pad), (0, 0)), constant_values=1.0)
    b = jnp.pad(b, ((0, 0), (0, pad), (0, 0)))
    a = a.reshape(bsz, nc, CHUNK, c).swapaxes(0, 1)
    b = b.reshape(bsz, nc, CHUNK, c).swapaxes(0, 1)

    def step(h, ab):
        a_c, b_c = ab
        b_c = b_c.at[:, 0].add(a_c[:, 0] * h)
        _, h_c = lax.associative_scan(_combine, (a_c, b_c), axis=1)
        return h_c[:, -1], h_c

    h_last, hs = lax.scan(step, h0, (a, b))
    hs = hs.swapaxes(0, 1).reshape(bsz, nc * CHUNK, c)[:, :t]
    return hs, h_last


def recurrent_branch(xr, gate, conv_hist, h0, conv_w, conv_b, w_rg_a, b_rg_a, w_rg_x, b_rg_x, lru_lambda):
    bsz, t, _ = xr.shape
    xp = jnp.concatenate([conv_hist.astype(xr.dtype), xr], axis=1)
    win = jnp.stack([xp[:, i:i + t] for i in range(CONV_WIDTH)], axis=2)
    xc = jnp.einsum("btwc,wc->btc", win, conv_w) + conv_b
    new_hist = xp[:, xp.shape[1] - (CONV_WIDTH - 1):]
    xblk = xc.reshape(bsz, t, N_RNN_BLOCKS, RNN_BLOCK)
    r = jax.nn.sigmoid((jnp.einsum("btni,nij->btnj", xblk, w_rg_a).reshape(bsz, t, D_RNN) + b_rg_a).astype(jnp.float32))
    i_g = jax.nn.sigmoid((jnp.einsum("btni,nij->btnj", xblk, w_rg_x).reshape(bsz, t, D_RNN) + b_rg_x).astype(jnp.float32))
    log_a = -LRU_C * r * jax.nn.softplus(-lru_lambda.astype(jnp.float32))
    a = jnp.exp(log_a)
    mult = jnp.sqrt(-jnp.expm1(2.0 * log_a))
    bterm = mult * i_g * xc.astype(jnp.float32)
    hs, h_last = linear_recurrence(a, bterm, h0.astype(jnp.float32))
    out = hs.astype(xr.dtype) * jax.nn.gelu(gate)
    return out, new_hist, h_last


def token_mixer(x, past_k, past_v, past_logf, conv_hist, h0, w_in, b_forget, conv_w, conv_b,
                w_rg_a, b_rg_a, w_rg_x, b_rg_x, lru_lambda, w_attn_up, w_rnn_up, w_out):
    bsz, t, _ = x.shape
    z = x @ w_in
    q, k, v, f_logit, xr, gate, g_attn, g_rnn = jnp.split(z, IN_SPLITS, axis=-1)
    q = q.reshape(bsz, t, N_ATTN_HEADS, ATTN_HEAD_DIM)
    k = k.reshape(bsz, t, N_ATTN_HEADS, ATTN_HEAD_DIM)
    v = v.reshape(bsz, t, N_ATTN_HEADS, ATTN_HEAD_DIM)
    logf = jax.nn.log_sigmoid(f_logit.astype(jnp.float32) + b_forget.astype(jnp.float32))
    if past_k is None:
        k_all, v_all, logf_all, p = k, v, logf, 0
    else:
        k_all = jnp.concatenate([past_k.astype(k.dtype), k], axis=1)
        v_all = jnp.concatenate([past_v.astype(v.dtype), v], axis=1)
        logf_all = jnp.concatenate([past_logf.astype(jnp.float32), logf], axis=1)
        p = past_k.shape[1]
    f_all = jnp.cumsum(logf_all, axis=1)
    o = fox_attention(q, k_all, v_all, f_all[:, p:], f_all, p + jnp.arange(t), jnp.arange(p + t))
    rnn_out, new_hist, h_last = recurrent_branch(xr, gate, conv_hist, h0, conv_w, conv_b,
                                                 w_rg_a, b_rg_a, w_rg_x, b_rg_x, lru_lambda)
    merged = (jax.nn.sigmoid(g_attn) * (o.reshape(bsz, t, D_ATTN) @ w_attn_up)
              + jax.nn.sigmoid(g_rnn) * (rnn_out @ w_rnn_up))
    return merged @ w_out, k, v, logf, new_hist, h_last


def peer_block(xb, w_query, keys_1, keys_2, u_tab, v_tab):
    n = xb.shape[0]
    qy = (xb @ w_query).reshape(n, PEER_HEADS, 2, PEER_HALF)
    s1 = jnp.einsum("nhd,kd->nhk", qy[:, :, 0], keys_1).astype(jnp.float32)
    s2 = jnp.einsum("nhd,kd->nhk", qy[:, :, 1], keys_2).astype(jnp.float32)
    t1, i1 = lax.top_k(s1, PEER_TOPK)
    t2, i2 = lax.top_k(s2, PEER_TOPK)
    cand = (t1[..., :, None] + t2[..., None, :]).reshape(n, PEER_HEADS, PEER_TOPK * PEER_TOPK)
    cidx = (i1[..., :, None] * N_KEYS + i2[..., None, :]).reshape(n, PEER_HEADS, PEER_TOPK * PEER_TOPK)
    top, sel = lax.top_k(cand, PEER_TOPK)
    idx = jnp.take_along_axis(cidx, sel, axis=-1)
    g = jax.nn.softmax(top, axis=-1)
    u = jnp.take(u_tab, idx, axis=0)
    act = jax.nn.gelu(jnp.einsum("nhkd,nd->nhk", u, xb).astype(jnp.float32))
    vv = jnp.take(v_tab, idx, axis=0)
    return jnp.einsum("nhk,nhkd->nd", (g * act).astype(xb.dtype), vv)


def peer_ffn(x, w_query, keys_1, keys_2, u_tab, v_tab):
    bsz, t, d = x.shape
    n = bsz * t
    nb = -(-n // PEER_TOKEN_BLOCK)
    flat = jnp.pad(x.reshape(n, d), ((0, nb * PEER_TOKEN_BLOCK - n), (0, 0)))
    out = lax.map(lambda xb: peer_block(xb, w_query, keys_1, keys_2, u_tab, v_tab),
                  flat.reshape(nb, PEER_TOKEN_BLOCK, d))
    return out.reshape(nb * PEER_TOKEN_BLOCK, d)[:n].reshape(bsz, t, d)


def trunk_layer(x, past_k, past_v, past_logf, conv_hist, h0, w_in, b_forget, conv_w, conv_b,
                w_rg_a, b_rg_a, w_rg_x, b_rg_x, lru_lambda, w_attn_up, w_rnn_up, w_out, ln1_g, ln1_b,
                peer_w_query, peer_keys_1, peer_keys_2, peer_u, peer_v, ln2_g, ln2_b):
    mix, k, v, logf, conv_state, rnn_state = token_mixer(
        x, past_k, past_v, past_logf, conv_hist, h0, w_in, b_forget, conv_w, conv_b,
        w_rg_a, b_rg_a, w_rg_x, b_rg_x, lru_lambda, w_attn_up, w_rnn_up, w_out)
    h = layer_norm(DN_ALPHA * x + mix, ln1_g, ln1_b)
    y = layer_norm(DN_ALPHA * h + peer_ffn(h, peer_w_query, peer_keys_1, peer_keys_2, peer_u, peer_v), ln2_g, ln2_b)
    return y, k, v, logf, conv_state, rnn_state


def setup_inputs(seed: int = 0) -> dict:
    key = jax.random.key(seed)
    ks = jax.random.split(key, 32)
    nrm = jax.random.normal
    f32 = jnp.float32
    a0c = jax.random.uniform(ks[12], (DEPTH, D_RNN), f32, minval=0.9, maxval=0.999)
    s = a0c ** (1.0 / LRU_C)
    return {
        "x_prompt": nrm(ks[0], (BATCH, SEQ, D_MODEL), f32),
        "x_sample": nrm(ks[1], (DEC_BATCH, DEC_SEQ, D_MODEL), f32),
        "cache_k": nrm(ks[2], (DEPTH, DEC_BATCH, PAST_LEN, N_ATTN_HEADS, ATTN_HEAD_DIM), f32),
        "cache_v": nrm(ks[3], (DEPTH, DEC_BATCH, PAST_LEN, N_ATTN_HEADS, ATTN_HEAD_DIM), f32),
        "cache_logf": jax.nn.log_sigmoid(nrm(ks[4], (DEPTH, DEC_BATCH, PAST_LEN, N_ATTN_HEADS), f32) + 3.0),
        "state_conv": nrm(ks[5], (DEPTH, DEC_BATCH, CONV_WIDTH - 1, D_RNN), f32),
        "state_rnn": 0.5 * nrm(ks[6], (DEPTH, DEC_BATCH, D_RNN), f32),
        "w_in": nrm(ks[7], (DEPTH, D_MODEL, D_IN), f32) * D_MODEL ** -0.5,
        "b_forget": 3.0 + 0.5 * nrm(ks[8], (DEPTH, N_ATTN_HEADS), f32),
        "conv_w": nrm(ks[9], (DEPTH, CONV_WIDTH, D_RNN), f32) * CONV_WIDTH ** -0.5,
        "conv_b": 0.01 * nrm(ks[10], (DEPTH, D_RNN), f32),
        "w_rg_a": nrm(ks[11], (DEPTH, N_RNN_BLOCKS, RNN_BLOCK, RNN_BLOCK), f32) * RNN_BLOCK ** -0.5,
        "b_rg_a": 0.01 * nrm(ks[13], (DEPTH, D_RNN), f32),
        "w_rg_x": nrm(ks[14], (DEPTH, N_RNN_BLOCKS, RNN_BLOCK, RNN_BLOCK), f32) * RNN_BLOCK ** -0.5,
        "b_rg_x": 0.01 * nrm(ks[15], (DEPTH, D_RNN), f32),
        "lru_lambda": jnp.log(s) - jnp.log1p(-s),
        "w_attn_up": nrm(ks[16], (DEPTH, D_ATTN, D_MODEL), f32) * (D_ATTN ** -0.5 * DN_BETA),
        "w_rnn_up": nrm(ks[17], (DEPTH, D_RNN, D_MODEL), f32) * (D_RNN ** -0.5 * DN_BETA),
        "w_out": nrm(ks[18], (DEPTH, D_MODEL, D_MODEL), f32) * (D_MODEL ** -0.5 * DN_BETA),
        "ln1_g": 1.0 + 0.02 * nrm(ks[19], (DEPTH, D_MODEL), f32),
        "ln1_b": 0.02 * nrm(ks[20], (DEPTH, D_MODEL), f32),
        "peer_w_query": nrm(ks[21], (DEPTH, D_MODEL, PEER_HEADS * PEER_KEY_DIM), f32) * D_MODEL ** -0.5,
        "peer_keys_1": nrm(ks[22], (DEPTH, N_KEYS, PEER_HALF), f32) * PEER_HALF ** -0.5,
        "peer_keys_2": nrm(ks[23], (DEPTH, N_KEYS, PEER_HALF), f32) * PEER_HALF ** -0.5,
        "peer_u": nrm(ks[24], (DEPTH, N_EXPERTS, D_MODEL), f32) * D_MODEL ** -0.5,
        "peer_v": nrm(ks[25], (DEPTH, N_EXPERTS, D_MODEL), f32) * (DN_BETA * PEER_HEADS ** -0.5),
        "ln2_g": 1.0 + 0.02 * nrm(ks[26], (DEPTH, D_MODEL), f32),
        "ln2_b": 0.02 * nrm(ks[27], (DEPTH, D_MODEL), f32),
    }


def reference(x_prompt, x_sample, cache_k, cache_v, cache_logf, state_conv, state_rnn,
              w_in, b_forget, conv_w, conv_b, w_rg_a, b_rg_a, w_rg_x, b_rg_x, lru_lambda,
              w_attn_up, w_rnn_up, w_out, ln1_g, ln1_b, peer_w_query, peer_keys_1, peer_keys_2,
              peer_u, peer_v, ln2_g, ln2_b):
    hp, hs = x_prompt, x_sample
    kp_l, vp_l, fp_l, cp_l, rp_l = [], [], [], [], []
    ks_l, vs_l, fs_l, cs_l, rs_l = [], [], [], [], []
    for l in range(DEPTH):
        lw = (w_in[l], b_forget[l], conv_w[l], conv_b[l], w_rg_a[l], b_rg_a[l], w_rg_x[l], b_rg_x[l],
              lru_lambda[l], w_attn_up[l], w_rnn_up[l], w_out[l], ln1_g[l], ln1_b[l],
              peer_w_query[l], peer_keys_1[l], peer_keys_2[l], peer_u[l], peer_v[l], ln2_g[l], ln2_b[l])
        zero_hist = jnp.zeros((hp.shape[0], CONV_WIDTH - 1, D_RNN), hp.dtype)
        zero_h = jnp.zeros((hp.shape[0], D_RNN), jnp.float32)
        hp, kp, vp, fp, cp, rp = trunk_layer(hp, None, None, None, zero_hist, zero_h, *lw)
        hs, ks_, vs_, fs_, cs_, rs_ = trunk_layer(hs, cache_k[l], cache_v[l], cache_logf[l],
                                                  state_conv[l], state_rnn[l], *lw)
        kp_l.append(kp); vp_l.append(vp); fp_l.append(fp); cp_l.append(cp); rp_l.append(rp)
        ks_l.append(ks_); vs_l.append(vs_); fs_l.append(fs_); cs_l.append(cs_); rs_l.append(rs_)
    return (hp, hs,
            jnp.stack(kp_l), jnp.stack(vp_l), jnp.stack(fp_l), jnp.stack(cp_l), jnp.stack(rp_l),
            jnp.stack(ks_l), jnp.stack(vs_l), jnp.stack(fs_l), jnp.stack(cs_l), jnp.stack(rs_l))
```

```cpp
#include <hip/hip_runtime.h>
#include <hip/hip_cooperative_groups.h>
#include <cstdio>
#include <cstdint>
namespace cg = cooperative_groups;
namespace pg8 {
#define PG8_LAS __attribute__((address_space(3)))
typedef unsigned short bf16_t;
typedef short bf16x8 __attribute__((ext_vector_type(8)));
typedef float f32x4 __attribute__((ext_vector_type(4)));
typedef unsigned u32x4 __attribute__((ext_vector_type(4)));
constexpr int BM = 256, BK = 64, HALF = 128, HTB = HALF * BK * 2  , STAGE_BYTES = 8 * HTB, NXCD = 8, WGM = 8;

__host__ __device__ __forceinline__ int lds_byte(int r, int c) { const int st = (r >> 4) * 2 + (c >> 5), rr = r & 15, cc = c & 31, ob = rr * 64 + cc * 2; return st * 1024 + (ob ^ (((ob >> 9) & 1) << 5)); }
__host__ __device__ __forceinline__ void stage_rc(int b, int& R, int& C) { const int st = b / 1024, sb = b % 1024, swz = sb ^ (((sb >> 9) & 1) << 5); R = (st >> 1) * 16 + swz / 64; C = (st & 1) * 32 + (swz % 64) / 2; }
__host__ __device__ __forceinline__ int perm32(int rho) { const int n = rho >> 4, i = rho & 15; return 8 * (i >> 2) + 4 * n + (i & 3); }

struct Unit { int pm, pn; };
struct Gemm { const bf16_t* A; const bf16_t* Bt; int M, N, K; };

struct StaticOrder {
    int nM, nN, nwg, G, c;
    __host__ __device__ void init(int M, int N, int G_, int c_) { nM = M / BM; nN = N / BM; nwg = nM * nN; G = G_; c = c_; }
    __host__ __device__ bool next(int i, Unit& u) const {
        const long L = (long)i * G + c; if (L >= nwg) return false;
        int wgid = (int)L; { const int q = nwg / NXCD, r = nwg % NXCD, xcd = wgid % NXCD, off = wgid / NXCD; wgid = (xcd < r ? xcd * (q + 1) : r * (q + 1) + (xcd - r) * q) + off; }
        const int nig = WGM * nN, gid = wgid / nig, fm = gid * WGM, gsz = (nM - fm) < WGM ? (nM - fm) : WGM;
        u.pm = fm + ((wgid % nig) % gsz); u.pn = (wgid % nig) / gsz; return true;
    }
    __device__ __forceinline__ void a_ready(const Unit&) const {}
    __device__ __forceinline__ void done(const Unit&) const {}
};

__device__ __forceinline__ unsigned cvt_pk_bf16(float lo, float hi) { unsigned r; asm volatile("v_cvt_pk_bf16_f32 %0, %1, %2" : "=v"(r) : "v"(lo), "v"(hi)); return r; }
template <class Epi, class Sched, bool ALIGN_EPI = false, bool SP2 = false>
__device__ __forceinline__ void gemm_phase(PG8_LAS unsigned char* lds, const Gemm g, const Sched& S, const Epi& E) {
    const int tid = threadIdx.x, wid = __builtin_amdgcn_readfirstlane(tid >> 6), lane = tid & 63, wr = wid >> 2, wc = wid & 3, fr = lane & 15, fq = lane >> 4;
    const int K = g.K, nt = K / BK;
    unsigned voffA[2], voffB[2];
#pragma unroll
    for (int i = 0; i < 2; ++i) { int R, C; stage_rc(tid * 16 + i * 8192, R, C); const int Rb = Epi::PERM ? ((R & ~31) + perm32(R & 31)) : R;
        voffA[i] = (unsigned)(R * K + C) * 2u; voffB[i] = (unsigned)(Rb * K + C) * 2u; }
    const size_t kstep = (size_t)(BK * 2);
    const size_t hstep = (size_t)HALF * K * 2;
    const size_t tstep = 2 * hstep;
    const unsigned ldsw = (unsigned)wid * 1024u;
    const int aoff = lds_byte(wr * 64 + fr, fq * 8), boff = lds_byte(wc * 32 + fr, fq * 8);
#define PG8_SA(b, h) (((b) * 2 + (h)) * HTB)
#define PG8_SB(b, h) ((4 + (b) * 2 + (h)) * HTB)
#define PG8_STAGE(bufoff, gbase, voff) do { _Pragma("unroll") for (int _i = 0; _i < 2; ++_i) \
        __builtin_amdgcn_global_load_lds((const unsigned*)((const char*)(gbase) + (voff)[_i]), (PG8_LAS unsigned*)(lds + (bufoff) + ldsw + _i * 8192), 16, 0, 0); } while (0)
#define PG8_LDA(dst, b, h) do { _Pragma("unroll") for (int m = 0; m < 4; ++m) _Pragma("unroll") for (int k = 0; k < 2; ++k) dst[m][k] = *(const PG8_LAS bf16x8*)(lds + PG8_SA(b, h) + aoff + m * 2048 + k * 1024); } while (0)
#define PG8_LDB(dst, b, h) do { _Pragma("unroll") for (int n = 0; n < 2; ++n) _Pragma("unroll") for (int k = 0; k < 2; ++k) dst[n][k] = *(const PG8_LAS bf16x8*)(lds + PG8_SB(b, h) + boff + n * 2048 + k * 1024); } while (0)
#define PG8_MMA(ai, bj, At, Bt) do { __builtin_amdgcn_s_setprio(1); _Pragma("unroll") for (int m = 0; m < 4; ++m) _Pragma("unroll") for (int n = 0; n < 2; ++n) _Pragma("unroll") for (int k = 0; k < 2; ++k) \
        acc[ai][bj][m][n] = __builtin_amdgcn_mfma_f32_16x16x32_bf16(Bt[n][k], At[m][k], acc[ai][bj][m][n], 0, 0, 0); __builtin_amdgcn_s_setprio(0); } while (0)
#define PG8_WAIT_V(n) asm volatile("s_waitcnt vmcnt(" #n ")" ::: "memory")
#define PG8_WAIT_L(n) asm volatile("s_waitcnt lgkmcnt(" #n ")" ::: "memory")
#define PG8_BAR __builtin_amdgcn_s_barrier()
#define PG8_SCHED __builtin_amdgcn_sched_barrier(0)
    Unit cur, nxt; int ui = 0;
    if (!S.next(0, cur)) return;
    f32x4 acc[2][2][4][2];
#pragma unroll
    for (int a = 0; a < 2; ++a)
#pragma unroll
        for (int b = 0; b < 2; ++b)
#pragma unroll
            for (int m = 0; m < 4; ++m)
#pragma unroll
                for (int n = 0; n < 2; ++n) acc[a][b][m][n] = (f32x4){0.f, 0.f, 0.f, 0.f};
    bf16x8 At[4][2], B0[2][2], B1[2][2];
    const char* cA = (const char*)g.A + (size_t)cur.pm * tstep; const char* cB = (const char*)g.Bt + (size_t)cur.pn * tstep;
    S.a_ready(cur);
    if constexpr (SP2) {
        PG8_STAGE(PG8_SB(0, 0), cB, voffB); PG8_STAGE(PG8_SB(0, 1), cB + hstep, voffB); PG8_STAGE(PG8_SA(0, 0), cA, voffA); PG8_STAGE(PG8_SA(0, 1), cA + hstep, voffA);
        if (wr == 1) PG8_BAR;
        PG8_WAIT_V(2); PG8_BAR;
        PG8_STAGE(PG8_SB(1, 0), cB + kstep, voffB); PG8_STAGE(PG8_SA(1, 0), cA + kstep, voffA); PG8_STAGE(PG8_SB(1, 1), cB + hstep + kstep, voffB);
        PG8_WAIT_V(6); PG8_BAR;
    } else {
        PG8_STAGE(PG8_SB(0, 0), cB, voffB); PG8_STAGE(PG8_SA(0, 0), cA, voffA); PG8_STAGE(PG8_SB(0, 1), cB + hstep, voffB); PG8_STAGE(PG8_SA(0, 1), cA + hstep, voffA);
        if (wr == 1) PG8_BAR;
        PG8_WAIT_V(4); PG8_BAR;
        PG8_STAGE(PG8_SB(1, 0), cB + kstep, voffB); PG8_STAGE(PG8_SA(1, 0), cA + kstep, voffA); PG8_STAGE(PG8_SB(1, 1), cB + hstep + kstep, voffB);
        PG8_WAIT_V(6); PG8_BAR;
    }
    for (;;) {
        const bool has_next = S.next(ui + 1, nxt);
        const char* nA = has_next ? (const char*)g.A + (size_t)nxt.pm * tstep : cA; const char* nB = has_next ? (const char*)g.Bt + (size_t)nxt.pn * tstep : cB;
        for (int t = 0; t < nt; t += 2) {
            const bool last = (t == nt - 2);
            const char* a1 = cA + (size_t)(t + 1) * kstep;
            const char* a2 = last ? nA : cA + (size_t)(t + 2) * kstep; const char* b2 = last ? nB : cB + (size_t)(t + 2) * kstep;
            const char* a3 = a2 + kstep; const char* b3 = b2 + kstep;
            if (last && has_next) S.a_ready(nxt);
            if constexpr (SP2) {
            PG8_LDB(B0, 0, 0); PG8_LDB(B1, 0, 1); PG8_SCHED; PG8_LDA(At, 0, 0); PG8_STAGE(PG8_SA(1, 1), a1 + hstep, voffA);
            PG8_WAIT_V(8); PG8_WAIT_L(0); PG8_BAR; PG8_MMA(0, 0, At, B0); PG8_MMA(0, 1, At, B1); PG8_BAR; PG8_SCHED;
            PG8_LDA(At, 0, 1); PG8_STAGE(PG8_SB(0, 0), b2, voffB); PG8_STAGE(PG8_SB(0, 1), b2 + hstep, voffB); PG8_STAGE(PG8_SA(0, 0), a2, voffA);
            PG8_WAIT_V(8); PG8_WAIT_L(0); PG8_BAR; PG8_MMA(1, 0, At, B0); PG8_MMA(1, 1, At, B1); PG8_BAR; PG8_SCHED;
            PG8_LDB(B0, 1, 0); PG8_LDB(B1, 1, 1); PG8_SCHED; PG8_LDA(At, 1, 0); PG8_STAGE(PG8_SA(0, 1), a2 + hstep, voffA);
            PG8_WAIT_V(8); PG8_WAIT_L(0); PG8_BAR; PG8_MMA(0, 0, At, B0); PG8_MMA(0, 1, At, B1); PG8_BAR; PG8_SCHED;
            PG8_LDA(At, 1, 1); PG8_STAGE(PG8_SB(1, 0), b3, voffB); PG8_STAGE(PG8_SB(1, 1), b3 + hstep, voffB); PG8_STAGE(PG8_SA(1, 0), a3, voffA);
            PG8_WAIT_V(8); PG8_WAIT_L(0); PG8_BAR; PG8_MMA(1, 0, At, B0); PG8_MMA(1, 1, At, B1); PG8_BAR; PG8_SCHED;
            } else {
            PG8_LDB(B0, 0, 0); PG8_SCHED; PG8_LDA(At, 0, 0); PG8_STAGE(PG8_SA(1, 1), a1 + hstep, voffA);
            PG8_WAIT_L(8); PG8_BAR; PG8_WAIT_L(0); PG8_MMA(0, 0, At, B0); PG8_BAR; PG8_SCHED;
            PG8_LDB(B1, 0, 1); PG8_STAGE(PG8_SB(0, 0), b2, voffB);
            PG8_BAR; PG8_WAIT_L(0); PG8_MMA(0, 1, At, B1); PG8_BAR;
            PG8_LDA(At, 0, 1); PG8_STAGE(PG8_SA(0, 0), a2, voffA);
            PG8_BAR; PG8_WAIT_L(0); PG8_MMA(1, 0, At, B0); PG8_BAR; PG8_SCHED;
            PG8_STAGE(PG8_SB(0, 1), b2 + hstep, voffB);
            PG8_WAIT_V(6); PG8_BAR; PG8_MMA(1, 1, At, B1); PG8_BAR;
            PG8_LDB(B0, 1, 0); PG8_SCHED; PG8_LDA(At, 1, 0); PG8_STAGE(PG8_SA(0, 1), a2 + hstep, voffA);
            PG8_WAIT_L(8); PG8_BAR; PG8_WAIT_L(0); PG8_MMA(0, 0, At, B0); PG8_BAR; PG8_SCHED;
            PG8_LDB(B1, 1, 1); PG8_STAGE(PG8_SB(1, 0), b3, voffB);
            PG8_BAR; PG8_WAIT_L(0); PG8_MMA(0, 1, At, B1); PG8_BAR;
            PG8_LDA(At, 1, 1); PG8_STAGE(PG8_SA(1, 0), a3, voffA);
            PG8_BAR; PG8_WAIT_L(0); PG8_MMA(1, 0, At, B0); PG8_BAR; PG8_SCHED;
            PG8_STAGE(PG8_SB(1, 1), b3 + hstep, voffB);
            PG8_WAIT_V(6); PG8_BAR; PG8_MMA(1, 1, At, B1); PG8_BAR;
            }
        }
        if constexpr (ALIGN_EPI) { if (wr == 0) PG8_BAR; }
        if constexpr (!Epi::AFTER_DRAIN) { E(acc, cur, wr, wc, fr, fq); S.done(cur); }
        if (!has_next) break;
#pragma unroll
        for (int a = 0; a < 2; ++a)
#pragma unroll
            for (int b = 0; b < 2; ++b)
#pragma unroll
                for (int m = 0; m < 4; ++m)
#pragma unroll
                    for (int n = 0; n < 2; ++n) acc[a][b][m][n] = (f32x4){0.f, 0.f, 0.f, 0.f};
        cur = nxt; cA = nA; cB = nB; ++ui;
        if constexpr (ALIGN_EPI) { if (wr == 1) PG8_BAR; }
    }
    PG8_WAIT_V(0);
    if constexpr (!ALIGN_EPI) { if (wr == 0) PG8_BAR; }
    PG8_BAR;
    if constexpr (Epi::AFTER_DRAIN) { E.fused(acc, cur, wr, wc, fr, fq, lds, wid, lane); S.done(cur); }
#undef PG8_SA
#undef PG8_SB
#undef PG8_STAGE
#undef PG8_LDA
#undef PG8_LDB
#undef PG8_MMA
#undef PG8_WAIT_V
#undef PG8_WAIT_L
#undef PG8_BAR
#undef PG8_SCHED
}
}

#define LAS __attribute__((address_space(3)))
typedef unsigned short bf16_t;
typedef short bf16x8 __attribute__((ext_vector_type(8)));
typedef float f32x4 __attribute__((ext_vector_type(4)));
typedef float f32x2 __attribute__((ext_vector_type(2)));
typedef float f32x16 __attribute__((ext_vector_type(16)));
typedef unsigned u32x4 __attribute__((ext_vector_type(4)));
typedef unsigned u32x2 __attribute__((ext_vector_type(2)));
typedef short v4i16_t __attribute__((ext_vector_type(4)));
typedef __bf16 bf16x2_t __attribute__((ext_vector_type(2)));

constexpr int DM = 1024, NBATCH = 8, SEQ = 4096, DBATCH = 16, DSEQ = 32, PAST = 1024, NH = 8, HD = 64, DA = 512, DR = 512;
constexpr int MP = NBATCH * SEQ, MS = DBATCH * DSEQ, MT = MP + MS;
constexpr int DIN = 4616, NIN = 4608, NE = 16384, NQ = 2048;
constexpr float LN_EPS = 1e-5f, DN_ALPHA = 1.189207115002721f, LOG2E = 1.4426950408889634f;
constexpr int NSEGP = SEQ / 64;
constexpr size_t OFF_KP = 34078720, OFF_VP = 50855936, OFF_FP = 67633152, OFF_CP = 67895296, OFF_RP = 67907584,
                 OFF_KS = 67911680, OFF_VS = 68173824, OFF_FS = 68435968, OFF_CS = 68440064, OFF_RS = 68464640, OUT_TOTAL = 68472832;
constexpr size_t MiB = 1u << 20;
constexpr size_t WS_XB = 0;
constexpr size_t WS_WIN = 65 * MiB;
constexpr size_t WS_WA = 74 * MiB, WS_WR = 75 * MiB, WS_WO = 76 * MiB, WS_WQ = 78 * MiB;
constexpr size_t WS_KEYS = 82 * MiB, WS_RGA = 82 * MiB + 65536, WS_RGX = 82 * MiB + 131072;
constexpr size_t WS_UT = 83 * MiB, WS_VT = 115 * MiB;
constexpr size_t QKV_BYTES = (size_t)MT * 512 * 2;
constexpr size_t WS_Q = 147 * MiB, WS_K = WS_Q + QKV_BYTES, WS_V = WS_K + QKV_BYTES, WS_XR = WS_V + QKV_BYTES;
constexpr size_t WS_GG = 277 * MiB;
constexpr size_t WS_SA = WS_GG + QKV_BYTES, WS_SR = WS_SA + 2 * QKV_BYTES;
constexpr size_t WS_LC = 440 * MiB, WS_SCH = 442 * MiB, WS_RA = 442 * MiB + 65536, WS_RB = WS_RA + MiB;
constexpr size_t WS_IDX = 445 * MiB, WS_G = 462 * MiB, WS_END = 480 * MiB;
static_assert(WS_XR + QKV_BYTES <= WS_GG && WS_SR + 2 * QKV_BYTES <= WS_LC && WS_IDX + (size_t)MT * 8 * 16 * 4 <= WS_G && WS_G + (size_t)MT * 8 * 16 * 4 <= WS_END, "ws map");

constexpr int LDS_BYTES = 147456;

struct Args { const float* in[28]; float* out; unsigned char* ws; int ph_lo, ph_hi; };
enum { I_XP = 0, I_XS, I_CK, I_CV, I_CLF, I_SCONV, I_SRNN, I_WIN, I_BF, I_CONVW, I_CONVB, I_RGA, I_BRGA, I_RGX, I_BRGX, I_LAM, I_WAUP, I_WRUP, I_WOUT, I_LN1G, I_LN1B,
       I_WQ, I_K1, I_K2, I_PU, I_PV, I_LN2G, I_LN2B };

__device__ __forceinline__ unsigned pk2(float lo, float hi) { f32x2 v = {lo, hi}; bf16x2_t b = __builtin_convertvector(v, bf16x2_t); return __builtin_bit_cast(unsigned, b); }
__device__ __forceinline__ float bflo(unsigned u) { return __uint_as_float(u << 16); }
__device__ __forceinline__ float bfhi(unsigned u) { return __uint_as_float(u & 0xffff0000u); }
__device__ __forceinline__ float bf1(bf16_t b) { return __uint_as_float((unsigned)b << 16); }
__device__ __forceinline__ float sigmoidf_(float x) { return __builtin_amdgcn_rcpf(1.f + __expf(-x)); }
__device__ __forceinline__ float gelu_tanh(float x) { const float u = 0.7978845608028654f * (x + 0.044715f * x * x * x); return x * sigmoidf_(2.f * u); }
__device__ __forceinline__ const float* xrow_ptr(const Args& a, int m) { return m < MP ? a.in[I_XP] + (size_t)m * DM : a.in[I_XS] + (size_t)(m - MP) * DM; }
__device__ __forceinline__ float wave_sum(float v) {
#pragma unroll
    for (int o = 1; o < 64; o <<= 1) v += __shfl_xor(v, o);
    return v;
}
__device__ __forceinline__ int crow(int r, int hi) { return (r & 3) + 8 * (r >> 2) + 4 * hi; }

__device__ __forceinline__ void transpose_item(const float* W, int ldw, bf16_t* WT, int ldk, LAS float* scr, int k0, int n0src, int n0dst, int lane) {
#pragma unroll 8
    for (int i = 0; i < 32; ++i) { const int kk = 2 * i + (lane >> 5); scr[kk * 33 + (lane & 31)] = W[(size_t)(k0 + kk) * ldw + n0src + (lane & 31)]; }
    asm volatile("s_waitcnt lgkmcnt(0)" ::: "memory");
    const int c = lane & 7;
#pragma unroll
    for (int j = 0; j < 4; ++j) { const int n = (lane >> 3) + 8 * j; const LAS float* s = scr + (8 * c) * 33 + n;
        u32x4 o; o.x = pk2(s[0 * 33], s[1 * 33]); o.y = pk2(s[2 * 33], s[3 * 33]); o.z = pk2(s[4 * 33], s[5 * 33]); o.w = pk2(s[6 * 33], s[7 * 33]);
        *(u32x4*)(WT + (size_t)(n0dst + n) * ldk + k0 + 8 * c) = o; }
    asm volatile("s_waitcnt lgkmcnt(0)" ::: "memory");
}
__device__ __forceinline__ void cvt8(const float* src, bf16_t* dst, size_t i) {
    const f32x4 v0 = *(const f32x4*)(src + i * 8), v1 = *(const f32x4*)(src + i * 8 + 4);
    u32x4 o; o.x = pk2(v0.x, v0.y); o.y = pk2(v0.z, v0.w); o.z = pk2(v1.x, v1.y); o.w = pk2(v1.z, v1.w);
    *(u32x4*)(dst + i * 8) = o;
}
__device__ __forceinline__ void p0_prologue(const Args& a, LAS unsigned char* lds, int tid, int lane, int wave) {
    unsigned char* ws = a.ws;
    const int G = gridDim.x, gw = blockIdx.x * 8 + wave, NGW = G * 8;
    {
        LAS float* scr = (LAS float*)(lds + wave * 8448);
        constexpr int I0 = 16 * 144, I1 = 8 * 32, I2 = 8 * 32, I3 = 16 * 32, I4 = 16 * 64, I5 = 16, I6 = 16, NIT = I0 + I1 + I2 + I3 + I4 + I5 + I6;
        for (int it = gw; it < NIT; it += NGW) {
            int r = it;
            if (r < I0) { const int kb = r / 144, nb = r % 144, n0 = 32 * nb; transpose_item(a.in[I_WIN], DIN, (bf16_t*)(ws + WS_WIN), 1024, scr, 64 * kb, n0 + (n0 >= 1536 ? 8 : 0), n0, lane); continue; } r -= I0;
            if (r < I1) { transpose_item(a.in[I_WAUP], 1024, (bf16_t*)(ws + WS_WA), 512, scr, 64 * (r / 32), 32 * (r % 32), 32 * (r % 32), lane); continue; } r -= I1;
            if (r < I2) { transpose_item(a.in[I_WRUP], 1024, (bf16_t*)(ws + WS_WR), 512, scr, 64 * (r / 32), 32 * (r % 32), 32 * (r % 32), lane); continue; } r -= I2;
            if (r < I3) { transpose_item(a.in[I_WOUT], 1024, (bf16_t*)(ws + WS_WO), 1024, scr, 64 * (r / 32), 32 * (r % 32), 32 * (r % 32), lane); continue; } r -= I3;
            if (r < I4) { transpose_item(a.in[I_WQ], 2048, (bf16_t*)(ws + WS_WQ), 1024, scr, 64 * (r / 64), 32 * (r % 64), 32 * (r % 64), lane); continue; } r -= I4;
            if (r < I5) { const int n = r >> 1, nb = r & 1; transpose_item(a.in[I_RGA] + n * 4096, 64, (bf16_t*)(ws + WS_RGA) + n * 4096, 64, scr, 0, 32 * nb, 32 * nb, lane); continue; } r -= I5;
            { const int n = r >> 1, nb = r & 1; transpose_item(a.in[I_RGX] + n * 4096, 64, (bf16_t*)(ws + WS_RGX) + n * 4096, 64, scr, 0, 32 * nb, 32 * nb, lane); }
        }
    }
    {
        constexpr size_t N0 = (size_t)MP * DM / 8, N1 = (size_t)MS * DM / 8, N2 = (size_t)NE * DM / 8, N3 = N2, N4 = 2048, N5 = 2048, NTOT = N0 + N1 + N2 + N3 + N4 + N5;
        const size_t stride = (size_t)G * 512;
        for (size_t i = (size_t)blockIdx.x * 512 + tid; i < NTOT; i += stride) {
            size_t r = i;
            if (r < N0) { cvt8(a.in[I_XP], (bf16_t*)(ws + WS_XB), r); continue; } r -= N0;
            if (r < N1) { cvt8(a.in[I_XS], (bf16_t*)(ws + WS_XB) + (size_t)MP * DM, r); continue; } r -= N1;
            if (r < N2) { cvt8(a.in[I_PU], (bf16_t*)(ws + WS_UT), r); continue; } r -= N2;
            if (r < N3) { cvt8(a.in[I_PV], (bf16_t*)(ws + WS_VT), r); continue; } r -= N3;
            if (r < N4) { cvt8(a.in[I_K1], (bf16_t*)(ws + WS_KEYS), r); continue; } r -= N4;
            cvt8(a.in[I_K2], (bf16_t*)(ws + WS_KEYS) + 16384, r);
        }
    }
    __syncthreads();
    {
        LAS float* wf = (LAS float*)lds;
        LAS float* lfs = (LAS float*)(lds + 32768);
        const float* win = a.in[I_WIN];
        bool staged = false;
        for (int u = blockIdx.x; u < MT / 64; u += G) {
            if (!staged) { for (int i = tid; i < 8192; i += 512) wf[i] = win[(size_t)(i >> 3) * DIN + 1536 + (i & 7)]; staged = true; __syncthreads(); }
            const int m0 = 64 * u;
            for (int i = 0; i < 8; ++i) {
                const int m = m0 + 8 * wave + i; const float* xr = xrow_ptr(a, m);
                float acc[8];
#pragma unroll
                for (int h = 0; h < 8; ++h) acc[h] = 0.f;
#pragma unroll 4
                for (int kk = 0; kk < 16; ++kk) { const int k = lane + 64 * kk; const float xv = xr[k]; const f32x4 w0 = *(const LAS f32x4*)(wf + k * 8), w1 = *(const LAS f32x4*)(wf + k * 8 + 4);
                    acc[0] += xv * w0.x; acc[1] += xv * w0.y; acc[2] += xv * w0.z; acc[3] += xv * w0.w; acc[4] += xv * w1.x; acc[5] += xv * w1.y; acc[6] += xv * w1.z; acc[7] += xv * w1.w; }
                float z = 0.f;
#pragma unroll
                for (int h = 0; h < 8; ++h) { const float s = wave_sum(acc[h]); if (lane == h) z = s; }
                if (lane < 8) { z += a.in[I_BF][lane]; const float lf = fminf(z, 0.f) - log1pf(__expf(-fabsf(z)));
                    if (m < MP) a.out[OFF_FP + (size_t)m * 8 + lane] = lf; else a.out[OFF_FS + (size_t)(m - MP) * 8 + lane] = lf;
                    lfs[(8 * wave + i) * 8 + lane] = lf; }
            }
            __syncthreads();
            if (u < MP / 64) { float v = lfs[lane * 8 + wave];
#pragma unroll
                for (int o = 1; o < 64; o <<= 1) { const float t = __shfl_up(v, o); if (lane >= o) v += t; }
                ((float*)(ws + WS_LC))[(size_t)(m0 + lane) * 8 + wave] = v;
                if (lane == 63) ((float*)(ws + WS_SCH))[u * 8 + wave] = v; }
            __syncthreads();
        }
    }
}

struct Epi1 {
    static constexpr bool PERM = false, AFTER_DRAIN = false;
    float* out; unsigned char* ws;
    __device__ __forceinline__ void operator()(const f32x4 (&acc)[2][2][4][2], const pg8::Unit& u, int wr, int wc, int fr, int fq) const {
        const int pn = u.pn; const int rbase = u.pm * 256 + wr * 64 + fr; const int cbase = pn * 256 + wc * 32 + 4 * fq;
        const bool samp = u.pm >= MP / 256;
#pragma unroll
        for (int ai = 0; ai < 2; ++ai)
#pragma unroll
            for (int m = 0; m < 4; ++m) {
                const int row = rbase + ai * 128 + m * 16;
#pragma unroll
                for (int bj = 0; bj < 2; ++bj)
#pragma unroll
                    for (int n = 0; n < 2; ++n) {
                        const int col = cbase + bj * 128 + n * 16; const f32x4 v = acc[ai][bj][m][n];
                        if (pn < 2) { u32x2 w; w.x = pk2(v.x, v.y); w.y = pk2(v.z, v.w); *(u32x2*)((bf16_t*)(ws + WS_Q) + (size_t)row * 512 + col) = w; }
                        else if (pn < 6) { const int isv = pn >= 4; const int c = col - (isv ? 1024 : 512);
                            u32x2 w; w.x = pk2(v.x, v.y); w.y = pk2(v.z, v.w); *(u32x2*)((bf16_t*)(ws + (isv ? WS_V : WS_K)) + (size_t)row * 512 + c) = w;
                            float* o = samp ? out + (isv ? OFF_VS : OFF_KS) + (size_t)(row - MP) * 512 + c : out + (isv ? OFF_VP : OFF_KP) + (size_t)row * 512 + c;
                            *(f32x4*)o = v; }
                        else if (pn < 8) { const int c = col - 1536;
                            u32x2 w; w.x = pk2(v.x, v.y); w.y = pk2(v.z, v.w); *(u32x2*)((bf16_t*)(ws + WS_XR) + (size_t)row * 512 + c) = w;
                            if (!samp) { const int t = row & (SEQ - 1); if (t >= SEQ - 3) *(f32x4*)(out + OFF_CP + (size_t)((row >> 12) * 3 + (t - (SEQ - 3))) * 512 + c) = v; }
                            else { const int rs = row - MP, t = rs & 31; if (t >= DSEQ - 3) *(f32x4*)(out + OFF_CS + (size_t)((rs >> 5) * 3 + (t - (DSEQ - 3))) * 512 + c) = v; } }
                        else if (pn < 10) { const int c = col - 2048;
                            u32x2 w; w.x = pk2(gelu_tanh(v.x), gelu_tanh(v.y)); w.y = pk2(gelu_tanh(v.z), gelu_tanh(v.w)); *(u32x2*)((bf16_t*)(ws + WS_GG) + (size_t)row * 512 + c) = w; }
                        else { const int isr = pn >= 14; const int c = col - (isr ? 3584 : 2560);
                            u32x2 w; w.x = pk2(sigmoidf_(v.x), sigmoidf_(v.y)); w.y = pk2(sigmoidf_(v.z), sigmoidf_(v.w)); *(u32x2*)((bf16_t*)(ws + (isr ? WS_SR : WS_SA)) + (size_t)row * 1024 + c) = w; }
                    }
            }
    }
};
template <int SECOND> struct EpiUp {
    static constexpr bool PERM = false, AFTER_DRAIN = false;
    const bf16_t* gate; bf16_t* mg;
    __device__ __forceinline__ void operator()(const f32x4 (&acc)[2][2][4][2], const pg8::Unit& u, int wr, int wc, int fr, int fq) const {
        const int rbase = u.pm * 256 + wr * 64 + fr; const int cbase = u.pn * 256 + wc * 32 + 4 * fq;
#pragma unroll
        for (int ai = 0; ai < 2; ++ai)
#pragma unroll
            for (int m = 0; m < 4; ++m) {
                const size_t ro = (size_t)(rbase + ai * 128 + m * 16) * 1024;
#pragma unroll
                for (int bj = 0; bj < 2; ++bj)
#pragma unroll
                    for (int n = 0; n < 2; ++n) {
                        const size_t o = ro + cbase + bj * 128 + n * 16; const f32x4 v = acc[ai][bj][m][n];
                        const u32x2 g = *(const u32x2*)(gate + o);
                        float r0 = bflo(g.x) * v.x, r1 = bfhi(g.x) * v.y, r2 = bflo(g.y) * v.z, r3 = bfhi(g.y) * v.w;
                        if (SECOND) { const u32x2 p = *(const u32x2*)(mg + o); r0 += bflo(p.x); r1 += bfhi(p.x); r2 += bflo(p.y); r3 += bfhi(p.y); }
                        u32x2 w; w.x = pk2(r0, r1); w.y = pk2(r2, r3); *(u32x2*)(mg + o) = w;
                    }
            }
    }
};
struct EpiOut {
    static constexpr bool PERM = false, AFTER_DRAIN = false;
    const float* xp; const float* xs; float* y;
    __device__ __forceinline__ void operator()(const f32x4 (&acc)[2][2][4][2], const pg8::Unit& u, int wr, int wc, int fr, int fq) const {
        const int rbase = u.pm * 256 + wr * 64 + fr; const int cbase = u.pn * 256 + wc * 32 + 4 * fq;
#pragma unroll
        for (int ai = 0; ai < 2; ++ai)
#pragma unroll
            for (int m = 0; m < 4; ++m) {
                const int row = rbase + ai * 128 + m * 16; const float* xr = row < MP ? xp + (size_t)row * DM : xs + (size_t)(row - MP) * DM;
#pragma unroll
                for (int bj = 0; bj < 2; ++bj)
#pragma unroll
                    for (int n = 0; n < 2; ++n) { const int col = cbase + bj * 128 + n * 16; const f32x4 xv = *(const f32x4*)(xr + col);
                        *(f32x4*)(y + (size_t)row * DM + col) = xv * DN_ALPHA + acc[ai][bj][m][n]; }
            }
    }
};
struct EpiQy {
    static constexpr bool PERM = true, AFTER_DRAIN = false;
    bf16_t* O;
    __device__ __forceinline__ void operator()(const f32x4 (&acc)[2][2][4][2], const pg8::Unit& u, int wr, int wc, int fr, int fq) const {
        const int row0 = u.pm * 256 + wr * 64 + fr; const int col0 = u.pn * 256 + wc * 32 + 8 * fq;
#pragma unroll
        for (int ai = 0; ai < 2; ++ai)
#pragma unroll
            for (int m = 0; m < 4; ++m) { bf16_t* rowp = O + (size_t)(row0 + ai * 128 + m * 16) * NQ + col0;
#pragma unroll
                for (int bj = 0; bj < 2; ++bj) { const f32x4 v0 = acc[ai][bj][m][0], v1 = acc[ai][bj][m][1];
                    u32x4 w; w.x = pk2(v0[0], v0[1]); w.y = pk2(v0[2], v0[3]); w.z = pk2(v1[0], v1[1]); w.w = pk2(v1[2], v1[3]);
                    *(u32x4*)(rowp + bj * 128) = w; } }
    }
};

template <int NK>
__device__ __forceinline__ void attn_tile(float& mrun, float& lrun, f32x16 (&o)[2], const bf16x8 (&qf)[4], const LAS unsigned char* Kt, const LAS unsigned char* Vt, int vimg_stride,
                                          const LAS float* cb, bool masked, int qrel, int lane) {
    const int r32 = lane & 31, hi = lane >> 5;
    f32x16 p[NK];
#pragma unroll
    for (int ks = 0; ks < NK; ++ks) {
        f32x16 acc = {};
#pragma unroll
        for (int c = 0; c < 4; ++c) { const bf16x8 kf = *(const LAS bf16x8*)(Kt + (32 * ks + r32) * 144 + (16 * c + 8 * hi) * 2); acc = __builtin_amdgcn_mfma_f32_32x32x16_bf16(kf, qf[c], acc, 0, 0, 0); }
        p[ks] = acc;
    }
    constexpr float SC = 0.125f * LOG2E;
    float mx = -INFINITY;
#pragma unroll
    for (int ks = 0; ks < NK; ++ks)
#pragma unroll
        for (int g = 0; g < 4; ++g) { const f32x4 cbv = *(const LAS f32x4*)(cb + 32 * ks + 8 * g + 4 * hi);
#pragma unroll
            for (int i = 0; i < 4; ++i) { float t = p[ks][4 * g + i] * SC + cbv[i]; if (masked && (32 * ks + 8 * g + 4 * hi + i > qrel)) t = -INFINITY; p[ks][4 * g + i] = t; mx = fmaxf(mx, t); } }
    mx = fmaxf(mx, __shfl_xor(mx, 32));
    const float mnew = fmaxf(mrun, mx);
    const float alpha = __builtin_amdgcn_exp2f(mrun - mnew);
    mrun = mnew;
    float rs = 0.f;
#pragma unroll
    for (int ks = 0; ks < NK; ++ks)
#pragma unroll
        for (int r = 0; r < 16; ++r) { const float e = __builtin_amdgcn_exp2f(p[ks][r] - mnew); p[ks][r] = e; rs += e; }
    lrun = lrun * alpha + rs;
#pragma unroll
    for (int dh = 0; dh < 2; ++dh)
#pragma unroll
        for (int r = 0; r < 16; ++r) o[dh][r] *= alpha;
    const int li = lane & 15, cg2 = (lane >> 4) & 1;
    const int voff = (4 * hi + (li >> 2)) * 64 + (16 * cg2 + 4 * (li & 3)) * 2;
#pragma unroll
    for (int kc = 0; kc < 2 * NK; ++kc) {
        const int ks = kc >> 1, rb = 8 * (kc & 1);
        u32x4 pw; pw.x = pk2(p[ks][rb + 0], p[ks][rb + 1]); pw.y = pk2(p[ks][rb + 2], p[ks][rb + 3]); pw.z = pk2(p[ks][rb + 4], p[ks][rb + 5]); pw.w = pk2(p[ks][rb + 6], p[ks][rb + 7]);
        const bf16x8 pb = __builtin_bit_cast(bf16x8, pw);
#pragma unroll
        for (int dh = 0; dh < 2; ++dh) {
            const LAS unsigned char* vp = Vt + dh * vimg_stride + (16 * kc) * 64 + voff;
            const v4i16_t lo = __builtin_amdgcn_ds_read_tr16_b64_v4i16((LAS v4i16_t*)vp);
            const v4i16_t hh = __builtin_amdgcn_ds_read_tr16_b64_v4i16((LAS v4i16_t*)(vp + 8 * 64));
            const bf16x8 vf = {lo[0], lo[1], lo[2], lo[3], hh[0], hh[1], hh[2], hh[3]};
            o[dh] = __builtin_amdgcn_mfma_f32_32x32x16_bf16(vf, pb, o[dh], 0, 0, 0);
        }
    }
}

constexpr int AT_KB = 64 * 144, AT_VB = 8192, AT_K0 = 0, AT_V0 = 2 * AT_KB, AT_CB = AT_V0 + 2 * AT_VB;
__device__ __forceinline__ void attn_prompt_unit(const Args& a, LAS unsigned char* lds, int b, int h, int qb, int tid, int lane, int wave) {
    unsigned char* ws = a.ws;
    const bf16_t* Q = (const bf16_t*)(ws + WS_Q); const bf16_t* K = (const bf16_t*)(ws + WS_K); const bf16_t* V = (const bf16_t*)(ws + WS_V); bf16_t* O = (bf16_t*)(ws + WS_Q);
    const float* LC = (const float*)(ws + WS_LC); const float* SCH = (const float*)(ws + WS_SCH);
    const int r32 = lane & 31, hi = lane >> 5;
    const size_t rowb = (size_t)b * SEQ;
    const int q0 = qb * 256 + wave * 32;
    bf16x8 qf[4];
#pragma unroll
    for (int c = 0; c < 4; ++c) qf[c] = *(const bf16x8*)(Q + (rowb + q0 + r32) * 512 + h * 64 + 16 * c + 8 * hi);
    const int NT = (qb + 1) * 4;
    const int skey = tid >> 3, sch = tid & 7;
    const bf16_t* ksrc = K + (rowb + skey) * 512 + h * 64 + sch * 8; const bf16_t* vsrc = V + (rowb + skey) * 512 + h * 64 + sch * 8;
    const int kdst = skey * 144 + sch * 16, vdst = (sch >> 2) * 4096 + skey * 64 + (sch & 3) * 16;
    float off = 0.f;
    u32x4 kreg = *(const u32x4*)ksrc, vreg = *(const u32x4*)vsrc; float creg = 0.f;
    if (tid < 64) { creg = -(off + LC[(rowb + tid) * 8 + h]) * LOG2E; off += SCH[(b * NSEGP + 0) * 8 + h]; }
    *(LAS u32x4*)(lds + AT_K0 + kdst) = kreg; *(LAS u32x4*)(lds + AT_V0 + vdst) = vreg; if (tid < 64) ((LAS float*)(lds + AT_CB))[tid] = creg;
    __syncthreads();
    float mrun = -INFINITY, lrun = 0.f; f32x16 o[2]; o[0] = f32x16{}; o[1] = f32x16{};
    for (int j = 0; j < NT; ++j) {
        const int buf = j & 1;
        if (j + 1 < NT) { kreg = *(const u32x4*)(ksrc + (size_t)(j + 1) * 64 * 512); vreg = *(const u32x4*)(vsrc + (size_t)(j + 1) * 64 * 512);
            if (tid < 64) { creg = -(off + LC[(rowb + 64 * (j + 1) + tid) * 8 + h]) * LOG2E; off += SCH[(b * NSEGP + j + 1) * 8 + h]; } }
        if (64 * j <= q0 + 31) {
            const bool masked = (64 * j + 63 > q0);
            attn_tile<2>(mrun, lrun, o, qf, lds + AT_K0 + buf * AT_KB, lds + AT_V0 + buf * AT_VB, 4096, (const LAS float*)(lds + AT_CB) + buf * 64, masked, q0 + r32 - 64 * j, lane);
        }
        if (j + 1 < NT) { *(LAS u32x4*)(lds + AT_K0 + (buf ^ 1) * AT_KB + kdst) = kreg; *(LAS u32x4*)(lds + AT_V0 + (buf ^ 1) * AT_VB + vdst) = vreg; if (tid < 64) ((LAS float*)(lds + AT_CB))[(buf ^ 1) * 64 + tid] = creg; }
        __syncthreads();
    }
    const float lt = lrun + __shfl_xor(lrun, 32); const float inv = 1.f / lt;
    bf16_t* orow = O + (rowb + q0 + r32) * 512 + h * 64;
#pragma unroll
    for (int dh = 0; dh < 2; ++dh)
#pragma unroll
        for (int g = 0; g < 4; ++g) { u32x2 w; w.x = pk2(o[dh][4 * g] * inv, o[dh][4 * g + 1] * inv); w.y = pk2(o[dh][4 * g + 2] * inv, o[dh][4 * g + 3] * inv);
            *(u32x2*)(orow + 32 * dh + 8 * g + 4 * hi) = w; }
}

constexpr int SA_WV = 4608 + 4096, SA_CB = 8 * SA_WV, SA_CMB = 0;
__device__ __forceinline__ void attn_sample_unit(const Args& a, LAS unsigned char* lds, int bs, int h, int tid, int lane, int wave) {
    unsigned char* ws = a.ws;
    const bf16_t* Q = (const bf16_t*)(ws + WS_Q); const bf16_t* Kn = (const bf16_t*)(ws + WS_K); const bf16_t* Vn = (const bf16_t*)(ws + WS_V); bf16_t* O = (bf16_t*)(ws + WS_Q);
    const int r32 = lane & 31, hi = lane >> 5;
    const size_t row0 = (size_t)MP + (size_t)bs * DSEQ;
    LAS float* cbs = (LAS float*)(lds + SA_CB);
    if (wave == 0) {
        float v[17]; float s = 0.f;
#pragma unroll
        for (int i = 0; i < 17; ++i) { const int k = lane * 17 + i; float x = 0.f;
            if (k < PAST) x = a.in[I_CLF][((size_t)bs * PAST + k) * 8 + h]; else if (k < PAST + DSEQ) x = a.out[OFF_FS + ((size_t)bs * DSEQ + (k - PAST)) * 8 + h];
            s += x; v[i] = s; }
        float inc = s;
#pragma unroll
        for (int o = 1; o < 64; o <<= 1) { const float t = __shfl_up(inc, o); if (lane >= o) inc += t; }
        const float excl = inc - s;
#pragma unroll
        for (int i = 0; i < 17; ++i) cbs[lane * 17 + i] = -(excl + v[i]) * LOG2E;
    }
    bf16x8 qf[4];
#pragma unroll
    for (int c = 0; c < 4; ++c) qf[c] = *(const bf16x8*)(Q + (row0 + r32) * 512 + h * 64 + 16 * c + 8 * hi);
    __syncthreads();
    LAS unsigned char* Kw = lds + wave * SA_WV; LAS unsigned char* Vw = Kw + 4608;
    float mrun = -INFINITY, lrun = 0.f; f32x16 o[2]; o[0] = f32x16{}; o[1] = f32x16{};
    for (int g = wave; g < 33; g += 8) {
        if (g < 32) {
            const float* kc = a.in[I_CK] + (((size_t)bs * PAST + 32 * g) * NH + h) * HD; const float* vc = a.in[I_CV] + (((size_t)bs * PAST + 32 * g) * NH + h) * HD;
#pragma unroll
            for (int i = 0; i < 8; ++i) { const int id = i * 64 + lane, key = id >> 4, part = id & 15;
                const f32x4 kv = *(const f32x4*)(kc + (size_t)key * NH * HD + part * 4), vv = *(const f32x4*)(vc + (size_t)key * NH * HD + part * 4);
                u32x2 kw; kw.x = pk2(kv.x, kv.y); kw.y = pk2(kv.z, kv.w); u32x2 vw; vw.x = pk2(vv.x, vv.y); vw.y = pk2(vv.z, vv.w);
                *(LAS u32x2*)(Kw + key * 144 + part * 8) = kw; *(LAS u32x2*)(Vw + (part >> 3) * 2048 + key * 64 + (part & 7) * 8) = vw; }
        } else {
#pragma unroll
            for (int i = 0; i < 4; ++i) { const int id = i * 64 + lane, key = id >> 3, ch = id & 7;
                const u32x4 kv = *(const u32x4*)(Kn + (row0 + key) * 512 + h * 64 + ch * 8), vv = *(const u32x4*)(Vn + (row0 + key) * 512 + h * 64 + ch * 8);
                *(LAS u32x4*)(Kw + key * 144 + ch * 16) = kv; *(LAS u32x4*)(Vw + (ch >> 2) * 2048 + key * 64 + (ch & 3) * 16) = vv; }
        }
        asm volatile("s_waitcnt lgkmcnt(0)" ::: "memory");
        attn_tile<1>(mrun, lrun, o, qf, Kw, Vw, 2048, cbs + 32 * g, g == 32, r32, lane);
        asm volatile("s_waitcnt lgkmcnt(0)" ::: "memory");
    }
    __syncthreads();
    LAS float* cm = (LAS float*)(lds + SA_CMB) + wave * 2112;
    const float lt = lrun + __shfl_xor(lrun, 32);
    if (hi == 0) { cm[r32] = mrun; cm[32 + r32] = lt; }
#pragma unroll
    for (int dh = 0; dh < 2; ++dh)
#pragma unroll
        for (int r = 0; r < 16; ++r) cm[64 + (32 * dh + crow(r, hi)) * 32 + r32] = o[dh][r];
    __syncthreads();
    {
        const int q = tid & 31, d0 = (tid >> 5) * 4;
        const LAS float* base = (const LAS float*)(lds + SA_CMB);
        float M = -INFINITY;
#pragma unroll
        for (int w = 0; w < 8; ++w) M = fmaxf(M, base[w * 2112 + q]);
        float L = 0.f, acc[4] = {0.f, 0.f, 0.f, 0.f};
#pragma unroll
        for (int w = 0; w < 8; ++w) { const float f = __builtin_amdgcn_exp2f(base[w * 2112 + q] - M); L += f * base[w * 2112 + 32 + q];
#pragma unroll
            for (int i = 0; i < 4; ++i) acc[i] += f * base[w * 2112 + 64 + (d0 + i) * 32 + q]; }
        const float inv = 1.f / L;
        u32x2 w; w.x = pk2(acc[0] * inv, acc[1] * inv); w.y = pk2(acc[2] * inv, acc[3] * inv);
        *(u32x2*)(O + (row0 + q) * 512 + h * 64 + d0) = w;
    }
    __syncthreads();
}

constexpr int RN_XC = 0, RN_XCS = 1040, RN_HIN = 64 * RN_XCS;
template <bool FINAL>
__device__ __forceinline__ void rnn_tile(const Args& a, LAS unsigned char* lds, int tile, int tid, int lane, int wave) {
    unsigned char* ws = a.ws;
    const bf16_t* XR = (const bf16_t*)(ws + WS_XR); bf16_t* GGRO = (bf16_t*)(ws + WS_GG);
    float* RA = (float*)(ws + WS_RA); float* RB = (float*)(ws + WS_RB);
    const bool samp = tile >= NBATCH * NSEGP;
    const int b = samp ? tile - NBATCH * NSEGP : tile / NSEGP, seg = samp ? 0 : tile % NSEGP;
    const size_t m0 = samp ? (size_t)MP + (size_t)b * DSEQ : (size_t)b * SEQ + (size_t)seg * 64;
    const int nrow = samp ? 32 : 64;
    for (int it = tid; it < nrow * 64; it += 512) {
        const int t = it >> 6, c0 = (it & 63) * 8;
        float acc[8];
        const f32x4 cb0 = *(const f32x4*)(a.in[I_CONVB] + c0), cb1 = *(const f32x4*)(a.in[I_CONVB] + c0 + 4);
        acc[0] = cb0.x; acc[1] = cb0.y; acc[2] = cb0.z; acc[3] = cb0.w; acc[4] = cb1.x; acc[5] = cb1.y; acc[6] = cb1.z; acc[7] = cb1.w;
#pragma unroll
        for (int w = 0; w < 4; ++w) {
            const int tt = (samp ? 0 : seg * 64) + t - 3 + w;
            float xv[8];
            if (tt >= 0) { const u32x4 x = *(const u32x4*)(XR + (m0 + t - 3 + w) * 512 + c0);
                xv[0] = bflo(x.x); xv[1] = bfhi(x.x); xv[2] = bflo(x.y); xv[3] = bfhi(x.y); xv[4] = bflo(x.z); xv[5] = bfhi(x.z); xv[6] = bflo(x.w); xv[7] = bfhi(x.w); }
            else if (samp) { const float* sc = a.in[I_SCONV] + ((size_t)b * 3 + (3 + tt)) * 512 + c0; const f32x4 s0 = *(const f32x4*)sc, s1 = *(const f32x4*)(sc + 4);
                xv[0] = s0.x; xv[1] = s0.y; xv[2] = s0.z; xv[3] = s0.w; xv[4] = s1.x; xv[5] = s1.y; xv[6] = s1.z; xv[7] = s1.w; }
            else {
#pragma unroll
                for (int i = 0; i < 8; ++i) xv[i] = 0.f; }
            const f32x4 w0 = *(const f32x4*)(a.in[I_CONVW] + w * 512 + c0), w1 = *(const f32x4*)(a.in[I_CONVW] + w * 512 + c0 + 4);
            acc[0] += xv[0] * w0.x; acc[1] += xv[1] * w0.y; acc[2] += xv[2] * w0.z; acc[3] += xv[3] * w0.w; acc[4] += xv[4] * w1.x; acc[5] += xv[5] * w1.y; acc[6] += xv[6] * w1.z; acc[7] += xv[7] * w1.w;
        }
        u32x4 o; o.x = pk2(acc[0], acc[1]); o.y = pk2(acc[2], acc[3]); o.z = pk2(acc[4], acc[5]); o.w = pk2(acc[6], acc[7]);
        *(LAS u32x4*)(lds + RN_XC + t * RN_XCS + c0 * 2) = o;
    }
    if (FINAL) {
        LAS float* hin = (LAS float*)(lds + RN_HIN);
        float hc;
        if (samp) hc = a.in[I_SRNN][(size_t)b * 512 + tid];
        else { hc = 0.f; const float* pa = RA + (size_t)(b * NSEGP) * 512 + tid; const float* pb = RB + (size_t)(b * NSEGP) * 512 + tid;
#pragma unroll 8
            for (int s = 0; s < seg; ++s) hc = pa[(size_t)s * 512] * hc + pb[(size_t)s * 512]; }
        hin[tid] = hc;
    }
    __syncthreads();
    const int r32 = lane & 31, hi = lane >> 5, n = wave;
    const bf16_t* WAt = (const bf16_t*)(ws + WS_RGA) + n * 4096; const bf16_t* WXt = (const bf16_t*)(ws + WS_RGX) + n * 4096;
    float carry[2], aprod[2];
#pragma unroll 1
    for (int jh = 0; jh < 2; ++jh) {
        const int ch = 64 * n + 32 * jh + r32;
        bf16x8 wa[4], wx[4];
#pragma unroll
        for (int c = 0; c < 4; ++c) { wa[c] = *(const bf16x8*)(WAt + (32 * jh + r32) * 64 + 16 * c + 8 * hi); wx[c] = *(const bf16x8*)(WXt + (32 * jh + r32) * 64 + 16 * c + 8 * hi); }
        const float ba = a.in[I_BRGA][ch], bx = a.in[I_BRGX][ch];
        const float lam = a.in[I_LAM][ch]; const float sp = fmaxf(-lam, 0.f) + log1pf(__expf(-fabsf(lam)));
        float cr = FINAL ? ((const LAS float*)(lds + RN_HIN))[ch] : 0.f; float ap = 1.f;
#pragma unroll 1
        for (int th = 0; th < (samp ? 1 : 2); ++th) {
            f32x16 ya = {}, yx = {};
#pragma unroll
            for (int c = 0; c < 4; ++c) { const bf16x8 af = *(const LAS bf16x8*)(lds + RN_XC + (32 * th + r32) * RN_XCS + (64 * n + 16 * c + 8 * hi) * 2);
                ya = __builtin_amdgcn_mfma_f32_32x32x16_bf16(af, wa[c], ya, 0, 0, 0); yx = __builtin_amdgcn_mfma_f32_32x32x16_bf16(af, wx[c], yx, 0, 0, 0); }
#pragma unroll
            for (int r = 0; r < 16; ++r) {
                const int t = 32 * th + crow(r, hi);
                const float xc = bf1(*(const LAS bf16_t*)(lds + RN_XC + t * RN_XCS + ch * 2));
                const float rg = sigmoidf_(ya[r] + ba), ig = sigmoidf_(yx[r] + bx);
                const float la = -8.f * rg * sp; const float av = __expf(la);
                const float mult = sqrtf(fmaxf(1.f - av * av, 0.f));
                ya[r] = av; yx[r] = mult * ig * xc;
            }
#pragma unroll
            for (int g = 0; g < 4; ++g) {
                float h0 = ya[4 * g] * cr + yx[4 * g], h1 = ya[4 * g + 1] * h0 + yx[4 * g + 1], h2 = ya[4 * g + 2] * h1 + yx[4 * g + 2], h3 = ya[4 * g + 3] * h2 + yx[4 * g + 3];
                const float rv = __shfl_xor(h3, 32);
                const float k0 = ya[4 * g] * rv + yx[4 * g], k1 = ya[4 * g + 1] * k0 + yx[4 * g + 1], k2 = ya[4 * g + 2] * k1 + yx[4 * g + 2], k3 = ya[4 * g + 3] * k2 + yx[4 * g + 3];
                ap *= (ya[4 * g] * ya[4 * g + 1]) * (ya[4 * g + 2] * ya[4 * g + 3]);
                if (hi) { h0 = k0; h1 = k1; h2 = k2; h3 = k3; }
                const float back = __shfl_xor(k3, 32);
                cr = hi ? k3 : back;
                if (FINAL) { yx[4 * g] = h0; yx[4 * g + 1] = h1; yx[4 * g + 2] = h2; yx[4 * g + 3] = h3; }
            }
            if (FINAL) {
#pragma unroll
                for (int r = 0; r < 16; ++r) { const int t = 32 * th + crow(r, hi); bf16_t* p = GGRO + (m0 + t) * 512 + ch; *p = (bf16_t)(pk2(yx[r] * bf1(*p), 0.f) & 0xffffu); }
            }
        }
        carry[jh] = cr; aprod[jh] = ap;
    }
#pragma unroll
    for (int jh = 0; jh < 2; ++jh) {
        const int ch = 64 * n + 32 * jh + r32;
        if (!FINAL) { const float ap = aprod[jh] * __shfl_xor(aprod[jh], 32); if (hi == 0) { RA[(size_t)tile * 512 + ch] = ap; RB[(size_t)tile * 512 + ch] = carry[jh]; } }
        else if (hi == 0) { if (samp) a.out[OFF_RS + (size_t)b * 512 + ch] = carry[jh]; else if (seg == NSEGP - 1) a.out[OFF_RP + (size_t)b * 512 + ch] = carry[jh]; }
    }
    __syncthreads();
}

__device__ __forceinline__ void ln1_phase(const Args& a, int lane, int wave) {
    const int gw = blockIdx.x * 8 + wave, NGW = gridDim.x * 8;
    bf16_t* HB = (bf16_t*)(a.ws + WS_XB);
    f32x4 gv[4], bv[4];
#pragma unroll
    for (int j = 0; j < 4; ++j) { gv[j] = *((const f32x4*)a.in[I_LN1G] + lane + 64 * j); bv[j] = *((const f32x4*)a.in[I_LN1B] + lane + 64 * j); }
    for (int m = gw; m < MT; m += NGW) {
        f32x4* row = (f32x4*)(a.out + (size_t)m * DM) + lane;
        f32x4 v[4]; float s = 0.f;
#pragma unroll
        for (int j = 0; j < 4; ++j) { v[j] = row[64 * j]; s += (v[j].x + v[j].y) + (v[j].z + v[j].w); }
        const float mean = wave_sum(s) * (1.f / DM); float s2 = 0.f;
#pragma unroll
        for (int j = 0; j < 4; ++j) { v[j] = v[j] - mean; s2 += (v[j].x * v[j].x + v[j].y * v[j].y) + (v[j].z * v[j].z + v[j].w * v[j].w); }
        const float rstd = 1.f / sqrtf(wave_sum(s2) * (1.f / DM) + LN_EPS);
        u32x2* o8 = (u32x2*)(HB + (size_t)m * DM) + lane;
#pragma unroll
        for (int j = 0; j < 4; ++j) { const f32x4 y = v[j] * rstd * gv[j] + bv[j]; row[64 * j] = y; u32x2 w; w.x = pk2(y.x, y.y); w.y = pk2(y.z, y.w); o8[64 * j] = w; }
    }
}

__device__ __forceinline__ unsigned fkey(float f) { const unsigned u = __float_as_uint(f); return (u & 0x80000000u) ? ~u : (u | 0x80000000u); }
__device__ __forceinline__ float funkey(unsigned k) { const unsigned u = (k & 0x80000000u) ? (k & 0x7fffffffu) : ~k; return __uint_as_float(u); }
__device__ __forceinline__ void cex(unsigned& hi_, unsigned& lo_) { const unsigned x = hi_, y = lo_; hi_ = x > y ? x : y; lo_ = x > y ? y : x; }
__device__ __forceinline__ void sort16_desc(unsigned (&v)[16]) {
#pragma unroll
    for (int k = 2; k <= 16; k <<= 1)
#pragma unroll
        for (int j = k >> 1; j > 0; j >>= 1)
#pragma unroll
            for (int i = 0; i < 16; ++i) { const int l = i ^ j; if (l > i) { if ((i & k) == 0) cex(v[i], v[l]); else cex(v[l], v[i]); } }
}
__device__ __forceinline__ void merge16_desc(unsigned (&v)[16]) {
#pragma unroll
    for (int j = 8; j > 0; j >>= 1)
#pragma unroll
        for (int i = 0; i < 16; ++i) { const int l = i ^ j; if (l > i) cex(v[i], v[l]); }
}
__device__ __forceinline__ void top16_of_two(unsigned (&a_)[16], const unsigned (&b_)[16]) {
#pragma unroll
    for (int i = 0; i < 16; ++i) a_[i] = a_[i] > b_[15 - i] ? a_[i] : b_[15 - i];
    merge16_desc(a_);
}
__device__ __forceinline__ void lane_top16(const f32x16 (&acc)[4], int hi, unsigned (&res)[16]) {
    unsigned g[16];
#pragma unroll
    for (int kt = 0; kt < 4; ++kt) {
#pragma unroll
        for (int r = 0; r < 16; ++r) g[r] = (fkey(acc[kt][r]) & ~127u) | (unsigned)(32 * kt + crow(r, hi));
        sort16_desc(g);
        if (kt == 0) {
#pragma unroll
            for (int r = 0; r < 16; ++r) res[r] = g[r];
        } else top16_of_two(res, g);
    }
}
constexpr int TK_KEYS = 0, TK_KS = 272, TK_LUT = 2 * 128 * TK_KS;
__device__ __forceinline__ void topk_phase(const Args& a, LAS unsigned char* lds, int tid, int lane, int wave) {
    unsigned char* ws = a.ws;
    const bf16_t* KEYS = (const bf16_t*)(ws + WS_KEYS); const bf16_t* QY = (const bf16_t*)(ws + WS_Q);
    int* IDX = (int*)(ws + WS_IDX); float* GW = (float*)(ws + WS_G);
    for (int i = tid; i < 2 * 128 * 16; i += 512) { const int row = i >> 4, ch = i & 15; *(LAS u32x4*)(lds + TK_KEYS + row * TK_KS + ch * 16) = *(const u32x4*)(KEYS + (size_t)row * 128 + ch * 8); }
    __syncthreads();
    const int r32 = lane & 31, hi = lane >> 5;
    LAS unsigned* lut = (LAS unsigned*)(lds + TK_LUT) + (wave * 64 + lane) * 33;
    const int gw = blockIdx.x * 8 + wave, NGW = gridDim.x * 8;
    for (int task = gw; task < MT * 8 / 32; task += NGW) {
        const size_t R = (size_t)task * 32 + r32;
        unsigned L[2][16];
#pragma unroll
        for (int p = 0; p < 2; ++p) {
            bf16x8 qf[8];
#pragma unroll
            for (int c = 0; c < 8; ++c) qf[c] = *(const bf16x8*)(QY + R * 256 + p * 128 + 16 * c + 8 * hi);
            f32x16 acc[4];
#pragma unroll
            for (int kt = 0; kt < 4; ++kt) { f32x16 s = {};
#pragma unroll
                for (int c = 0; c < 8; ++c) { const bf16x8 kf = *(const LAS bf16x8*)(lds + TK_KEYS + (p * 128 + 32 * kt + r32) * TK_KS + (16 * c + 8 * hi) * 2); s = __builtin_amdgcn_mfma_f32_32x32x16_bf16(kf, qf[c], s, 0, 0, 0); }
                acc[kt] = s; }
            lane_top16(acc, hi, L[p]);
        }
        unsigned mine[16], recv[16];
#pragma unroll
        for (int i = 0; i < 16; ++i) { const unsigned send = hi ? L[0][i] : L[1][i]; recv[i] = __shfl_xor(send, 32); mine[i] = hi ? L[1][i] : L[0][i]; }
        top16_of_two(mine, recv);
        unsigned P[16], Qk[16];
#pragma unroll
        for (int i = 0; i < 16; ++i) { P[i] = mine[i]; Qk[i] = __shfl_xor(mine[i], 32); }
#pragma unroll
        for (int i = 0; i < 16; ++i) { lut[i] = hi ? Qk[i] : P[i]; lut[16 + i] = hi ? P[i] : Qk[i]; }
        float pv[16], qv[16];
#pragma unroll
        for (int i = 0; i < 16; ++i) { pv[i] = funkey(P[i] & ~127u); qv[i] = funkey(Qk[i] & ~127u); }
        unsigned c0[16], c1[16];
        {
            int cnt = 0;
#pragma unroll
            for (int x = 0; x < 4; ++x)
#pragma unroll
                for (int y = x; y < 16; ++y) {
                    if ((x + 1) * (y + 1) <= 16) {
                        const float s = pv[x] + qv[y];
                        unsigned key = (fkey(s) & ~255u) | (hi ? (unsigned)(y * 16 + x) : (unsigned)(x * 16 + y));
                        if (x == y && hi) key = 0u;
                        if (cnt < 16) c0[cnt] = key; else c1[cnt - 16] = key;
                        ++cnt;
                    }
                }
#pragma unroll
            for (int i = 11; i < 16; ++i) c1[i] = 0u;
        }
        sort16_desc(c0); sort16_desc(c1); top16_of_two(c0, c1);
#pragma unroll
        for (int i = 0; i < 16; ++i) c1[i] = __shfl_xor(c0[i], 32);
        top16_of_two(c0, c1);
        asm volatile("s_waitcnt lgkmcnt(0)" ::: "memory");
        float top[16]; int eidx[16]; float mxv = -INFINITY;
#pragma unroll
        for (int w = 0; w < 16; ++w) { const unsigned pay = c0[w] & 255u; const unsigned k1 = lut[pay >> 4], k2 = lut[16 + (pay & 15u)];
            top[w] = funkey(k1 & ~127u) + funkey(k2 & ~127u); eidx[w] = (int)((k1 & 127u) * 128u + (k2 & 127u)); mxv = fmaxf(mxv, top[w]); }
        float se = 0.f;
#pragma unroll
        for (int w = 0; w < 16; ++w) { top[w] = __expf(top[w] - mxv); se += top[w]; }
        const float inv = 1.f / se;
        if (hi == 0) {
#pragma unroll
            for (int w = 0; w < 16; w += 4) { *(int4*)(IDX + R * 16 + w) = make_int4(eidx[w], eidx[w + 1], eidx[w + 2], eidx[w + 3]);
                *(f32x4*)(GW + R * 16 + w) = (f32x4){top[w] * inv, top[w + 1] * inv, top[w + 2] * inv, top[w + 3] * inv}; }
        }
        asm volatile("s_waitcnt lgkmcnt(0)" ::: "memory");
    }
}

constexpr int GA_PART = 0, GA_RED = 8 * 1024 * 4;
__device__ __forceinline__ float dot8(const u32x4 u, const float (&x)[8]) {
    return bflo(u.x) * x[0] + bfhi(u.x) * x[1] + bflo(u.y) * x[2] + bfhi(u.y) * x[3] + bflo(u.z) * x[4] + bfhi(u.z) * x[5] + bflo(u.w) * x[6] + bfhi(u.w) * x[7];
}
__device__ __forceinline__ void fma8(float (&acc)[8], const u32x4 v, float w) {
    acc[0] += w * bflo(v.x); acc[1] += w * bfhi(v.x); acc[2] += w * bflo(v.y); acc[3] += w * bfhi(v.y); acc[4] += w * bflo(v.z); acc[5] += w * bfhi(v.z); acc[6] += w * bflo(v.w); acc[7] += w * bfhi(v.w);
}
__device__ __forceinline__ void gather_phase(const Args& a, LAS unsigned char* lds, int tid, int lane, int wave) {
    unsigned char* ws = a.ws;
    const bf16_t* UT = (const bf16_t*)(ws + WS_UT); const bf16_t* VT = (const bf16_t*)(ws + WS_VT);
    const int* IDX = (const int*)(ws + WS_IDX); const float* GW = (const float*)(ws + WS_G);
    LAS float* part = (LAS float*)(lds + GA_PART); LAS float* red = (LAS float*)(lds + GA_RED);
    const f32x2 g2 = *((const f32x2*)a.in[I_LN2G] + tid), b2 = *((const f32x2*)a.in[I_LN2B] + tid);
    for (int tok = blockIdx.x; tok < MT; tok += gridDim.x) {
        float* hrow = a.out + (size_t)tok * DM;
        const size_t R = (size_t)tok * 8 + wave;
        const int myidx = IDX[R * 16 + (lane & 15)]; const float myg = GW[R * 16 + (lane & 15)];
        float xa[8], xb[8];
        { const f32x4 t0 = *(const f32x4*)(hrow + lane * 8), t1 = *(const f32x4*)(hrow + lane * 8 + 4), t2 = *(const f32x4*)(hrow + 512 + lane * 8), t3 = *(const f32x4*)(hrow + 512 + lane * 8 + 4);
          xa[0] = t0.x; xa[1] = t0.y; xa[2] = t0.z; xa[3] = t0.w; xa[4] = t1.x; xa[5] = t1.y; xa[6] = t1.z; xa[7] = t1.w;
          xb[0] = t2.x; xb[1] = t2.y; xb[2] = t2.z; xb[3] = t2.w; xb[4] = t3.x; xb[5] = t3.y; xb[6] = t3.z; xb[7] = t3.w; }
        float pd[16];
#pragma unroll
        for (int k = 0; k < 16; ++k) { const int e = __builtin_amdgcn_readlane(myidx, k); const bf16_t* ur = UT + (size_t)e * DM;
            const u32x4 ua = *(const u32x4*)(ur + lane * 8), ub = *(const u32x4*)(ur + 512 + lane * 8); pd[k] = dot8(ua, xa) + dot8(ub, xb); }
        float q8[8], q4[4], q2[2], q1;
#pragma unroll
        for (int i = 0; i < 8; ++i) { const bool up = lane & 1; const float send = up ? pd[i] : pd[i + 8], keep = up ? pd[i + 8] : pd[i]; q8[i] = keep + __shfl_xor(send, 1); }
#pragma unroll
        for (int i = 0; i < 4; ++i) { const bool up = lane & 2; const float send = up ? q8[i] : q8[i + 4], keep = up ? q8[i + 4] : q8[i]; q4[i] = keep + __shfl_xor(send, 2); }
#pragma unroll
        for (int i = 0; i < 2; ++i) { const bool up = lane & 4; const float send = up ? q4[i] : q4[i + 2], keep = up ? q4[i + 2] : q4[i]; q2[i] = keep + __shfl_xor(send, 4); }
        { const bool up = lane & 8; const float send = up ? q2[0] : q2[1], keep = up ? q2[1] : q2[0]; q1 = keep + __shfl_xor(send, 8); }
        q1 += __shfl_xor(q1, 16); q1 += __shfl_xor(q1, 32);
        const int kmap = ((lane & 1) << 3) | ((lane & 2) << 1) | ((lane & 4) >> 1) | ((lane & 8) >> 3);
        const float wgt = __shfl(myg, kmap) * gelu_tanh(q1);
        float oa[8], ob[8];
#pragma unroll
        for (int i = 0; i < 8; ++i) { oa[i] = 0.f; ob[i] = 0.f; }
#pragma unroll
        for (int k = 0; k < 16; ++k) { const int e = __builtin_amdgcn_readlane(myidx, k); const bf16_t* vr = VT + (size_t)e * DM;
            const int src = ((k & 1) << 3) | ((k & 2) << 1) | ((k & 4) >> 1) | ((k & 8) >> 3);
            const float wk = __uint_as_float(__builtin_amdgcn_readlane(__float_as_uint(wgt), src));
            const u32x4 va = *(const u32x4*)(vr + lane * 8), vb = *(const u32x4*)(vr + 512 + lane * 8); fma8(oa, va, wk); fma8(ob, vb, wk); }
        LAS float* pw = part + wave * 1024;
        *(LAS f32x4*)(pw + lane * 8) = (f32x4){oa[0], oa[1], oa[2], oa[3]}; *(LAS f32x4*)(pw + lane * 8 + 4) = (f32x4){oa[4], oa[5], oa[6], oa[7]};
        *(LAS f32x4*)(pw + 512 + lane * 8) = (f32x4){ob[0], ob[1], ob[2], ob[3]}; *(LAS f32x4*)(pw + 512 + lane * 8 + 4) = (f32x4){ob[4], ob[5], ob[6], ob[7]};
        __syncthreads();
        const f32x2 hv = *((const f32x2*)hrow + tid);
        float v0 = DN_ALPHA * hv.x, v1 = DN_ALPHA * hv.y;
#pragma unroll
        for (int w = 0; w < 8; ++w) { const f32x2 p = *(const LAS f32x2*)(part + w * 1024 + 2 * tid); v0 += p.x; v1 += p.y; }
        float s = wave_sum(v0 + v1);
        if (lane == 0) red[wave] = s;
        __syncthreads();
        float tot = 0.f;
#pragma unroll
        for (int w = 0; w < 8; ++w) tot += red[w];
        const float mean = tot * (1.f / DM);
        const float d0 = v0 - mean, d1 = v1 - mean;
        float s2 = wave_sum(d0 * d0 + d1 * d1);
        if (lane == 0) red[8 + wave] = s2;
        __syncthreads();
        float tot2 = 0.f;
#pragma unroll
        for (int w = 0; w < 8; ++w) tot2 += red[8 + w];
        const float rstd = 1.f / sqrtf(tot2 * (1.f / DM) + LN_EPS);
        *((f32x2*)hrow + tid) = (f32x2){d0 * rstd * g2.x + b2.x, d1 * rstd * g2.y + b2.y};
    }
}

constexpr int NPH = 10;
__global__ void __launch_bounds__(512, 2) fox_peer_fwd(Args a) {
    extern __shared__ __attribute__((aligned(16))) unsigned char lds_raw[];
    LAS unsigned char* lds = (LAS unsigned char*)lds_raw;
    cg::grid_group grid = cg::this_grid();
    const int tid = threadIdx.x, lane = tid & 63, wave = __builtin_amdgcn_readfirstlane(tid >> 6);
    const int G = gridDim.x;
    unsigned char* ws = a.ws;
    const int lo = a.ph_lo, hi_ = a.ph_hi;
#ifndef PHMASK
#define PHMASK 0x3ff
#endif
#define IN(k) (((PHMASK >> (k)) & 1) && lo <= (k) && (k) < hi_)
#define SEAM(k) do { if (IN(k) && IN((k) + 1)) grid.sync(); } while (0)

    if (IN(0)) { p0_prologue(a, lds, tid, lane, wave); }
    SEAM(0);
    if (IN(1)) {
        pg8::Gemm g{(const bf16_t*)(ws + WS_XB), (const bf16_t*)(ws + WS_WIN), MT, NIN, DM}; pg8::StaticOrder S; S.init(MT, NIN, G, (int)blockIdx.x);
        Epi1 E{a.out, ws};
        pg8::gemm_phase<Epi1, pg8::StaticOrder, true, true>(lds, g, S, E);
    }
    SEAM(1);
    if (IN(2)) {
        for (int t = blockIdx.x; t < NBATCH * NSEGP; t += G) rnn_tile<false>(a, lds, t, tid, lane, wave);
        for (int u = blockIdx.x; u < DBATCH * NH; u += G) attn_sample_unit(a, lds, u >> 3, u & 7, tid, lane, wave);
        for (int v = blockIdx.x; v < 256; v += G) {
            const int bh = v >> 2, s = v & 3;
#pragma unroll 1
            for (int i = 0; i < 4; ++i) { const int qb = (i == 0) ? s : (i == 1) ? 7 - s : (i == 2) ? 8 + s : 15 - s; attn_prompt_unit(a, lds, bh >> 3, bh & 7, qb, tid, lane, wave); __syncthreads(); }
        }
    }
    SEAM(2);
    if (IN(3)) { for (int t = blockIdx.x; t < NBATCH * NSEGP + DBATCH; t += G) rnn_tile<true>(a, lds, t, tid, lane, wave); }
    SEAM(3);
    if (IN(4)) {
        { pg8::Gemm g{(const bf16_t*)(ws + WS_Q), (const bf16_t*)(ws + WS_WA), MT, DM, DA}; pg8::StaticOrder S; S.init(MT, DM, G, (int)blockIdx.x);
          EpiUp<0> E{(const bf16_t*)(ws + WS_SA), (bf16_t*)(ws + WS_K)}; pg8::gemm_phase<EpiUp<0>, pg8::StaticOrder, true, true>(lds, g, S, E); }
        { pg8::Gemm g{(const bf16_t*)(ws + WS_GG), (const bf16_t*)(ws + WS_WR), MT, DM, DR}; pg8::StaticOrder S; S.init(MT, DM, G, (int)blockIdx.x);
          EpiUp<1> E{(const bf16_t*)(ws + WS_SR), (bf16_t*)(ws + WS_K)}; pg8::gemm_phase<EpiUp<1>, pg8::StaticOrder, true, true>(lds, g, S, E); }
    }
    SEAM(4);
    if (IN(5)) {
        pg8::Gemm g{(const bf16_t*)(ws + WS_K), (const bf16_t*)(ws + WS_WO), MT, DM, DM}; pg8::StaticOrder S; S.init(MT, DM, G, (int)blockIdx.x);
        EpiOut E{a.in[I_XP], a.in[I_XS], a.out}; pg8::gemm_phase<EpiOut, pg8::StaticOrder, true, true>(lds, g, S, E);
    }
    SEAM(5);
    if (IN(6)) { ln1_phase(a, lane, wave); }
    SEAM(6);
    if (IN(7)) {
        pg8::Gemm g{(const bf16_t*)(ws + WS_XB), (const bf16_t*)(ws + WS_WQ), MT, NQ, DM}; pg8::StaticOrder S; S.init(MT, NQ, G, (int)blockIdx.x);
        EpiQy E{(bf16_t*)(ws + WS_Q)}; pg8::gemm_phase<EpiQy, pg8::StaticOrder, true, true>(lds, g, S, E);
    }
    SEAM(7);
    if (IN(8)) { topk_phase(a, lds, tid, lane, wave); }
    SEAM(8);
    if (IN(9)) { gather_phase(a, lds, tid, lane, wave); }
#undef IN
#undef SEAM
}

#ifndef N_LAUNCHES
#define N_LAUNCHES 1
#endif
extern "C" void kernel_launch(void* const* d_in, const int* in_sizes, int n_in, void* d_out, int out_size, void* d_ws, size_t ws_size, hipStream_t stream) {
    static int grid = 0;
    if (grid == 0) {
        if (n_in != 28 || (size_t)out_size != OUT_TOTAL || ws_size < WS_END) { fprintf(stderr, "kernel_launch: unexpected problem: n_in %d out %d ws %zu\n", n_in, out_size, ws_size); grid = -1; return; }
        int dev = 0, cus = 0, per_cu = 0;
        hipGetDevice(&dev); hipDeviceGetAttribute(&cus, hipDeviceAttributeMultiprocessorCount, dev);
        if (hipFuncSetAttribute((const void*)fox_peer_fwd, hipFuncAttributeMaxDynamicSharedMemorySize, LDS_BYTES) != hipSuccess) { fprintf(stderr, "kernel_launch: hipFuncSetAttribute failed\n"); grid = -1; return; }
        if (hipOccupancyMaxActiveBlocksPerMultiprocessor(&per_cu, (const void*)fox_peer_fwd, 512, LDS_BYTES) != hipSuccess || per_cu < 1) { fprintf(stderr, "kernel_launch: occupancy query gave %d\n", per_cu); per_cu = 1; }
        (void)hipGetLastError();
        grid = cus * (per_cu < 1 ? 1 : per_cu);
    }
    if (grid < 0) return;
    Args a{};
    for (int i = 0; i < 28; ++i) a.in[i] = (const float*)d_in[i];
    a.out = (float*)d_out; a.ws = (unsigned char*)d_ws;
#if N_LAUNCHES == 1
    a.ph_lo = 0; a.ph_hi = NPH;
    void* args[] = {&a};
    hipError_t e = hipLaunchCooperativeKernel((const void*)fox_peer_fwd, dim3(grid), dim3(512), args, LDS_BYTES, stream);
    if (e != hipSuccess) fprintf(stderr, "cooperative launch failed: %s (grid %d)\n", hipGetErrorString(e), grid);
#else
    for (int p = 0; p < NPH; ++p) { a.ph_lo = p; a.ph_hi = p + 1; hipLaunchKernelGGL(fox_peer_fwd, dim3(grid), dim3(512), LDS_BYTES, stream, a); }
#endif
}
```

```cpp
#include <hip/hip_runtime.h>
#include <hip/hip_cooperative_groups.h>
#include <cstdio>
#include <cstdint>
namespace cg = cooperative_groups;
namespace pg8 {
#define PG8_LAS __attribute__((address_space(3)))
typedef unsigned short bf16_t;
typedef short bf16x8 __attribute__((ext_vector_type(8)));
typedef float f32x4 __attribute__((ext_vector_type(4)));
typedef unsigned u32x4 __attribute__((ext_vector_type(4)));
constexpr int BM = 256, BK = 64, HALF = 128, HTB = HALF * BK * 2  , STAGE_BYTES = 8 * HTB, NXCD = 8, WGM = 8;

__host__ __device__ __forceinline__ int lds_byte(int r, int c) { const int st = (r >> 4) * 2 + (c >> 5), rr = r & 15, cc = c & 31, ob = rr * 64 + cc * 2; return st * 1024 + (ob ^ (((ob >> 9) & 1) << 5)); }
__host__ __device__ __forceinline__ void stage_rc(int b, int& R, int& C) { const int st = b / 1024, sb = b % 1024, swz = sb ^ (((sb >> 9) & 1) << 5); R = (st >> 1) * 16 + swz / 64; C = (st & 1) * 32 + (swz % 64) / 2; }
__host__ __device__ __forceinline__ int perm32(int rho) { const int n = rho >> 4, i = rho & 15; return 8 * (i >> 2) + 4 * n + (i & 3); }

struct Unit { int pm, pn; };
struct Gemm { const bf16_t* A; const bf16_t* Bt; int M, N, K; };

struct StaticOrder {
    int nM, nN, nwg, G, c;
    __host__ __device__ void init(int M, int N, int G_, int c_) { nM = M / BM; nN = N / BM; nwg = nM * nN; G = G_; c = c_; }
    __host__ __device__ bool next(int i, Unit& u) const {
        const long L = (long)i * G + c; if (L >= nwg) return false;
        int wgid = (int)L; { const int q = nwg / NXCD, r = nwg % NXCD, xcd = wgid % NXCD, off = wgid / NXCD; wgid = (xcd < r ? xcd * (q + 1) : r * (q + 1) + (xcd - r) * q) + off; }
        const int nig = WGM * nN, gid = wgid / nig, fm = gid * WGM, gsz = (nM - fm) < WGM ? (nM - fm) : WGM;
        u.pm = fm + ((wgid % nig) % gsz); u.pn = (wgid % nig) / gsz; return true;
    }
    __device__ __forceinline__ void a_ready(const Unit&) const {}
    __device__ __forceinline__ void done(const Unit&) const {}
};

__device__ __forceinline__ unsigned cvt_pk_bf16(float lo, float hi) { unsigned r; asm volatile("v_cvt_pk_bf16_f32 %0, %1, %2" : "=v"(r) : "v"(lo), "v"(hi)); return r; }
template <class Epi, class Sched, bool ALIGN_EPI = false, bool SP2 = false>
__device__ __forceinline__ void gemm_phase(PG8_LAS unsigned char* lds, const Gemm g, const Sched& S, const Epi& E) {
    const int tid = threadIdx.x, wid = __builtin_amdgcn_readfirstlane(tid >> 6), lane = tid & 63, wr = wid >> 2, wc = wid & 3, fr = lane & 15, fq = lane >> 4;
    const int K = g.K, nt = K / BK;
    unsigned voffA[2], voffB[2];
#pragma unroll
    for (int i = 0; i < 2; ++i) { int R, C; stage_rc(tid * 16 + i * 8192, R, C); const int Rb = Epi::PERM ? ((R & ~31) + perm32(R & 31)) : R;
        voffA[i] = (unsigned)(R * K + C) * 2u; voffB[i] = (unsigned)(Rb * K + C) * 2u; }
    const size_t kstep = (size_t)(BK * 2);
    const size_t hstep = (size_t)HALF * K * 2;
    const size_t tstep = 2 * hstep;
    const unsigned ldsw = (unsigned)wid * 1024u;
    const int aoff = lds_byte(wr * 64 + fr, fq * 8), boff = lds_byte(wc * 32 + fr, fq * 8);
#define PG8_SA(b, h) (((b) * 2 + (h)) * HTB)
#define PG8_SB(b, h) ((4 + (b) * 2 + (h)) * HTB)
#define PG8_STAGE(bufoff, gbase, voff) do { _Pragma("unroll") for (int _i = 0; _i < 2; ++_i) \
        __builtin_amdgcn_global_load_lds((const unsigned*)((const char*)(gbase) + (voff)[_i]), (PG8_LAS unsigned*)(lds + (bufoff) + ldsw + _i * 8192), 16, 0, 0); } while (0)
#define PG8_LDA(dst, b, h) do { _Pragma("unroll") for (int m = 0; m < 4; ++m) _Pragma("unroll") for (int k = 0; k < 2; ++k) dst[m][k] = *(const PG8_LAS bf16x8*)(lds + PG8_SA(b, h) + aoff + m * 2048 + k * 1024); } while (0)
#define PG8_LDB(dst, b, h) do { _Pragma("unroll") for (int n = 0; n < 2; ++n) _Pragma("unroll") for (int k = 0; k < 2; ++k) dst[n][k] = *(const PG8_LAS bf16x8*)(lds + PG8_SB(b, h) + boff + n * 2048 + k * 1024); } while (0)
#define PG8_MMA(ai, bj, At, Bt) do { __builtin_amdgcn_s_setprio(1); _Pragma("unroll") for (int m = 0; m < 4; ++m) _Pragma("unroll") for (int n = 0; n < 2; ++n) _Pragma("unroll") for (int k = 0; k < 2; ++k) \
        acc[ai][bj][m][n] = __builtin_amdgcn_mfma_f32_16x16x32_bf16(Bt[n][k], At[m][k], acc[ai][bj][m][n], 0, 0, 0); __builtin_amdgcn_s_setprio(0); } while (0)
#define PG8_WAIT_V(n) asm volatile("s_waitcnt vmcnt(" #n ")" ::: "memory")
#define PG8_WAIT_L(n) asm volatile("s_waitcnt lgkmcnt(" #n ")" ::: "memory")
#define PG8_BAR __builtin_amdgcn_s_barrier()
#define PG8_SCHED __builtin_amdgcn_sched_barrier(0)
    Unit cur, nxt; int ui = 0;
    if (!S.next(0, cur)) return;
    f32x4 acc[2][2][4][2];
#pragma unroll
    for (int a = 0; a < 2; ++a)
#pragma unroll
        for (int b = 0; b < 2; ++b)
#pragma unroll
            for (int m = 0; m < 4; ++m)
#pragma unroll
                for (int n = 0; n < 2; ++n) acc[a][b][m][n] = (f32x4){0.f, 0.f, 0.f, 0.f};
    bf16x8 At[4][2], B0[2][2], B1[2][2];
    const char* cA = (const char*)g.A + (size_t)cur.pm * tstep; const char* cB = (const char*)g.Bt + (size_t)cur.pn * tstep;
    S.a_ready(cur);
    if constexpr (SP2) {
        PG8_STAGE(PG8_SB(0, 0), cB, voffB); PG8_STAGE(PG8_SB(0, 1), cB + hstep, voffB); PG8_STAGE(PG8_SA(0, 0), cA, voffA); PG8_STAGE(PG8_SA(0, 1), cA + hstep, voffA);
        if (wr == 1) PG8_BAR;
        PG8_WAIT_V(2); PG8_BAR;
        PG8_STAGE(PG8_SB(1, 0), cB + kstep, voffB); PG8_STAGE(PG8_SA(1, 0), cA + kstep, voffA); PG8_STAGE(PG8_SB(1, 1), cB + hstep + kstep, voffB);
        PG8_WAIT_V(6); PG8_BAR;
    } else {
        PG8_STAGE(PG8_SB(0, 0), cB, voffB); PG8_STAGE(PG8_SA(0, 0), cA, voffA); PG8_STAGE(PG8_SB(0, 1), cB + hstep, voffB); PG8_STAGE(PG8_SA(0, 1), cA + hstep, voffA);
        if (wr == 1) PG8_BAR;
        PG8_WAIT_V(4); PG8_BAR;
        PG8_STAGE(PG8_SB(1, 0), cB + kstep, voffB); PG8_STAGE(PG8_SA(1, 0), cA + kstep, voffA); PG8_STAGE(PG8_SB(1, 1), cB + hstep + kstep, voffB);
        PG8_WAIT_V(6); PG8_BAR;
    }
    for (;;) {
        const bool has_next = S.next(ui + 1, nxt);
        const char* nA = has_next ? (const char*)g.A + (size_t)nxt.pm * tstep : cA; const char* nB = has_next ? (const char*)g.Bt + (size_t)nxt.pn * tstep : cB;
        for (int t = 0; t < nt; t += 2) {
            const bool last = (t == nt - 2);
            const char* a1 = cA + (size_t)(t + 1) * kstep;
            const char* a2 = last ? nA : cA + (size_t)(t + 2) * kstep; const char* b2 = last ? nB : cB + (size_t)(t + 2) * kstep;
            const char* a3 = a2 + kstep; const char* b3 = b2 + kstep;
            if (last && has_next) S.a_ready(nxt);
            if constexpr (SP2) {
            PG8_LDB(B0, 0, 0); PG8_LDB(B1, 0, 1); PG8_SCHED; PG8_LDA(At, 0, 0); PG8_STAGE(PG8_SA(1, 1), a1 + hstep, voffA);
            PG8_WAIT_V(8); PG8_WAIT_L(0); PG8_BAR; PG8_MMA(0, 0, At, B0); PG8_MMA(0, 1, At, B1); PG8_BAR; PG8_SCHED;
            PG8_LDA(At, 0, 1); PG8_STAGE(PG8_SB(0, 0), b2, voffB); PG8_STAGE(PG8_SB(0, 1), b2 + hstep, voffB); PG8_STAGE(PG8_SA(0, 0), a2, voffA);
            PG8_WAIT_V(8); PG8_WAIT_L(0); PG8_BAR; PG8_MMA(1, 0, At, B0); PG8_MMA(1, 1, At, B1); PG8_BAR; PG8_SCHED;
            PG8_LDB(B0, 1, 0); PG8_LDB(B1, 1, 1); PG8_SCHED; PG8_LDA(At, 1, 0); PG8_STAGE(PG8_SA(0, 1), a2 + hstep, voffA);
            PG8_WAIT_V(8); PG8_WAIT_L(0); PG8_BAR; PG8_MMA(0, 0, At, B0); PG8_MMA(0, 1, At, B1); PG8_BAR; PG8_SCHED;
            PG8_LDA(At, 1, 1); PG8_STAGE(PG8_SB(1, 0), b3, voffB); PG8_STAGE(PG8_SB(1, 1), b3 + hstep, voffB); PG8_STAGE(PG8_SA(1, 0), a3, voffA);
            PG8_WAIT_V(8); PG8_WAIT_L(0); PG8_BAR; PG8_MMA(1, 0, At, B0); PG8_MMA(1, 1, At, B1); PG8_BAR; PG8_SCHED;
            } else {
            PG8_LDB(B0, 0, 0); PG8_SCHED; PG8_LDA(At, 0, 0); PG8_STAGE(PG8_SA(1, 1), a1 + hstep, voffA);
            PG8_WAIT_L(8); PG8_BAR; PG8_WAIT_L(0); PG8_MMA(0, 0, At, B0); PG8_BAR; PG8_SCHED;
            PG8_LDB(B1, 0, 1); PG8_STAGE(PG8_SB(0, 0), b2, voffB);
            PG8_BAR; PG8_WAIT_L(0); PG8_MMA(0, 1, At, B1); PG8_BAR;
            PG8_LDA(At, 0, 1); PG8_STAGE(PG8_SA(0, 0), a2, voffA);
            PG8_BAR; PG8_WAIT_L(0); PG8_MMA(1, 0, At, B0); PG8_BAR; PG8_SCHED;
            PG8_STAGE(PG8_SB(0, 1), b2 + hstep, voffB);
            PG8_WAIT_V(6); PG8_BAR; PG8_MMA(1, 1, At, B1); PG8_BAR;
            PG8_LDB(B0, 1, 0); PG8_SCHED; PG8_LDA(At, 1, 0); PG8_STAGE(PG8_SA(0, 1), a2 + hstep, voffA);
            PG8_WAIT_L(8); PG8_BAR; PG8_WAIT_L(0); PG8_MMA(0, 0, At, B0); PG8_BAR; PG8_SCHED;
            PG8_LDB(B1, 1, 1); PG8_STAGE(PG8_SB(1, 0), b3, voffB);
            PG8_BAR; PG8_WAIT_L(0); PG8_MMA(0, 1, At, B1); PG8_BAR;
            PG8_LDA(At, 1, 1); PG8_STAGE(PG8_SA(1, 0), a3, voffA);
            PG8_BAR; PG8_WAIT_L(0); PG8_MMA(1, 0, At, B0); PG8_BAR; PG8_SCHED;
            PG8_STAGE(PG8_SB(1, 1), b3 + hstep, voffB);
            PG8_WAIT_V(6); PG8_BAR; PG8_MMA(1, 1, At, B1); PG8_BAR;
            }
        }
        if constexpr (ALIGN_EPI) { if (wr == 0) PG8_BAR; }
        if constexpr (!Epi::AFTER_DRAIN) { E(acc, cur, wr, wc, fr, fq); S.done(cur); }
        if (!has_next) break;
#pragma unroll
        for (int a = 0; a < 2; ++a)
#pragma unroll
            for (int b = 0; b < 2; ++b)
#pragma unroll
                for (int m = 0; m < 4; ++m)
#pragma unroll
                    for (int n = 0; n < 2; ++n) acc[a][b][m][n] = (f32x4){0.f, 0.f, 0.f, 0.f};
        cur = nxt; cA = nA; cB = nB; ++ui;
        if constexpr (ALIGN_EPI) { if (wr == 1) PG8_BAR; }
    }
    PG8_WAIT_V(0);
    if constexpr (!ALIGN_EPI) { if (wr == 0) PG8_BAR; }
    PG8_BAR;
    if constexpr (Epi::AFTER_DRAIN) { E.fused(acc, cur, wr, wc, fr, fq, lds, wid, lane); S.done(cur); }
#undef PG8_SA
#undef PG8_SB
#undef PG8_STAGE
#undef PG8_LDA
#undef PG8_LDB
#undef PG8_MMA
#undef PG8_WAIT_V
#undef PG8_WAIT_L
#undef PG8_BAR
#undef PG8_SCHED
}
}

#define LAS __attribute__((address_space(3)))
typedef unsigned short bf16_t;
typedef short bf16x8 __attribute__((ext_vector_type(8)));
typedef float f32x4 __attribute__((ext_vector_type(4)));
typedef float f32x2 __attribute__((ext_vector_type(2)));
typedef float f32x16 __attribute__((ext_vector_type(16)));
typedef unsigned u32x4 __attribute__((ext_vector_type(4)));
typedef unsigned u32x2 __attribute__((ext_vector_type(2)));
typedef short v4i16_t __attribute__((ext_vector_type(4)));
typedef __bf16 bf16x2_t __attribute__((ext_vector_type(2)));

constexpr int DM = 1024, NBATCH = 8, SEQ = 4096, DBATCH = 16, DSEQ = 32, PAST = 1024, NH = 8, HD = 64, DA = 512, DR = 512;
constexpr int MP = NBATCH * SEQ, MS = DBATCH * DSEQ, MT = MP + MS;
constexpr int DIN = 4616, NIN = 4608, NE = 16384, NQ = 2048;
constexpr float LN_EPS = 1e-5f, DN_ALPHA = 1.189207115002721f, LOG2E = 1.4426950408889634f;
constexpr int NSEGP = SEQ / 64;
constexpr size_t OFF_KP = 34078720, OFF_VP = 50855936, OFF_FP = 67633152, OFF_CP = 67895296, OFF_RP = 67907584,
                 OFF_KS = 67911680, OFF_VS = 68173824, OFF_FS = 68435968, OFF_CS = 68440064, OFF_RS = 68464640, OUT_TOTAL = 68472832;
constexpr size_t MiB = 1u << 20;
constexpr size_t WS_XB = 0;
constexpr size_t WS_WIN = 65 * MiB;
constexpr size_t WS_WA = 74 * MiB, WS_WR = 75 * MiB, WS_WO = 76 * MiB, WS_WQ = 78 * MiB;
constexpr size_t WS_KEYS = 82 * MiB, WS_RGA = 82 * MiB + 65536, WS_RGX = 82 * MiB + 131072;
constexpr size_t WS_UT = 83 * MiB, WS_VT = 115 * MiB;
constexpr size_t QKV_BYTES = (size_t)MT * 512 * 2;
constexpr size_t WS_Q = 147 * MiB, WS_K = WS_Q + QKV_BYTES, WS_V = WS_K + QKV_BYTES, WS_XR = WS_V + QKV_BYTES;
constexpr size_t WS_GG = 277 * MiB;
constexpr size_t WS_SA = WS_GG + QKV_BYTES, WS_SR = WS_SA + 2 * QKV_BYTES;
constexpr size_t WS_LC = 440 * MiB, WS_SCH = 442 * MiB, WS_RA = 442 * MiB + 65536, WS_RB = WS_RA + MiB;
constexpr size_t WS_IDX = 445 * MiB, WS_G = 462 * MiB, WS_CTL = 479 * MiB, WS_END = 480 * MiB;
static_assert(WS_XR + QKV_BYTES <= WS_GG && WS_SR + 2 * QKV_BYTES <= WS_LC && WS_IDX + (size_t)MT * 8 * 16 * 4 <= WS_G && WS_G + (size_t)MT * 8 * 16 * 4 <= WS_END, "ws map");

constexpr int LDS_BYTES = 147456;

struct Args { const float* in[28]; float* out; unsigned char* ws; int ph_lo, ph_hi; };
enum { I_XP = 0, I_XS, I_CK, I_CV, I_CLF, I_SCONV, I_SRNN, I_WIN, I_BF, I_CONVW, I_CONVB, I_RGA, I_BRGA, I_RGX, I_BRGX, I_LAM, I_WAUP, I_WRUP, I_WOUT, I_LN1G, I_LN1B,
       I_WQ, I_K1, I_K2, I_PU, I_PV, I_LN2G, I_LN2B };

__device__ __forceinline__ unsigned pk2(float lo, float hi) { f32x2 v = {lo, hi}; bf16x2_t b = __builtin_convertvector(v, bf16x2_t); return __builtin_bit_cast(unsigned, b); }
__device__ __forceinline__ float bflo(unsigned u) { return __uint_as_float(u << 16); }
__device__ __forceinline__ float bfhi(unsigned u) { return __uint_as_float(u & 0xffff0000u); }
__device__ __forceinline__ float bf1(bf16_t b) { return __uint_as_float((unsigned)b << 16); }
__device__ __forceinline__ float sigmoidf_(float x) { return __builtin_amdgcn_rcpf(1.f + __expf(-x)); }
__device__ __forceinline__ float gelu_tanh(float x) { const float u = 0.7978845608028654f * (x + 0.044715f * x * x * x); return x * sigmoidf_(2.f * u); }
__device__ __forceinline__ const float* xrow_ptr(const Args& a, int m) { return m < MP ? a.in[I_XP] + (size_t)m * DM : a.in[I_XS] + (size_t)(m - MP) * DM; }
__device__ __forceinline__ float wave_sum(float v) {
#pragma unroll
    for (int o = 1; o < 64; o <<= 1) v += __shfl_xor(v, o);
    return v;
}
__device__ __forceinline__ int crow(int r, int hi) { return (r & 3) + 8 * (r >> 2) + 4 * hi; }

__device__ __forceinline__ void transpose_item(const float* W, int ldw, bf16_t* WT, int ldk, LAS float* scr, int k0, int n0src, int n0dst, int lane) {
#pragma unroll 8
    for (int i = 0; i < 32; ++i) { const int kk = 2 * i + (lane >> 5); scr[kk * 33 + (lane & 31)] = W[(size_t)(k0 + kk) * ldw + n0src + (lane & 31)]; }
    asm volatile("s_waitcnt lgkmcnt(0)" ::: "memory");
    const int c = lane & 7;
#pragma unroll
    for (int j = 0; j < 4; ++j) { const int n = (lane >> 3) + 8 * j; const LAS float* s = scr + (8 * c) * 33 + n;
        u32x4 o; o.x = pk2(s[0 * 33], s[1 * 33]); o.y = pk2(s[2 * 33], s[3 * 33]); o.z = pk2(s[4 * 33], s[5 * 33]); o.w = pk2(s[6 * 33], s[7 * 33]);
        *(u32x4*)(WT + (size_t)(n0dst + n) * ldk + k0 + 8 * c) = o; }
    asm volatile("s_waitcnt lgkmcnt(0)" ::: "memory");
}
__device__ __forceinline__ void cvt8(const float* src, bf16_t* dst, size_t i) {
    const f32x4 v0 = *(const f32x4*)(src + i * 8), v1 = *(const f32x4*)(src + i * 8 + 4);
    u32x4 o; o.x = pk2(v0.x, v0.y); o.y = pk2(v0.z, v0.w); o.z = pk2(v1.x, v1.y); o.w = pk2(v1.z, v1.w);
    *(u32x4*)(dst + i * 8) = o;
}
__device__ __forceinline__ void p0_prologue(const Args& a, LAS unsigned char* lds, int tid, int lane, int wave) {
    unsigned char* ws = a.ws;
    const int G = gridDim.x, gw = blockIdx.x * 8 + wave, NGW = G * 8;
    {
        LAS float* scr = (LAS float*)(lds + wave * 8448);
        constexpr int I0 = 16 * 144, I1 = 8 * 32, I2 = 8 * 32, I3 = 16 * 32, I4 = 16 * 64, I5 = 16, I6 = 16, NIT = I0 + I1 + I2 + I3 + I4 + I5 + I6;
        for (int it = gw; it < NIT; it += NGW) {
            int r = it;
            if (r < I0) { const int kb = r / 144, nb = r % 144, n0 = 32 * nb; transpose_item(a.in[I_WIN], DIN, (bf16_t*)(ws + WS_WIN), 1024, scr, 64 * kb, n0 + (n0 >= 1536 ? 8 : 0), n0, lane); continue; } r -= I0;
            if (r < I1) { transpose_item(a.in[I_WAUP], 1024, (bf16_t*)(ws + WS_WA), 512, scr, 64 * (r / 32), 32 * (r % 32), 32 * (r % 32), lane); continue; } r -= I1;
            if (r < I2) { transpose_item(a.in[I_WRUP], 1024, (bf16_t*)(ws + WS_WR), 512, scr, 64 * (r / 32), 32 * (r % 32), 32 * (r % 32), lane); continue; } r -= I2;
            if (r < I3) { transpose_item(a.in[I_WOUT], 1024, (bf16_t*)(ws + WS_WO), 1024, scr, 64 * (r / 32), 32 * (r % 32), 32 * (r % 32), lane); continue; } r -= I3;
            if (r < I4) { transpose_item(a.in[I_WQ], 2048, (bf16_t*)(ws + WS_WQ), 1024, scr, 64 * (r / 64), 32 * (r % 64), 32 * (r % 64), lane); continue; } r -= I4;
            if (r < I5) { const int n = r >> 1, nb = r & 1; transpose_item(a.in[I_RGA] + n * 4096, 64, (bf16_t*)(ws + WS_RGA) + n * 4096, 64, scr, 0, 32 * nb, 32 * nb, lane); continue; } r -= I5;
            { const int n = r >> 1, nb = r & 1; transpose_item(a.in[I_RGX] + n * 4096, 64, (bf16_t*)(ws + WS_RGX) + n * 4096, 64, scr, 0, 32 * nb, 32 * nb, lane); }
        }
    }
    {
        constexpr size_t N0 = (size_t)MP * DM / 8, N1 = (size_t)MS * DM / 8, N2 = (size_t)NE * DM / 8, N3 = N2, N4 = 2048, N5 = 2048, NTOT = N0 + N1 + N2 + N3 + N4 + N5;
        const size_t stride = (size_t)G * 512;
        for (size_t i = (size_t)blockIdx.x * 512 + tid; i < NTOT; i += stride) {
            size_t r = i;
            if (r < N0) { cvt8(a.in[I_XP], (bf16_t*)(ws + WS_XB), r); continue; } r -= N0;
            if (r < N1) { cvt8(a.in[I_XS], (bf16_t*)(ws + WS_XB) + (size_t)MP * DM, r); continue; } r -= N1;
            if (r < N2) { cvt8(a.in[I_PU], (bf16_t*)(ws + WS_UT), r); continue; } r -= N2;
            if (r < N3) { cvt8(a.in[I_PV], (bf16_t*)(ws + WS_VT), r); continue; } r -= N3;
            if (r < N4) { cvt8(a.in[I_K1], (bf16_t*)(ws + WS_KEYS), r); continue; } r -= N4;
            cvt8(a.in[I_K2], (bf16_t*)(ws + WS_KEYS) + 16384, r);
        }
    }
    __syncthreads();
    {
        LAS float* wf = (LAS float*)lds;
        LAS float* lfs = (LAS float*)(lds + 32768);
        const float* win = a.in[I_WIN];
        bool staged = false;
        for (int u = blockIdx.x; u < MT / 64; u += G) {
            if (!staged) { for (int i = tid; i < 8192; i += 512) wf[i] = win[(size_t)(i >> 3) * DIN + 1536 + (i & 7)]; staged = true; __syncthreads(); }
            const int m0 = 64 * u;
            for (int i = 0; i < 8; ++i) {
                const int m = m0 + 8 * wave + i; const float* xr = xrow_ptr(a, m);
                float acc[8];
#pragma unroll
                for (int h = 0; h < 8; ++h) acc[h] = 0.f;
#pragma unroll 4
                for (int kk = 0; kk < 16; ++kk) { const int k = lane + 64 * kk; const float xv = xr[k]; const f32x4 w0 = *(const LAS f32x4*)(wf + k * 8), w1 = *(const LAS f32x4*)(wf + k * 8 + 4);
                    acc[0] += xv * w0.x; acc[1] += xv * w0.y; acc[2] += xv * w0.z; acc[3] += xv * w0.w; acc[4] += xv * w1.x; acc[5] += xv * w1.y; acc[6] += xv * w1.z; acc[7] += xv * w1.w; }
                float z = 0.f;
#pragma unroll
                for (int h = 0; h < 8; ++h) { const float s = wave_sum(acc[h]); if (lane == h) z = s; }
                if (lane < 8) { z += a.in[I_BF][lane]; const float lf = fminf(z, 0.f) - log1pf(__expf(-fabsf(z)));
                    if (m < MP) a.out[OFF_FP + (size_t)m * 8 + lane] = lf; else a.out[OFF_FS + (size_t)(m - MP) * 8 + lane] = lf;
                    lfs[(8 * wave + i) * 8 + lane] = lf; }
            }
            __syncthreads();
            if (u < MP / 64) { float v = lfs[lane * 8 + wave];
#pragma unroll
                for (int o = 1; o < 64; o <<= 1) { const float t = __shfl_up(v, o); if (lane >= o) v += t; }
                ((float*)(ws + WS_LC))[(size_t)(m0 + lane) * 8 + wave] = v;
                if (lane == 63) ((float*)(ws + WS_SCH))[u * 8 + wave] = v; }
            __syncthreads();
        }
    }
}

struct Epi1 {
    static constexpr bool PERM = false, AFTER_DRAIN = false;
    float* out; unsigned char* ws;
    __device__ __forceinline__ void operator()(const f32x4 (&acc)[2][2][4][2], const pg8::Unit& u, int wr, int wc, int fr, int fq) const {
        const int pn = u.pn; const int rbase = u.pm * 256 + wr * 64 + fr; const int cbase = pn * 256 + wc * 32 + 4 * fq;
        const bool samp = u.pm >= MP / 256;
#pragma unroll
        for (int ai = 0; ai < 2; ++ai)
#pragma unroll
            for (int m = 0; m < 4; ++m) {
                const int row = rbase + ai * 128 + m * 16;
#pragma unroll
                for (int bj = 0; bj < 2; ++bj)
#pragma unroll
                    for (int n = 0; n < 2; ++n) {
                        const int col = cbase + bj * 128 + n * 16; const f32x4 v = acc[ai][bj][m][n];
                        if (pn < 2) { u32x2 w; w.x = pk2(v.x, v.y); w.y = pk2(v.z, v.w); *(u32x2*)((bf16_t*)(ws + WS_Q) + (size_t)row * 512 + col) = w; }
                        else if (pn < 6) { const int isv = pn >= 4; const int c = col - (isv ? 1024 : 512);
                            u32x2 w; w.x = pk2(v.x, v.y); w.y = pk2(v.z, v.w); *(u32x2*)((bf16_t*)(ws + (isv ? WS_V : WS_K)) + (size_t)row * 512 + c) = w;
                            float* o = samp ? out + (isv ? OFF_VS : OFF_KS) + (size_t)(row - MP) * 512 + c : out + (isv ? OFF_VP : OFF_KP) + (size_t)row * 512 + c;
                            *(f32x4*)o = v; }
                        else if (pn < 8) { const int c = col - 1536;
                            u32x2 w; w.x = pk2(v.x, v.y); w.y = pk2(v.z, v.w); *(u32x2*)((bf16_t*)(ws + WS_XR) + (size_t)row * 512 + c) = w;
                            if (!samp) { const int t = row & (SEQ - 1); if (t >= SEQ - 3) *(f32x4*)(out + OFF_CP + (size_t)((row >> 12) * 3 + (t - (SEQ - 3))) * 512 + c) = v; }
                            else { const int rs = row - MP, t = rs & 31; if (t >= DSEQ - 3) *(f32x4*)(out + OFF_CS + (size_t)((rs >> 5) * 3 + (t - (DSEQ - 3))) * 512 + c) = v; } }
                        else if (pn < 10) { const int c = col - 2048;
                            u32x2 w; w.x = pk2(gelu_tanh(v.x), gelu_tanh(v.y)); w.y = pk2(gelu_tanh(v.z), gelu_tanh(v.w)); *(u32x2*)((bf16_t*)(ws + WS_GG) + (size_t)row * 512 + c) = w; }
                        else { const int isr = pn >= 14; const int c = col - (isr ? 3584 : 2560);
                            u32x2 w; w.x = pk2(sigmoidf_(v.x), sigmoidf_(v.y)); w.y = pk2(sigmoidf_(v.z), sigmoidf_(v.w)); *(u32x2*)((bf16_t*)(ws + (isr ? WS_SR : WS_SA)) + (size_t)row * 1024 + c) = w; }
                    }
            }
    }
};
template <int SECOND> struct EpiUp {
    static constexpr bool PERM = false, AFTER_DRAIN = false;
    const bf16_t* gate; bf16_t* mg;
    __device__ __forceinline__ void operator()(const f32x4 (&acc)[2][2][4][2], const pg8::Unit& u, int wr, int wc, int fr, int fq) const {
        const int rbase = u.pm * 256 + wr * 64 + fr; const int cbase = u.pn * 256 + wc * 32 + 4 * fq;
#pragma unroll
        for (int ai = 0; ai < 2; ++ai)
#pragma unroll
            for (int m = 0; m < 4; ++m) {
                const size_t ro = (size_t)(rbase + ai * 128 + m * 16) * 1024;
#pragma unroll
                for (int bj = 0; bj < 2; ++bj)
#pragma unroll
                    for (int n = 0; n < 2; ++n) {
                        const size_t o = ro + cbase + bj * 128 + n * 16; const f32x4 v = acc[ai][bj][m][n];
                        const u32x2 g = *(const u32x2*)(gate + o);
                        float r0 = bflo(g.x) * v.x, r1 = bfhi(g.x) * v.y, r2 = bflo(g.y) * v.z, r3 = bfhi(g.y) * v.w;
                        if (SECOND) { const u32x2 p = *(const u32x2*)(mg + o); r0 += bflo(p.x); r1 += bfhi(p.x); r2 += bflo(p.y); r3 += bfhi(p.y); }
                        u32x2 w; w.x = pk2(r0, r1); w.y = pk2(r2, r3); *(u32x2*)(mg + o) = w;
                    }
            }
    }
};
struct EpiOut {
    static constexpr bool PERM = false, AFTER_DRAIN = false;
    const float* xp; const float* xs; float* y;
    __device__ __forceinline__ void operator()(const f32x4 (&acc)[2][2][4][2], const pg8::Unit& u, int wr, int wc, int fr, int fq) const {
        const int rbase = u.pm * 256 + wr * 64 + fr; const int cbase = u.pn * 256 + wc * 32 + 4 * fq;
#pragma unroll
        for (int ai = 0; ai < 2; ++ai)
#pragma unroll
            for (int m = 0; m < 4; ++m) {
                const int row = rbase + ai * 128 + m * 16; const float* xr = row < MP ? xp + (size_t)row * DM : xs + (size_t)(row - MP) * DM;
#pragma unroll
                for (int bj = 0; bj < 2; ++bj)
#pragma unroll
                    for (int n = 0; n < 2; ++n) { const int col = cbase + bj * 128 + n * 16; const f32x4 xv = *(const f32x4*)(xr + col);
                        *(f32x4*)(y + (size_t)row * DM + col) = xv * DN_ALPHA + acc[ai][bj][m][n]; }
            }
    }
};
struct EpiQy {
    static constexpr bool PERM = true, AFTER_DRAIN = false;
    bf16_t* O;
    __device__ __forceinline__ void operator()(const f32x4 (&acc)[2][2][4][2], const pg8::Unit& u, int wr, int wc, int fr, int fq) const {
        const int row0 = u.pm * 256 + wr * 64 + fr; const int col0 = u.pn * 256 + wc * 32 + 8 * fq;
#pragma unroll
        for (int ai = 0; ai < 2; ++ai)
#pragma unroll
            for (int m = 0; m < 4; ++m) { bf16_t* rowp = O + (size_t)(row0 + ai * 128 + m * 16) * NQ + col0;
#pragma unroll
                for (int bj = 0; bj < 2; ++bj) { const f32x4 v0 = acc[ai][bj][m][0], v1 = acc[ai][bj][m][1];
                    u32x4 w; w.x = pk2(v0[0], v0[1]); w.y = pk2(v0[2], v0[3]); w.z = pk2(v1[0], v1[1]); w.w = pk2(v1[2], v1[3]);
                    *(u32x4*)(rowp + bj * 128) = w; } }
    }
};
#define GAS __attribute__((address_space(1)))
#define XB_TMO      128
#define XB_XCNT(j)  (256  + 64 * (j))
#define XB_XSUB(j)  (1280 + 64 * (j))
#define XB_XGEN(j)  (2304 + 64 * (j))
#define XB_TOP      3328
#define XB_TOPGEN   3392
#define XCD_BAR_WORDS 3456
#define XB_SPIN_CAP (1u << 18)

__device__ __forceinline__ unsigned xb_ld(unsigned* p)              { return __hip_atomic_load(p, __ATOMIC_RELAXED, __HIP_MEMORY_SCOPE_AGENT); }
__device__ __forceinline__ unsigned xb_add(unsigned* p, unsigned v) { return __hip_atomic_fetch_add(p, v, __ATOMIC_RELAXED, __HIP_MEMORY_SCOPE_AGENT); }
__device__ __forceinline__ unsigned xb_xcc_id() { return (unsigned)__builtin_amdgcn_s_getreg((3 << 11) | 20) & 0xFu; }
#define XB_SPIN(cond, bar) do { unsigned _sp = 0; while (cond) { __builtin_amdgcn_s_sleep(1); \
    if ((++_sp & 255u) == 0u) { if (xb_ld(&(bar)[XB_TMO])) break; if (_sp > XB_SPIN_CAP) { atomicAdd(&(bar)[XB_TMO], 1u); break; } } } } while (0)

struct XcdBarrier {
    unsigned* bar; unsigned x;
    volatile LAS unsigned* st;
};

__device__ __forceinline__ XcdBarrier xcd_barrier_post(unsigned* bar, volatile LAS unsigned* st) {
    XcdBarrier b; b.bar = bar; b.x = xb_xcc_id(); b.st = st;
    if (threadIdx.x == 0) (void)xb_add(&bar[XB_XCNT(b.x)], 1u);
    return b;
}
__device__ __forceinline__ void xcd_barrier_complete(unsigned* bar, unsigned x, unsigned& nloc, unsigned& nx) {
    const unsigned G = gridDim.x * gridDim.y * gridDim.z;
    unsigned sum, cnt, mine, sp = 0u;
    for (;;) {
        sum = 0u; cnt = 0u; mine = 0u;
#pragma unroll
        for (unsigned j = 0; j < 16; ++j) { const unsigned c = xb_ld(&bar[XB_XCNT(j)]); sum += c; cnt += (c > 0u) ? 1u : 0u; mine = (j == x) ? c : mine; }
        if (sum == G) break;
        __builtin_amdgcn_s_sleep(1);
        if ((++sp & 255u) == 0u) { if (xb_ld(&bar[XB_TMO])) break; if (sp > XB_SPIN_CAP) { atomicAdd(&bar[XB_TMO], 1u); break; } }
    }
    nloc = mine > 0u ? mine : 1u; nx = cnt > 0u ? cnt : 1u;
}

__device__ __forceinline__ void xcd_barrier(const XcdBarrier& b) {
    asm volatile("s_waitcnt vmcnt(0)" ::: "memory");
    __syncthreads();
    if (threadIdx.x == 0) {
        unsigned* bar = b.bar;
        __builtin_amdgcn_s_waitcnt(0);
        unsigned nloc = b.st[0], nx = b.st[1];
        if (nloc == 0u) { xcd_barrier_complete(bar, b.x, nloc, nx); b.st[0] = nloc; b.st[1] = nx; }
        const unsigned old = xb_add(&bar[XB_XSUB(b.x)], 1u);
        const unsigned gen = old / nloc;
        if (old + 1u == (gen + 1u) * nloc) {
            __builtin_amdgcn_fence(__ATOMIC_RELEASE, "agent");
            asm volatile("s_waitcnt vmcnt(0)" ::: "memory");
            const unsigned og = xb_add(&bar[XB_TOP], 1u);
            const unsigned tg = og / nx;
            if (og + 1u == (tg + 1u) * nx) xb_add(&bar[XB_TOPGEN], 1u);
            else XB_SPIN(xb_ld(&bar[XB_TOPGEN]) == tg, bar);
            __builtin_amdgcn_fence(__ATOMIC_ACQUIRE, "agent");
            xb_add(&bar[XB_XGEN(b.x)], 1u);
            asm volatile("s_waitcnt vmcnt(0)" ::: "memory");
        } else {
            XB_SPIN(xb_ld(&bar[XB_XGEN(b.x)]) == gen, bar);
            __builtin_amdgcn_fence(__ATOMIC_ACQUIRE, "agent");
            asm volatile("s_waitcnt vmcnt(0)" ::: "memory");
        }
    }
    __syncthreads();
}

template <int NK>
__device__ __forceinline__ void attn_tile(float& mrun, float& lrun, f32x16 (&o)[2], const bf16x8 (&qf)[4], const LAS unsigned char* Kt, const LAS unsigned char* Vt, int vimg_stride,
                                          const LAS float* cb, bool masked, int qrel, int lane) {
    const int r32 = lane & 31, hi = lane >> 5;
    f32x16 p[NK];
#pragma unroll
    for (int ks = 0; ks < NK; ++ks) {
        f32x16 acc = {};
#pragma unroll
        for (int c = 0; c < 4; ++c) { const bf16x8 kf = *(const LAS bf16x8*)(Kt + (32 * ks + r32) * 144 + (16 * c + 8 * hi) * 2); acc = __builtin_amdgcn_mfma_f32_32x32x16_bf16(kf, qf[c], acc, 0, 0, 0); }
        p[ks] = acc;
    }
    constexpr float SC = 0.125f * LOG2E;
    float mx = -INFINITY;
#pragma unroll
    for (int ks = 0; ks < NK; ++ks)
#pragma unroll
        for (int g = 0; g < 4; ++g) { const f32x4 cbv = *(const LAS f32x4*)(cb + 32 * ks + 8 * g + 4 * hi);
#pragma unroll
            for (int i = 0; i < 4; ++i) { float t = p[ks][4 * g + i] * SC + cbv[i]; if (masked && (32 * ks + 8 * g + 4 * hi + i > qrel)) t = -INFINITY; p[ks][4 * g + i] = t; mx = fmaxf(mx, t); } }
    mx = fmaxf(mx, __shfl_xor(mx, 32));
    const float mnew = fmaxf(mrun, mx);
    const float alpha = __builtin_amdgcn_exp2f(mrun - mnew);
    mrun = mnew;
    float rs = 0.f;
#pragma unroll
    for (int ks = 0; ks < NK; ++ks)
#pragma unroll
        for (int r = 0; r < 16; ++r) { const float e = __builtin_amdgcn_exp2f(p[ks][r] - mnew); p[ks][r] = e; rs += e; }
    lrun = lrun * alpha + rs;
#pragma unroll
    for (int dh = 0; dh < 2; ++dh)
#pragma unroll
        for (int r = 0; r < 16; ++r) o[dh][r] *= alpha;
    const int li = lane & 15, cg2 = (lane >> 4) & 1;
    const int voff = (4 * hi + (li >> 2)) * 64 + (16 * cg2 + 4 * (li & 3)) * 2;
#pragma unroll
    for (int kc = 0; kc < 2 * NK; ++kc) {
        const int ks = kc >> 1, rb = 8 * (kc & 1);
        u32x4 pw; pw.x = pk2(p[ks][rb + 0], p[ks][rb + 1]); pw.y = pk2(p[ks][rb + 2], p[ks][rb + 3]); pw.z = pk2(p[ks][rb + 4], p[ks][rb + 5]); pw.w = pk2(p[ks][rb + 6], p[ks][rb + 7]);
        const bf16x8 pb = __builtin_bit_cast(bf16x8, pw);
#pragma unroll
        for (int dh = 0; dh < 2; ++dh) {
            const LAS unsigned char* vp = Vt + dh * vimg_stride + (16 * kc) * 64 + voff;
            const v4i16_t lo = __builtin_amdgcn_ds_read_tr16_b64_v4i16((LAS v4i16_t*)vp);
            const v4i16_t hh = __builtin_amdgcn_ds_read_tr16_b64_v4i16((LAS v4i16_t*)(vp + 8 * 64));
            const bf16x8 vf = {lo[0], lo[1], lo[2], lo[3], hh[0], hh[1], hh[2], hh[3]};
            o[dh] = __builtin_amdgcn_mfma_f32_32x32x16_bf16(vf, pb, o[dh], 0, 0, 0);
        }
    }
}

constexpr int AT_KB = 64 * 144, AT_VB = 8192, AT_K0 = 0, AT_V0 = 2 * AT_KB, AT_CB = AT_V0 + 2 * AT_VB;
__device__ __forceinline__ void attn_prompt_unit(const Args& a, LAS unsigned char* lds, int b, int h, int qb, int tid, int lane, int wave) {
    unsigned char* ws = a.ws;
    const bf16_t* Q = (const bf16_t*)(ws + WS_Q); const bf16_t* K = (const bf16_t*)(ws + WS_K); const bf16_t* V = (const bf16_t*)(ws + WS_V); bf16_t* O = (bf16_t*)(ws + WS_Q);
    const float* LC = (const float*)(ws + WS_LC); const float* SCH = (const float*)(ws + WS_SCH);
    const int r32 = lane & 31, hi = lane >> 5;
    const size_t rowb = (size_t)b * SEQ;
    const int q0 = qb * 256 + wave * 32;
    bf16x8 qf[4];
#pragma unroll
    for (int c = 0; c < 4; ++c) qf[c] = *(const bf16x8*)(Q + (rowb + q0 + r32) * 512 + h * 64 + 16 * c + 8 * hi);
    const int NT = (qb + 1) * 4;
    const int skey = tid >> 3, sch = tid & 7;
    const bf16_t* ksrc = K + (rowb + skey) * 512 + h * 64 + sch * 8; const bf16_t* vsrc = V + (rowb + skey) * 512 + h * 64 + sch * 8;
    const int kdst = skey * 144 + sch * 16, vdst = (sch >> 2) * 4096 + skey * 64 + (sch & 3) * 16;
    float off = 0.f;
    u32x4 kreg = *(const u32x4*)ksrc, vreg = *(const u32x4*)vsrc; float creg = 0.f;
    if (tid < 64) { creg = -(off + LC[(rowb + tid) * 8 + h]) * LOG2E; off += SCH[(b * NSEGP + 0) * 8 + h]; }
    *(LAS u32x4*)(lds + AT_K0 + kdst) = kreg; *(LAS u32x4*)(lds + AT_V0 + vdst) = vreg; if (tid < 64) ((LAS float*)(lds + AT_CB))[tid] = creg;
    __syncthreads();
    float mrun = -INFINITY, lrun = 0.f; f32x16 o[2]; o[0] = f32x16{}; o[1] = f32x16{};
    for (int j = 0; j < NT; ++j) {
        const int buf = j & 1;
        if (j + 1 < NT) { kreg = *(const u32x4*)(ksrc + (size_t)(j + 1) * 64 * 512); vreg = *(const u32x4*)(vsrc + (size_t)(j + 1) * 64 * 512);
            if (tid < 64) { creg = -(off + LC[(rowb + 64 * (j + 1) + tid) * 8 + h]) * LOG2E; off += SCH[(b * NSEGP + j + 1) * 8 + h]; } }
        if (64 * j <= q0 + 31) {
            const bool masked = (64 * j + 63 > q0);
            attn_tile<2>(mrun, lrun, o, qf, lds + AT_K0 + buf * AT_KB, lds + AT_V0 + buf * AT_VB, 4096, (const LAS float*)(lds + AT_CB) + buf * 64, masked, q0 + r32 - 64 * j, lane);
        }
        if (j + 1 < NT) { *(LAS u32x4*)(lds + AT_K0 + (buf ^ 1) * AT_KB + kdst) = kreg; *(LAS u32x4*)(lds + AT_V0 + (buf ^ 1) * AT_VB + vdst) = vreg; if (tid < 64) ((LAS float*)(lds + AT_CB))[(buf ^ 1) * 64 + tid] = creg; }
        __syncthreads();
    }
    const float lt = lrun + __shfl_xor(lrun, 32); const float inv = 1.f / lt;
    bf16_t* orow = O + (rowb + q0 + r32) * 512 + h * 64;
#pragma unroll
    for (int dh = 0; dh < 2; ++dh)
#pragma unroll
        for (int g = 0; g < 4; ++g) { u32x2 w; w.x = pk2(o[dh][4 * g] * inv, o[dh][4 * g + 1] * inv); w.y = pk2(o[dh][4 * g + 2] * inv, o[dh][4 * g + 3] * inv);
            *(u32x2*)(orow + 32 * dh + 8 * g + 4 * hi) = w; }
}

constexpr int SA_WV = 4608 + 4096, SA_CB = 8 * SA_WV, SA_CMB = 0;
__device__ __forceinline__ void attn_sample_unit(const Args& a, LAS unsigned char* lds, int bs, int h, int tid, int lane, int wave) {
    unsigned char* ws = a.ws;
    const bf16_t* Q = (const bf16_t*)(ws + WS_Q); const bf16_t* Kn = (const bf16_t*)(ws + WS_K); const bf16_t* Vn = (const bf16_t*)(ws + WS_V); bf16_t* O = (bf16_t*)(ws + WS_Q);
    const int r32 = lane & 31, hi = lane >> 5;
    const size_t row0 = (size_t)MP + (size_t)bs * DSEQ;
    LAS float* cbs = (LAS float*)(lds + SA_CB);
    if (wave == 0) {
        float v[17]; float s = 0.f;
#pragma unroll
        for (int i = 0; i < 17; ++i) { const int k = lane * 17 + i; float x = 0.f;
            if (k < PAST) x = a.in[I_CLF][((size_t)bs * PAST + k) * 8 + h]; else if (k < PAST + DSEQ) x = a.out[OFF_FS + ((size_t)bs * DSEQ + (k - PAST)) * 8 + h];
            s += x; v[i] = s; }
        float inc = s;
#pragma unroll
        for (int o = 1; o < 64; o <<= 1) { const float t = __shfl_up(inc, o); if (lane >= o) inc += t; }
        const float excl = inc - s;
#pragma unroll
        for (int i = 0; i < 17; ++i) cbs[lane * 17 + i] = -(excl + v[i]) * LOG2E;
    }
    bf16x8 qf[4];
#pragma unroll
    for (int c = 0; c < 4; ++c) qf[c] = *(const bf16x8*)(Q + (row0 + r32) * 512 + h * 64 + 16 * c + 8 * hi);
    __syncthreads();
    LAS unsigned char* Kw = lds + wave * SA_WV; LAS unsigned char* Vw = Kw + 4608;
    float mrun = -INFINITY, lrun = 0.f; f32x16 o[2]; o[0] = f32x16{}; o[1] = f32x16{};
    for (int g = wave; g < 33; g += 8) {
        if (g < 32) {
            const float* kc = a.in[I_CK] + (((size_t)bs * PAST + 32 * g) * NH + h) * HD; const float* vc = a.in[I_CV] + (((size_t)bs * PAST + 32 * g) * NH + h) * HD;
#pragma unroll
            for (int i = 0; i < 8; ++i) { const int id = i * 64 + lane, key = id >> 4, part = id & 15;
                const f32x4 kv = *(const f32x4*)(kc + (size_t)key * NH * HD + part * 4), vv = *(const f32x4*)(vc + (size_t)key * NH * HD + part * 4);
                u32x2 kw; kw.x = pk2(kv.x, kv.y); kw.y = pk2(kv.z, kv.w); u32x2 vw; vw.x = pk2(vv.x, vv.y); vw.y = pk2(vv.z, vv.w);
                *(LAS u32x2*)(Kw + key * 144 + part * 8) = kw; *(LAS u32x2*)(Vw + (part >> 3) * 2048 + key * 64 + (part & 7) * 8) = vw; }
        } else {
#pragma unroll
            for (int i = 0; i < 4; ++i) { const int id = i * 64 + lane, key = id >> 3, ch = id & 7;
                const u32x4 kv = *(const u32x4*)(Kn + (row0 + key) * 512 + h * 64 + ch * 8), vv = *(const u32x4*)(Vn + (row0 + key) * 512 + h * 64 + ch * 8);
                *(LAS u32x4*)(Kw + key * 144 + ch * 16) = kv; *(LAS u32x4*)(Vw + (ch >> 2) * 2048 + key * 64 + (ch & 3) * 16) = vv; }
        }
        asm volatile("s_waitcnt lgkmcnt(0)" ::: "memory");
        attn_tile<1>(mrun, lrun, o, qf, Kw, Vw, 2048, cbs + 32 * g, g == 32, r32, lane);
        asm volatile("s_waitcnt lgkmcnt(0)" ::: "memory");
    }
    __syncthreads();
    LAS float* cm = (LAS float*)(lds + SA_CMB) + wave * 2112;
    const float lt = lrun + __shfl_xor(lrun, 32);
    if (hi == 0) { cm[r32] = mrun; cm[32 + r32] = lt; }
#pragma unroll
    for (int dh = 0; dh < 2; ++dh)
#pragma unroll
        for (int r = 0; r < 16; ++r) cm[64 + (32 * dh + crow(r, hi)) * 32 + r32] = o[dh][r];
    __syncthreads();
    {
        const int q = tid & 31, d0 = (tid >> 5) * 4;
        const LAS float* base = (const LAS float*)(lds + SA_CMB);
        float M = -INFINITY;
#pragma unroll
        for (int w = 0; w < 8; ++w) M = fmaxf(M, base[w * 2112 + q]);
        float L = 0.f, acc[4] = {0.f, 0.f, 0.f, 0.f};
#pragma unroll
        for (int w = 0; w < 8; ++w) { const float f = __builtin_amdgcn_exp2f(base[w * 2112 + q] - M); L += f * base[w * 2112 + 32 + q];
#pragma unroll
            for (int i = 0; i < 4; ++i) acc[i] += f * base[w * 2112 + 64 + (d0 + i) * 32 + q]; }
        const float inv = 1.f / L;
        u32x2 w; w.x = pk2(acc[0] * inv, acc[1] * inv); w.y = pk2(acc[2] * inv, acc[3] * inv);
        *(u32x2*)(O + (row0 + q) * 512 + h * 64 + d0) = w;
    }
    __syncthreads();
}

constexpr int RN_XC = 0, RN_XCS = 1040, RN_HIN = 64 * RN_XCS;
template <bool FINAL>
__device__ __forceinline__ void rnn_tile(const Args& a, LAS unsigned char* lds, int tile, int tid, int lane, int wave) {
    unsigned char* ws = a.ws;
    const bf16_t* XR = (const bf16_t*)(ws + WS_XR); bf16_t* GGRO = (bf16_t*)(ws + WS_GG);
    float* RA = (float*)(ws + WS_RA); float* RB = (float*)(ws + WS_RB);
    const bool samp = tile >= NBATCH * NSEGP;
    const int b = samp ? tile - NBATCH * NSEGP : tile / NSEGP, seg = samp ? 0 : tile % NSEGP;
    const size_t m0 = samp ? (size_t)MP + (size_t)b * DSEQ : (size_t)b * SEQ + (size_t)seg * 64;
    const int nrow = samp ? 32 : 64;
    for (int it = tid; it < nrow * 64; it += 512) {
        const int t = it >> 6, c0 = (it & 63) * 8;
        float acc[8];
        const f32x4 cb0 = *(const f32x4*)(a.in[I_CONVB] + c0), cb1 = *(const f32x4*)(a.in[I_CONVB] + c0 + 4);
        acc[0] = cb0.x; acc[1] = cb0.y; acc[2] = cb0.z; acc[3] = cb0.w; acc[4] = cb1.x; acc[5] = cb1.y; acc[6] = cb1.z; acc[7] = cb1.w;
#pragma unroll
        for (int w = 0; w < 4; ++w) {
            const int tt = (samp ? 0 : seg * 64) + t - 3 + w;
            float xv[8];
            if (tt >= 0) { const u32x4 x = *(const u32x4*)(XR + (m0 + t - 3 + w) * 512 + c0);
                xv[0] = bflo(x.x); xv[1] = bfhi(x.x); xv[2] = bflo(x.y); xv[3] = bfhi(x.y); xv[4] = bflo(x.z); xv[5] = bfhi(x.z); xv[6] = bflo(x.w); xv[7] = bfhi(x.w); }
            else if (samp) { const float* sc = a.in[I_SCONV] + ((size_t)b * 3 + (3 + tt)) * 512 + c0; const f32x4 s0 = *(const f32x4*)sc, s1 = *(const f32x4*)(sc + 4);
                xv[0] = s0.x; xv[1] = s0.y; xv[2] = s0.z; xv[3] = s0.w; xv[4] = s1.x; xv[5] = s1.y; xv[6] = s1.z; xv[7] = s1.w; }
            else {
#pragma unroll
                for (int i = 0; i < 8; ++i) xv[i] = 0.f; }
            const f32x4 w0 = *(const f32x4*)(a.in[I_CONVW] + w * 512 + c0), w1 = *(const f32x4*)(a.in[I_CONVW] + w * 512 + c0 + 4);
            acc[0] += xv[0] * w0.x; acc[1] += xv[1] * w0.y; acc[2] += xv[2] * w0.z; acc[3] += xv[3] * w0.w; acc[4] += xv[4] * w1.x; acc[5] += xv[5] * w1.y; acc[6] += xv[6] * w1.z; acc[7] += xv[7] * w1.w;
        }
        u32x4 o; o.x = pk2(acc[0], acc[1]); o.y = pk2(acc[2], acc[3]); o.z = pk2(acc[4], acc[5]); o.w = pk2(acc[6], acc[7]);
        *(LAS u32x4*)(lds + RN_XC + t * RN_XCS + c0 * 2) = o;
    }
    if (FINAL) {
        LAS float* hin = (LAS float*)(lds + RN_HIN);
        float hc;
        if (samp) hc = a.in[I_SRNN][(size_t)b * 512 + tid];
        else { hc = 0.f; const float* pa = RA + (size_t)(b * NSEGP) * 512 + tid; const float* pb = RB + (size_t)(b * NSEGP) * 512 + tid;
#pragma unroll 8
            for (int s = 0; s < seg; ++s) hc = pa[(size_t)s * 512] * hc + pb[(size_t)s * 512]; }
        hin[tid] = hc;
    }
    __syncthreads();
    const int r32 = lane & 31, hi = lane >> 5, n = wave;
    const bf16_t* WAt = (const bf16_t*)(ws + WS_RGA) + n * 4096; const bf16_t* WXt = (const bf16_t*)(ws + WS_RGX) + n * 4096;
    float carry[2], aprod[2];
#pragma unroll 1
    for (int jh = 0; jh < 2; ++jh) {
        const int ch = 64 * n + 32 * jh + r32;
        bf16x8 wa[4], wx[4];
#pragma unroll
        for (int c = 0; c < 4; ++c) { wa[c] = *(const bf16x8*)(WAt + (32 * jh + r32) * 64 + 16 * c + 8 * hi); wx[c] = *(const bf16x8*)(WXt + (32 * jh + r32) * 64 + 16 * c + 8 * hi); }
        const float ba = a.in[I_BRGA][ch], bx = a.in[I_BRGX][ch];
        const float lam = a.in[I_LAM][ch]; const float sp = fmaxf(-lam, 0.f) + log1pf(__expf(-fabsf(lam)));
        float cr = FINAL ? ((const LAS float*)(lds + RN_HIN))[ch] : 0.f; float ap = 1.f;
#pragma unroll 1
        for (int th = 0; th < (samp ? 1 : 2); ++th) {
            f32x16 ya = {}, yx = {};
#pragma unroll
            for (int c = 0; c < 4; ++c) { const bf16x8 af = *(const LAS bf16x8*)(lds + RN_XC + (32 * th + r32) * RN_XCS + (64 * n + 16 * c + 8 * hi) * 2);
                ya = __builtin_amdgcn_mfma_f32_32x32x16_bf16(af, wa[c], ya, 0, 0, 0); yx = __builtin_amdgcn_mfma_f32_32x32x16_bf16(af, wx[c], yx, 0, 0, 0); }
#pragma unroll
            for (int r = 0; r < 16; ++r) {
                const int t = 32 * th + crow(r, hi);
                const float xc = bf1(*(const LAS bf16_t*)(lds + RN_XC + t * RN_XCS + ch * 2));
                const float rg = sigmoidf_(ya[r] + ba), ig = sigmoidf_(yx[r] + bx);
                const float la = -8.f * rg * sp; const float av = __expf(la);
                const float mult = sqrtf(fmaxf(1.f - av * av, 0.f));
                ya[r] = av; yx[r] = mult * ig * xc;
            }
#pragma unroll
            for (int g = 0; g < 4; ++g) {
                float h0 = ya[4 * g] * cr + yx[4 * g], h1 = ya[4 * g + 1] * h0 + yx[4 * g + 1], h2 = ya[4 * g + 2] * h1 + yx[4 * g + 2], h3 = ya[4 * g + 3] * h2 + yx[4 * g + 3];
                const float rv = __shfl_xor(h3, 32);
                const float k0 = ya[4 * g] * rv + yx[4 * g], k1 = ya[4 * g + 1] * k0 + yx[4 * g + 1], k2 = ya[4 * g + 2] * k1 + yx[4 * g + 2], k3 = ya[4 * g + 3] * k2 + yx[4 * g + 3];
                ap *= (ya[4 * g] * ya[4 * g + 1]) * (ya[4 * g + 2] * ya[4 * g + 3]);
                if (hi) { h0 = k0; h1 = k1; h2 = k2; h3 = k3; }
                const float back = __shfl_xor(k3, 32);
                cr = hi ? k3 : back;
                if (FINAL) { yx[4 * g] = h0; yx[4 * g + 1] = h1; yx[4 * g + 2] = h2; yx[4 * g + 3] = h3; }
            }
            if (FINAL) {
#pragma unroll
                for (int r = 0; r < 16; ++r) { const int t = 32 * th + crow(r, hi); bf16_t* p = GGRO + (m0 + t) * 512 + ch; *p = (bf16_t)(pk2(yx[r] * bf1(*p), 0.f) & 0xffffu); }
            }
        }
        carry[jh] = cr; aprod[jh] = ap;
    }
#pragma unroll
    for (int jh = 0; jh < 2; ++jh) {
        const int ch = 64 * n + 32 * jh + r32;
        if (!FINAL) { const float ap = aprod[jh] * __shfl_xor(aprod[jh], 32); if (hi == 0) { RA[(size_t)tile * 512 + ch] = ap; RB[(size_t)tile * 512 + ch] = carry[jh]; } }
        else if (hi == 0) { if (samp) a.out[OFF_RS + (size_t)b * 512 + ch] = carry[jh]; else if (seg == NSEGP - 1) a.out[OFF_RP + (size_t)b * 512 + ch] = carry[jh]; }
    }
    __syncthreads();
}

__device__ __forceinline__ void ln1_phase(const Args& a, int lane, int wave) {
    const int gw = blockIdx.x * 8 + wave, NGW = gridDim.x * 8;
    bf16_t* HB = (bf16_t*)(a.ws + WS_XB);
    f32x4 gv[4], bv[4];
#pragma unroll
    for (int j = 0; j < 4; ++j) { gv[j] = *((const f32x4*)a.in[I_LN1G] + lane + 64 * j); bv[j] = *((const f32x4*)a.in[I_LN1B] + lane + 64 * j); }
    for (int m = gw; m < MT; m += NGW) {
        f32x4* row = (f32x4*)(a.out + (size_t)m * DM) + lane;
        f32x4 v[4]; float s = 0.f;
#pragma unroll
        for (int j = 0; j < 4; ++j) { v[j] = row[64 * j]; s += (v[j].x + v[j].y) + (v[j].z + v[j].w); }
        const float mean = wave_sum(s) * (1.f / DM); float s2 = 0.f;
#pragma unroll
        for (int j = 0; j < 4; ++j) { v[j] = v[j] - mean; s2 += (v[j].x * v[j].x + v[j].y * v[j].y) + (v[j].z * v[j].z + v[j].w * v[j].w); }
        const float rstd = 1.f / sqrtf(wave_sum(s2) * (1.f / DM) + LN_EPS);
        u32x2* o8 = (u32x2*)(HB + (size_t)m * DM) + lane;
#pragma unroll
        for (int j = 0; j < 4; ++j) { const f32x4 y = v[j] * rstd * gv[j] + bv[j]; row[64 * j] = y; u32x2 w; w.x = pk2(y.x, y.y); w.y = pk2(y.z, y.w); o8[64 * j] = w; }
    }
}

__device__ __forceinline__ unsigned fkey(float f) { const unsigned u = __float_as_uint(f); return (u & 0x80000000u) ? ~u : (u | 0x80000000u); }
__device__ __forceinline__ float funkey(unsigned k) { const unsigned u = (k & 0x80000000u) ? (k & 0x7fffffffu) : ~k; return __uint_as_float(u); }
__device__ __forceinline__ void cex(unsigned& hi_, unsigned& lo_) { const unsigned x = hi_, y = lo_; hi_ = x > y ? x : y; lo_ = x > y ? y : x; }
__device__ __forceinline__ void sort16_desc(unsigned (&v)[16]) {
#pragma unroll
    for (int k = 2; k <= 16; k <<= 1)
#pragma unroll
        for (int j = k >> 1; j > 0; j >>= 1)
#pragma unroll
            for (int i = 0; i < 16; ++i) { const int l = i ^ j; if (l > i) { if ((i & k) == 0) cex(v[i], v[l]); else cex(v[l], v[i]); } }
}
__device__ __forceinline__ void merge16_desc(unsigned (&v)[16]) {
#pragma unroll
    for (int j = 8; j > 0; j >>= 1)
#pragma unroll
        for (int i = 0; i < 16; ++i) { const int l = i ^ j; if (l > i) cex(v[i], v[l]); }
}
__device__ __forceinline__ void top16_of_two(unsigned (&a_)[16], const unsigned (&b_)[16]) {
#pragma unroll
    for (int i = 0; i < 16; ++i) a_[i] = a_[i] > b_[15 - i] ? a_[i] : b_[15 - i];
    merge16_desc(a_);
}
__device__ __forceinline__ void lane_top16(const f32x16 (&acc)[4], int hi, unsigned (&res)[16]) {
    unsigned g[16];
#pragma unroll
    for (int kt = 0; kt < 4; ++kt) {
#pragma unroll
        for (int r = 0; r < 16; ++r) g[r] = (fkey(acc[kt][r]) & ~127u) | (unsigned)(32 * kt + crow(r, 0));
        sort16_desc(g);
        if (kt == 0) {
#pragma unroll
            for (int r = 0; r < 16; ++r) res[r] = g[r];
        } else top16_of_two(res, g);
    }
#pragma unroll
    for (int r = 0; r < 16; ++r) res[r] |= (unsigned)(4 * hi);
}
constexpr int TK_KEYS = 0, TK_KS = 272, TK_LUT = 2 * 128 * TK_KS;
__device__ __forceinline__ void topk_phase(const Args& a, LAS unsigned char* lds, int tid, int lane, int wave) {
    unsigned char* ws = a.ws;
    const bf16_t* KEYS = (const bf16_t*)(ws + WS_KEYS); const bf16_t* QY = (const bf16_t*)(ws + WS_Q);
    int* IDX = (int*)(ws + WS_IDX); float* GW = (float*)(ws + WS_G);
    for (int i = tid; i < 2 * 128 * 16; i += 512) { const int row = i >> 4, ch = i & 15; *(LAS u32x4*)(lds + TK_KEYS + row * TK_KS + ch * 16) = *(const u32x4*)(KEYS + (size_t)row * 128 + ch * 8); }
    __syncthreads();
    const int r32 = lane & 31, hi = lane >> 5;
    LAS unsigned* lut = (LAS unsigned*)(lds + TK_LUT) + (wave * 64 + lane) * 33;
    const int gw = blockIdx.x * 8 + wave, NGW = gridDim.x * 8;
    for (int task = gw; task < MT * 8 / 32; task += NGW) {
        const size_t R = (size_t)task * 32 + r32;
        unsigned L[2][16];
#pragma unroll
        for (int p = 0; p < 2; ++p) {
            bf16x8 qf[8];
#pragma unroll
            for (int c = 0; c < 8; ++c) qf[c] = *(const bf16x8*)(QY + R * 256 + p * 128 + 16 * c + 8 * hi);
            f32x16 acc[4];
#pragma unroll
            for (int kt = 0; kt < 4; ++kt) { f32x16 s = {};
#pragma unroll
                for (int c = 0; c < 8; ++c) { const bf16x8 kf = *(const LAS bf16x8*)(lds + TK_KEYS + (p * 128 + 32 * kt + r32) * TK_KS + (16 * c + 8 * hi) * 2); s = __builtin_amdgcn_mfma_f32_32x32x16_bf16(kf, qf[c], s, 0, 0, 0); }
                acc[kt] = s; }
            lane_top16(acc, hi, L[p]);
        }
        unsigned mine[16], recv[16];
#pragma unroll
        for (int i = 0; i < 16; ++i) { const unsigned send = hi ? L[0][i] : L[1][i]; recv[i] = __shfl_xor(send, 32); mine[i] = hi ? L[1][i] : L[0][i]; }
        top16_of_two(mine, recv);
        unsigned P[16], Qk[16];
#pragma unroll
        for (int i = 0; i < 16; ++i) { P[i] = mine[i]; Qk[i] = __shfl_xor(mine[i], 32); }
#pragma unroll
        for (int i = 0; i < 16; ++i) { lut[i] = hi ? Qk[i] : P[i]; lut[16 + i] = hi ? P[i] : Qk[i]; }
        float pv[16], qv[16];
#pragma unroll
        for (int i = 0; i < 16; ++i) { pv[i] = funkey(P[i] & ~127u); qv[i] = funkey(Qk[i] & ~127u); }
        unsigned c0[16], c1[16];
        {
            int cnt = 0;
#pragma unroll
            for (int x = 0; x < 4; ++x)
#pragma unroll
                for (int y = x; y < 16; ++y) {
                    if ((x + 1) * (y + 1) <= 16) {
                        const float s = pv[x] + qv[y];
                        unsigned key = (fkey(s) & ~255u) | (hi ? (unsigned)(y * 16 + x) : (unsigned)(x * 16 + y));
                        if (x == y && hi) key = 0u;
                        if (cnt < 16) c0[cnt] = key; else c1[cnt - 16] = key;
                        ++cnt;
                    }
                }
#pragma unroll
            for (int i = 11; i < 16; ++i) c1[i] = 0u;
        }
        sort16_desc(c0); sort16_desc(c1); top16_of_two(c0, c1);
#pragma unroll
        for (int i = 0; i < 16; ++i) c1[i] = __shfl_xor(c0[i], 32);
        top16_of_two(c0, c1);
        asm volatile("s_waitcnt lgkmcnt(0)" ::: "memory");
        float top[16]; int eidx[16]; float mxv = -INFINITY;
#pragma unroll
        for (int w = 0; w < 16; ++w) { const unsigned pay = c0[w] & 255u; const unsigned k1 = lut[pay >> 4], k2 = lut[16 + (pay & 15u)];
            top[w] = funkey(k1 & ~127u) + funkey(k2 & ~127u); eidx[w] = (int)((k1 & 127u) * 128u + (k2 & 127u)); mxv = fmaxf(mxv, top[w]); }
        float se = 0.f;
#pragma unroll
        for (int w = 0; w < 16; ++w) { top[w] = __expf(top[w] - mxv); se += top[w]; }
        const float inv = 1.f / se;
        if (hi == 0) {
#pragma unroll
            for (int w = 0; w < 16; w += 4) { *(int4*)(IDX + R * 16 + w) = make_int4(eidx[w], eidx[w + 1], eidx[w + 2], eidx[w + 3]);
                *(f32x4*)(GW + R * 16 + w) = (f32x4){top[w] * inv, top[w + 1] * inv, top[w + 2] * inv, top[w + 3] * inv}; }
        }
        asm volatile("s_waitcnt lgkmcnt(0)" ::: "memory");
    }
}

constexpr int GA_PART = 0, GA_RED = 8 * 1024 * 4;
__device__ __forceinline__ float dot8(const u32x4 u, const float (&x)[8]) {
    return bflo(u.x) * x[0] + bfhi(u.x) * x[1] + bflo(u.y) * x[2] + bfhi(u.y) * x[3] + bflo(u.z) * x[4] + bfhi(u.z) * x[5] + bflo(u.w) * x[6] + bfhi(u.w) * x[7];
}
__device__ __forceinline__ void fma8(float (&acc)[8], const u32x4 v, float w) {
    acc[0] += w * bflo(v.x); acc[1] += w * bfhi(v.x); acc[2] += w * bflo(v.y); acc[3] += w * bfhi(v.y); acc[4] += w * bflo(v.z); acc[5] += w * bfhi(v.z); acc[6] += w * bflo(v.w); acc[7] += w * bfhi(v.w);
}
__device__ __forceinline__ void gather_phase(const Args& a, LAS unsigned char* lds, int tid, int lane, int wave) {
    unsigned char* ws = a.ws;
    const bf16_t* UT = (const bf16_t*)(ws + WS_UT); const bf16_t* VT = (const bf16_t*)(ws + WS_VT);
    const int* IDX = (const int*)(ws + WS_IDX); const float* GW = (const float*)(ws + WS_G);
    LAS float* part = (LAS float*)(lds + GA_PART); LAS float* red = (LAS float*)(lds + GA_RED);
    const f32x2 g2 = *((const f32x2*)a.in[I_LN2G] + tid), b2 = *((const f32x2*)a.in[I_LN2B] + tid);
    for (int tok = blockIdx.x; tok < MT; tok += gridDim.x) {
        float* hrow = a.out + (size_t)tok * DM;
        const size_t R = (size_t)tok * 8 + wave;
        const int myidx = IDX[R * 16 + (lane & 15)]; const float myg = GW[R * 16 + (lane & 15)];
        float xa[8], xb[8];
        { const f32x4 t0 = *(const f32x4*)(hrow + lane * 8), t1 = *(const f32x4*)(hrow + lane * 8 + 4), t2 = *(const f32x4*)(hrow + 512 + lane * 8), t3 = *(const f32x4*)(hrow + 512 + lane * 8 + 4);
          xa[0] = t0.x; xa[1] = t0.y; xa[2] = t0.z; xa[3] = t0.w; xa[4] = t1.x; xa[5] = t1.y; xa[6] = t1.z; xa[7] = t1.w;
          xb[0] = t2.x; xb[1] = t2.y; xb[2] = t2.z; xb[3] = t2.w; xb[4] = t3.x; xb[5] = t3.y; xb[6] = t3.z; xb[7] = t3.w; }
        float pd[16];
#pragma unroll
        for (int k = 0; k < 16; ++k) { const int e = __builtin_amdgcn_readlane(myidx, k); const bf16_t* ur = UT + (size_t)e * DM;
            const u32x4 ua = *(const u32x4*)(ur + lane * 8), ub = *(const u32x4*)(ur + 512 + lane * 8); pd[k] = dot8(ua, xa) + dot8(ub, xb); }
        float q8[8], q4[4], q2[2], q1;
#pragma unroll
        for (int i = 0; i < 8; ++i) { const bool up = lane & 1; const float send = up ? pd[i] : pd[i + 8], keep = up ? pd[i + 8] : pd[i]; q8[i] = keep + __shfl_xor(send, 1); }
#pragma unroll
        for (int i = 0; i < 4; ++i) { const bool up = lane & 2; const float send = up ? q8[i] : q8[i + 4], keep = up ? q8[i + 4] : q8[i]; q4[i] = keep + __shfl_xor(send, 2); }
#pragma unroll
        for (int i = 0; i < 2; ++i) { const bool up = lane & 4; const float send = up ? q4[i] : q4[i + 2], keep = up ? q4[i + 2] : q4[i]; q2[i] = keep + __shfl_xor(send, 4); }
        { const bool up = lane & 8; const float send = up ? q2[0] : q2[1], keep = up ? q2[1] : q2[0]; q1 = keep + __shfl_xor(send, 8); }
        q1 += __shfl_xor(q1, 16); q1 += __shfl_xor(q1, 32);
        const int kmap = ((lane & 1) << 3) | ((lane & 2) << 1) | ((lane & 4) >> 1) | ((lane & 8) >> 3);
        const float wgt = __shfl(myg, kmap) * gelu_tanh(q1);
        float oa[8], ob[8];
#pragma unroll
        for (int i = 0; i < 8; ++i) { oa[i] = 0.f; ob[i] = 0.f; }
#pragma unroll
        for (int k = 0; k < 16; ++k) { const int e = __builtin_amdgcn_readlane(myidx, k); const bf16_t* vr = VT + (size_t)e * DM;
            const int src = ((k & 1) << 3) | ((k & 2) << 1) | ((k & 4) >> 1) | ((k & 8) >> 3);
            const float wk = __uint_as_float(__builtin_amdgcn_readlane(__float_as_uint(wgt), src));
            const u32x4 va = *(const u32x4*)(vr + lane * 8), vb = *(const u32x4*)(vr + 512 + lane * 8); fma8(oa, va, wk); fma8(ob, vb, wk); }
        LAS float* pw = part + wave * 1024;
        *(LAS f32x4*)(pw + lane * 8) = (f32x4){oa[0], oa[1], oa[2], oa[3]}; *(LAS f32x4*)(pw + lane * 8 + 4) = (f32x4){oa[4], oa[5], oa[6], oa[7]};
        *(LAS f32x4*)(pw + 512 + lane * 8) = (f32x4){ob[0], ob[1], ob[2], ob[3]}; *(LAS f32x4*)(pw + 512 + lane * 8 + 4) = (f32x4){ob[4], ob[5], ob[6], ob[7]};
        __syncthreads();
        const f32x2 hv = *((const f32x2*)hrow + tid);
        float v0 = DN_ALPHA * hv.x, v1 = DN_ALPHA * hv.y;
#pragma unroll
        for (int w = 0; w < 8; ++w) { const f32x2 p = *(const LAS f32x2*)(part + w * 1024 + 2 * tid); v0 += p.x; v1 += p.y; }
        float s = wave_sum(v0 + v1);
        if (lane == 0) red[wave] = s;
        __syncthreads();
        float tot = 0.f;
#pragma unroll
        for (int w = 0; w < 8; ++w) tot += red[w];
        const float mean = tot * (1.f / DM);
        const float d0 = v0 - mean, d1 = v1 - mean;
        float s2 = wave_sum(d0 * d0 + d1 * d1);
        if (lane == 0) red[8 + wave] = s2;
        __syncthreads();
        float tot2 = 0.f;
#pragma unroll
        for (int w = 0; w < 8; ++w) tot2 += red[8 + w];
        const float rstd = 1.f / sqrtf(tot2 * (1.f / DM) + LN_EPS);
        *((f32x2*)hrow + tid) = (f32x2){d0 * rstd * g2.x + b2.x, d1 * rstd * g2.y + b2.y};
    }
}

constexpr int NPH = 10;
__global__ void __launch_bounds__(512, 2) fox_peer_fwd(Args a) {
    extern __shared__ __attribute__((aligned(16))) unsigned char lds_raw[];
    LAS unsigned char* lds = (LAS unsigned char*)lds_raw;
    cg::grid_group grid = cg::this_grid();
    const int tid = threadIdx.x, lane = tid & 63, wave = __builtin_amdgcn_readfirstlane(tid >> 6);
    const int G = gridDim.x;
    unsigned char* ws = a.ws;
    const int lo = a.ph_lo, hi_ = a.ph_hi;
    volatile LAS unsigned* xst = (volatile LAS unsigned*)(lds + LDS_BYTES - 16);
    if (tid < 2) xst[tid] = 0u;
    __syncthreads();
    XcdBarrier xbar = xcd_barrier_post((unsigned*)(ws + WS_CTL), xst);
#ifndef PHMASK
#define PHMASK 0x3ff
#endif
#define IN(k) (((PHMASK >> (k)) & 1) && lo <= (k) && (k) < hi_)
#define SEAM(k) do { if (IN(k) && IN((k) + 1)) { if ((k) == 0) grid.sync(); else xcd_barrier(xbar); } } while (0)

    if (IN(0)) { p0_prologue(a, lds, tid, lane, wave); }
    SEAM(0);
    if (IN(1)) {
        pg8::Gemm g{(const bf16_t*)(ws + WS_XB), (const bf16_t*)(ws + WS_WIN), MT, NIN, DM}; pg8::StaticOrder S; S.init(MT, NIN, G, (int)blockIdx.x);
        Epi1 E{a.out, ws};
        pg8::gemm_phase<Epi1, pg8::StaticOrder, true, true>(lds, g, S, E);
    }
    SEAM(1);
    if (IN(2)) {
        for (int t = blockIdx.x; t < NBATCH * NSEGP; t += G) rnn_tile<false>(a, lds, t, tid, lane, wave);
        for (int u = blockIdx.x; u < DBATCH * NH; u += G) attn_sample_unit(a, lds, u >> 3, u & 7, tid, lane, wave);
        for (int v = blockIdx.x; v < 256; v += G) {
            const int bh = v >> 2, s = v & 3;
#pragma unroll 1
            for (int i = 0; i < 4; ++i) { const int qb = (i == 0) ? s : (i == 1) ? 7 - s : (i == 2) ? 8 + s : 15 - s; attn_prompt_unit(a, lds, bh >> 3, bh & 7, qb, tid, lane, wave); __syncthreads(); }
        }
    }
    SEAM(2);
    if (IN(3)) { for (int t = blockIdx.x; t < NBATCH * NSEGP + DBATCH; t += G) rnn_tile<true>(a, lds, t, tid, lane, wave); }
    SEAM(3);
    if (IN(4)) {
        { pg8::Gemm g{(const bf16_t*)(ws + WS_Q), (const bf16_t*)(ws + WS_WA), MT, DM, DA}; pg8::StaticOrder S; S.init(MT, DM, G, (int)blockIdx.x);
          EpiUp<0> E{(const bf16_t*)(ws + WS_SA), (bf16_t*)(ws + WS_K)}; pg8::gemm_phase<EpiUp<0>, pg8::StaticOrder, true, true>(lds, g, S, E); }
        { pg8::Gemm g{(const bf16_t*)(ws + WS_GG), (const bf16_t*)(ws + WS_WR), MT, DM, DR}; pg8::StaticOrder S; S.init(MT, DM, G, (int)blockIdx.x);
          EpiUp<1> E{(const bf16_t*)(ws + WS_SR), (bf16_t*)(ws + WS_K)}; pg8::gemm_phase<EpiUp<1>, pg8::StaticOrder, true, true>(lds, g, S, E); }
    }
    SEAM(4);
    if (IN(5)) {
        pg8::Gemm g{(const bf16_t*)(ws + WS_K), (const bf16_t*)(ws + WS_WO), MT, DM, DM}; pg8::StaticOrder S; S.init(MT, DM, G, (int)blockIdx.x);
        EpiOut E{a.in[I_XP], a.in[I_XS], a.out}; pg8::gemm_phase<EpiOut, pg8::StaticOrder, true, true>(lds, g, S, E);
    }
    SEAM(5);
    if (IN(6)) { ln1_phase(a, lane, wave); }
    SEAM(6);
    if (IN(7)) {
        pg8::Gemm g{(const bf16_t*)(ws + WS_XB), (const bf16_t*)(ws + WS_WQ), MT, NQ, DM}; pg8::StaticOrder S; S.init(MT, NQ, G, (int)blockIdx.x);
        EpiQy E{(bf16_t*)(ws + WS_Q)}; pg8::gemm_phase<EpiQy, pg8::StaticOrder, true, true>(lds, g, S, E);
    }
    SEAM(7);
    if (IN(8)) { topk_phase(a, lds, tid, lane, wave); }
    SEAM(8);
    if (IN(9)) { gather_phase(a, lds, tid, lane, wave); }
#undef IN
#undef SEAM
}

#ifndef N_LAUNCHES
#define N_LAUNCHES 1
#endif
extern "C" void kernel_launch(void* const* d_in, const int* in_sizes, int n_in, void* d_out, int out_size, void* d_ws, size_t ws_size, hipStream_t stream) {
    static int grid = 0;
    if (grid == 0) {
        if (n_in != 28 || (size_t)out_size != OUT_TOTAL || ws_size < WS_END) { fprintf(stderr, "kernel_launch: unexpected problem: n_in %d out %d ws %zu\n", n_in, out_size, ws_size); grid = -1; return; }
        int dev = 0, cus = 0, per_cu = 0;
        hipGetDevice(&dev); hipDeviceGetAttribute(&cus, hipDeviceAttributeMultiprocessorCount, dev);
        if (hipFuncSetAttribute((const void*)fox_peer_fwd, hipFuncAttributeMaxDynamicSharedMemorySize, LDS_BYTES) != hipSuccess) { fprintf(stderr, "kernel_launch: hipFuncSetAttribute failed\n"); grid = -1; return; }
        if (hipOccupancyMaxActiveBlocksPerMultiprocessor(&per_cu, (const void*)fox_peer_fwd, 512, LDS_BYTES) != hipSuccess || per_cu < 1) { fprintf(stderr, "kernel_launch: occupancy query gave %d\n", per_cu); per_cu = 1; }
        (void)hipGetLastError();
        grid = cus * (per_cu < 1 ? 1 : per_cu);
    }
    if (grid < 0) return;
    if (hipMemsetAsync((char*)d_ws + WS_CTL, 0, 16384, stream) != hipSuccess) { fprintf(stderr, "kernel_launch: memset failed\n"); return; }
    Args a{};
    for (int i = 0; i < 28; ++i) a.in[i] = (const float*)d_in[i];
    a.out = (float*)d_out; a.ws = (unsigned char*)d_ws;
#if N_LAUNCHES == 1
    a.ph_lo = 0; a.ph_hi = NPH;
    void* args[] = {&a};
    hipError_t e = hipLaunchCooperativeKernel((const void*)fox_peer_fwd, dim3(grid), dim3(512), args, LDS_BYTES, stream);
    if (e != hipSuccess) fprintf(stderr, "cooperative launch failed: %s (grid %d)\n", hipGetErrorString(e), grid);
#else
    for (int p = 0; p < NPH; ++p) { a.ph_lo = p; a.ph_hi = p + 1; hipLaunchKernelGGL(fox_peer_fwd, dim3(grid), dim3(512), LDS_BYTES, stream, a); }
#endif
}
```

```cpp
#include <hip/hip_runtime.h>
#include <hip/hip_cooperative_groups.h>
#include <cstdio>
#include <cstdint>
namespace cg = cooperative_groups;
namespace pg8 {
#define PG8_LAS __attribute__((address_space(3)))
typedef unsigned short bf16_t;
typedef short bf16x8 __attribute__((ext_vector_type(8)));
typedef float f32x4 __attribute__((ext_vector_type(4)));
typedef unsigned u32x4 __attribute__((ext_vector_type(4)));
constexpr int BM = 256, BK = 64, HALF = 128, HTB = HALF * BK * 2  , STAGE_BYTES = 8 * HTB, NXCD = 8, WGM = 8;

__host__ __device__ __forceinline__ int lds_byte(int r, int c) { const int st = (r >> 4) * 2 + (c >> 5), rr = r & 15, cc = c & 31, ob = rr * 64 + cc * 2; return st * 1024 + (ob ^ (((ob >> 9) & 1) << 5)); }
__host__ __device__ __forceinline__ void stage_rc(int b, int& R, int& C) { const int st = b / 1024, sb = b % 1024, swz = sb ^ (((sb >> 9) & 1) << 5); R = (st >> 1) * 16 + swz / 64; C = (st & 1) * 32 + (swz % 64) / 2; }
__host__ __device__ __forceinline__ int perm32(int rho) { const int n = rho >> 4, i = rho & 15; return 8 * (i >> 2) + 4 * n + (i & 3); }

struct Unit { int pm, pn; };
struct Gemm { const bf16_t* A; const bf16_t* Bt; int M, N, K; };

struct StaticOrder {
    int nM, nN, nwg, G, c;
    __host__ __device__ void init(int M, int N, int G_, int c_) { nM = M / BM; nN = N / BM; nwg = nM * nN; G = G_; c = c_; }
    __host__ __device__ bool next(int i, Unit& u) const {
        const long L = (long)i * G + c; if (L >= nwg) return false;
        int wgid = (int)L; { const int q = nwg / NXCD, r = nwg % NXCD, xcd = wgid % NXCD, off = wgid / NXCD; wgid = (xcd < r ? xcd * (q + 1) : r * (q + 1) + (xcd - r) * q) + off; }
        const int nig = WGM * nN, gid = wgid / nig, fm = gid * WGM, gsz = (nM - fm) < WGM ? (nM - fm) : WGM;
        u.pm = fm + ((wgid % nig) % gsz); u.pn = (wgid % nig) / gsz; return true;
    }
    __device__ __forceinline__ void a_ready(const Unit&) const {}
    __device__ __forceinline__ void done(const Unit&) const {}
};

__device__ __forceinline__ unsigned cvt_pk_bf16(float lo, float hi) { unsigned r; asm volatile("v_cvt_pk_bf16_f32 %0, %1, %2" : "=v"(r) : "v"(lo), "v"(hi)); return r; }
template <class Epi, class Sched, bool ALIGN_EPI = false, bool SP2 = false>
__device__ __forceinline__ void gemm_phase(PG8_LAS unsigned char* lds, const Gemm g, const Sched& S, const Epi& E) {
    const int tid = threadIdx.x, wid = __builtin_amdgcn_readfirstlane(tid >> 6), lane = tid & 63, wr = wid >> 2, wc = wid & 3, fr = lane & 15, fq = lane >> 4;
    const int K = g.K, nt = K / BK;
    unsigned voffA[2], voffB[2];
#pragma unroll
    for (int i = 0; i < 2; ++i) { int R, C; stage_rc(tid * 16 + i * 8192, R, C); const int Rb = Epi::PERM ? ((R & ~31) + perm32(R & 31)) : R;
        voffA[i] = (unsigned)(R * K + C) * 2u; voffB[i] = (unsigned)(Rb * K + C) * 2u; }
    const size_t kstep = (size_t)(BK * 2);
    const size_t hstep = (size_t)HALF * K * 2;
    const size_t tstep = 2 * hstep;
    const unsigned ldsw = (unsigned)wid * 1024u;
    const int aoff = lds_byte(wr * 64 + fr, fq * 8), boff = lds_byte(wc * 32 + fr, fq * 8);
#define PG8_SA(b, h) (((b) * 2 + (h)) * HTB)
#define PG8_SB(b, h) ((4 + (b) * 2 + (h)) * HTB)
#define PG8_STAGE(bufoff, gbase, voff) do { _Pragma("unroll") for (int _i = 0; _i < 2; ++_i) \
        __builtin_amdgcn_global_load_lds((const unsigned*)((const char*)(gbase) + (voff)[_i]), (PG8_LAS unsigned*)(lds + (bufoff) + ldsw + _i * 8192), 16, 0, 0); } while (0)
#define PG8_LDA(dst, b, h) do { _Pragma("unroll") for (int m = 0; m < 4; ++m) _Pragma("unroll") for (int k = 0; k < 2; ++k) dst[m][k] = *(const PG8_LAS bf16x8*)(lds + PG8_SA(b, h) + aoff + m * 2048 + k * 1024); } while (0)
#define PG8_LDB(dst, b, h) do { _Pragma("unroll") for (int n = 0; n < 2; ++n) _Pragma("unroll") for (int k = 0; k < 2; ++k) dst[n][k] = *(const PG8_LAS bf16x8*)(lds + PG8_SB(b, h) + boff + n * 2048 + k * 1024); } while (0)
#define PG8_MMA(ai, bj, At, Bt) do { __builtin_amdgcn_s_setprio(1); _Pragma("unroll") for (int m = 0; m < 4; ++m) _Pragma("unroll") for (int n = 0; n < 2; ++n) _Pragma("unroll") for (int k = 0; k < 2; ++k) \
        acc[ai][bj][m][n] = __builtin_amdgcn_mfma_f32_16x16x32_bf16(Bt[n][k], At[m][k], acc[ai][bj][m][n], 0, 0, 0); __builtin_amdgcn_s_setprio(0); } while (0)
#define PG8_WAIT_V(n) asm volatile("s_waitcnt vmcnt(" #n ")" ::: "memory")
#define PG8_WAIT_L(n) asm volatile("s_waitcnt lgkmcnt(" #n ")" ::: "memory")
#define PG8_BAR __builtin_amdgcn_s_barrier()
#define PG8_SCHED __builtin_amdgcn_sched_barrier(0)
    Unit cur, nxt; int ui = 0;
    if (!S.next(0, cur)) return;
    f32x4 acc[2][2][4][2];
#pragma unroll
    for (int a = 0; a < 2; ++a)
#pragma unroll
        for (int b = 0; b < 2; ++b)
#pragma unroll
            for (int m = 0; m < 4; ++m)
#pragma unroll
                for (int n = 0; n < 2; ++n) acc[a][b][m][n] = (f32x4){0.f, 0.f, 0.f, 0.f};
    bf16x8 At[4][2], B0[2][2], B1[2][2];
    const char* cA = (const char*)g.A + (size_t)cur.pm * tstep; const char* cB = (const char*)g.Bt + (size_t)cur.pn * tstep;
    S.a_ready(cur);
    if constexpr (SP2) {
        PG8_STAGE(PG8_SB(0, 0), cB, voffB); PG8_STAGE(PG8_SB(0, 1), cB + hstep, voffB); PG8_STAGE(PG8_SA(0, 0), cA, voffA); PG8_STAGE(PG8_SA(0, 1), cA + hstep, voffA);
        if (wr == 1) PG8_BAR;
        PG8_WAIT_V(2); PG8_BAR;
        PG8_STAGE(PG8_SB(1, 0), cB + kstep, voffB); PG8_STAGE(PG8_SA(1, 0), cA + kstep, voffA); PG8_STAGE(PG8_SB(1, 1), cB + hstep + kstep, voffB);
        PG8_WAIT_V(6); PG8_BAR;
    } else {
        PG8_STAGE(PG8_SB(0, 0), cB, voffB); PG8_STAGE(PG8_SA(0, 0), cA, voffA); PG8_STAGE(PG8_SB(0, 1), cB + hstep, voffB); PG8_STAGE(PG8_SA(0, 1), cA + hstep, voffA);
        if (wr == 1) PG8_BAR;
        PG8_WAIT_V(4); PG8_BAR;
        PG8_STAGE(PG8_SB(1, 0), cB + kstep, voffB); PG8_STAGE(PG8_SA(1, 0), cA + kstep, voffA); PG8_STAGE(PG8_SB(1, 1), cB + hstep + kstep, voffB);
        PG8_WAIT_V(6); PG8_BAR;
    }
    for (;;) {
        const bool has_next = S.next(ui + 1, nxt);
        const char* nA = has_next ? (const char*)g.A + (size_t)nxt.pm * tstep : cA; const char* nB = has_next ? (const char*)g.Bt + (size_t)nxt.pn * tstep : cB;
        for (int t = 0; t < nt; t += 2) {
            const bool last = (t == nt - 2);
            const char* a1 = cA + (size_t)(t + 1) * kstep;
            const char* a2 = last ? nA : cA + (size_t)(t + 2) * kstep; const char* b2 = last ? nB : cB + (size_t)(t + 2) * kstep;
            const char* a3 = a2 + kstep; const char* b3 = b2 + kstep;
            if (last && has_next) S.a_ready(nxt);
            if constexpr (SP2) {
            PG8_LDB(B0, 0, 0); PG8_LDB(B1, 0, 1); PG8_SCHED; PG8_LDA(At, 0, 0); PG8_STAGE(PG8_SA(1, 1), a1 + hstep, voffA);
            PG8_WAIT_V(8); PG8_WAIT_L(0); PG8_BAR; PG8_MMA(0, 0, At, B0); PG8_MMA(0, 1, At, B1); PG8_BAR; PG8_SCHED;
            PG8_LDA(At, 0, 1); PG8_STAGE(PG8_SB(0, 0), b2, voffB); PG8_STAGE(PG8_SB(0, 1), b2 + hstep, voffB); PG8_STAGE(PG8_SA(0, 0), a2, voffA);
            PG8_WAIT_V(8); PG8_WAIT_L(0); PG8_BAR; PG8_MMA(1, 0, At, B0); PG8_MMA(1, 1, At, B1); PG8_BAR; PG8_SCHED;
            PG8_LDB(B0, 1, 0); PG8_LDB(B1, 1, 1); PG8_SCHED; PG8_LDA(At, 1, 0); PG8_STAGE(PG8_SA(0, 1), a2 + hstep, voffA);
            PG8_WAIT_V(8); PG8_WAIT_L(0); PG8_BAR; PG8_MMA(0, 0, At, B0); PG8_MMA(0, 1, At, B1); PG8_BAR; PG8_SCHED;
            PG8_LDA(At, 1, 1); PG8_STAGE(PG8_SB(1, 0), b3, voffB); PG8_STAGE(PG8_SB(1, 1), b3 + hstep, voffB); PG8_STAGE(PG8_SA(1, 0), a3, voffA);
            PG8_WAIT_V(8); PG8_WAIT_L(0); PG8_BAR; PG8_MMA(1, 0, At, B0); PG8_MMA(1, 1, At, B1); PG8_BAR; PG8_SCHED;
            } else {
            PG8_LDB(B0, 0, 0); PG8_SCHED; PG8_LDA(At, 0, 0); PG8_STAGE(PG8_SA(1, 1), a1 + hstep, voffA);
            PG8_WAIT_L(8); PG8_BAR; PG8_WAIT_L(0); PG8_MMA(0, 0, At, B0); PG8_BAR; PG8_SCHED;
            PG8_LDB(B1, 0, 1); PG8_STAGE(PG8_SB(0, 0), b2, voffB);
            PG8_BAR; PG8_WAIT_L(0); PG8_MMA(0, 1, At, B1); PG8_BAR;
            PG8_LDA(At, 0, 1); PG8_STAGE(PG8_SA(0, 0), a2, voffA);
            PG8_BAR; PG8_WAIT_L(0); PG8_MMA(1, 0, At, B0); PG8_BAR; PG8_SCHED;
            PG8_STAGE(PG8_SB(0, 1), b2 + hstep, voffB);
            PG8_WAIT_V(6); PG8_BAR; PG8_MMA(1, 1, At, B1); PG8_BAR;
            PG8_LDB(B0, 1, 0); PG8_SCHED; PG8_LDA(At, 1, 0); PG8_STAGE(PG8_SA(0, 1), a2 + hstep, voffA);
            PG8_WAIT_L(8); PG8_BAR; PG8_WAIT_L(0); PG8_MMA(0, 0, At, B0); PG8_BAR; PG8_SCHED;
            PG8_LDB(B1, 1, 1); PG8_STAGE(PG8_SB(1, 0), b3, voffB);
            PG8_BAR; PG8_WAIT_L(0); PG8_MMA(0, 1, At, B1); PG8_BAR;
            PG8_LDA(At, 1, 1); PG8_STAGE(PG8_SA(1, 0), a3, voffA);
            PG8_BAR; PG8_WAIT_L(0); PG8_MMA(1, 0, At, B0); PG8_BAR; PG8_SCHED;
            PG8_STAGE(PG8_SB(1, 1), b3 + hstep, voffB);
            PG8_WAIT_V(6); PG8_BAR; PG8_MMA(1, 1, At, B1); PG8_BAR;
            }
        }
        if constexpr (ALIGN_EPI) { if (wr == 0) PG8_BAR; }
        if constexpr (!Epi::AFTER_DRAIN) { E(acc, cur, wr, wc, fr, fq); S.done(cur); }
        if (!has_next) break;
#pragma unroll
        for (int a = 0; a < 2; ++a)
#pragma unroll
            for (int b = 0; b < 2; ++b)
#pragma unroll
                for (int m = 0; m < 4; ++m)
#pragma unroll
                    for (int n = 0; n < 2; ++n) acc[a][b][m][n] = (f32x4){0.f, 0.f, 0.f, 0.f};
        cur = nxt; cA = nA; cB = nB; ++ui;
        if constexpr (ALIGN_EPI) { if (wr == 1) PG8_BAR; }
    }
    PG8_WAIT_V(0);
    if constexpr (!ALIGN_EPI) { if (wr == 0) PG8_BAR; }
    PG8_BAR;
    if constexpr (Epi::AFTER_DRAIN) { E.fused(acc, cur, wr, wc, fr, fq, lds, wid, lane); S.done(cur); }
#undef PG8_SA
#undef PG8_SB
#undef PG8_STAGE
#undef PG8_LDA
#undef PG8_LDB
#undef PG8_MMA
#undef PG8_WAIT_V
#undef PG8_WAIT_L
#undef PG8_BAR
#undef PG8_SCHED
}
}

#define LAS __attribute__((address_space(3)))
typedef unsigned short bf16_t;
typedef short bf16x8 __attribute__((ext_vector_type(8)));
typedef float f32x4 __attribute__((ext_vector_type(4)));
typedef float f32x2 __attribute__((ext_vector_type(2)));
typedef float f32x16 __attribute__((ext_vector_type(16)));
typedef unsigned u32x4 __attribute__((ext_vector_type(4)));
typedef unsigned u32x2 __attribute__((ext_vector_type(2)));
typedef short v4i16_t __attribute__((ext_vector_type(4)));
typedef __bf16 bf16x2_t __attribute__((ext_vector_type(2)));

constexpr int DM = 1024, NBATCH = 8, SEQ = 4096, DBATCH = 16, DSEQ = 32, PAST = 1024, NH = 8, HD = 64, DA = 512, DR = 512;
constexpr int MP = NBATCH * SEQ, MS = DBATCH * DSEQ, MT = MP + MS;
constexpr int DIN = 4616, NIN = 4608, NE = 16384, NQ = 2048;
constexpr float LN_EPS = 1e-5f, DN_ALPHA = 1.189207115002721f, LOG2E = 1.4426950408889634f;
constexpr int NSEGP = SEQ / 64;
constexpr size_t OFF_KP = 34078720, OFF_VP = 50855936, OFF_FP = 67633152, OFF_CP = 67895296, OFF_RP = 67907584,
                 OFF_KS = 67911680, OFF_VS = 68173824, OFF_FS = 68435968, OFF_CS = 68440064, OFF_RS = 68464640, OUT_TOTAL = 68472832;
constexpr size_t MiB = 1u << 20;
constexpr size_t WS_XB = 0;
constexpr size_t WS_WIN = 65 * MiB;
constexpr size_t WS_WA = 74 * MiB, WS_WR = 75 * MiB, WS_WO = 76 * MiB, WS_WQ = 78 * MiB;
constexpr size_t WS_KEYS = 82 * MiB, WS_RGA = 82 * MiB + 65536, WS_RGX = 82 * MiB + 131072;
constexpr size_t WS_UT = 83 * MiB, WS_VT = 115 * MiB;
constexpr size_t QKV_BYTES = (size_t)MT * 512 * 2;
constexpr size_t WS_Q = 147 * MiB, WS_K = WS_Q + QKV_BYTES, WS_V = WS_K + QKV_BYTES, WS_XR = WS_V + QKV_BYTES;
constexpr size_t WS_GG = 277 * MiB;
constexpr size_t WS_SA = WS_GG + QKV_BYTES, WS_SR = WS_SA + 2 * QKV_BYTES;
constexpr size_t WS_LC = 440 * MiB, WS_SCH = 442 * MiB, WS_RA = 442 * MiB + 65536, WS_RB = WS_RA + MiB;
constexpr size_t WS_IDX = 445 * MiB, WS_G = 462 * MiB, WS_CTL = 479 * MiB, WS_END = 480 * MiB;
static_assert(WS_XR + QKV_BYTES <= WS_GG && WS_SR + 2 * QKV_BYTES <= WS_LC && WS_IDX + (size_t)MT * 8 * 16 * 4 <= WS_G && WS_G + (size_t)MT * 8 * 16 * 4 <= WS_END, "ws map");

constexpr int LDS_BYTES = 147456;

struct Args { const float* in[28]; float* out; unsigned char* ws; int ph_lo, ph_hi; };
enum { I_XP = 0, I_XS, I_CK, I_CV, I_CLF, I_SCONV, I_SRNN, I_WIN, I_BF, I_CONVW, I_CONVB, I_RGA, I_BRGA, I_RGX, I_BRGX, I_LAM, I_WAUP, I_WRUP, I_WOUT, I_LN1G, I_LN1B,
       I_WQ, I_K1, I_K2, I_PU, I_PV, I_LN2G, I_LN2B };

__device__ __forceinline__ unsigned pk2(float lo, float hi) { f32x2 v = {lo, hi}; bf16x2_t b = __builtin_convertvector(v, bf16x2_t); return __builtin_bit_cast(unsigned, b); }
__device__ __forceinline__ float bflo(unsigned u) { return __uint_as_float(u << 16); }
__device__ __forceinline__ float bfhi(unsigned u) { return __uint_as_float(u & 0xffff0000u); }
__device__ __forceinline__ float bf1(bf16_t b) { return __uint_as_float((unsigned)b << 16); }
__device__ __forceinline__ float sigmoidf_(float x) { return __builtin_amdgcn_rcpf(1.f + __expf(-x)); }
__device__ __forceinline__ float gelu_tanh(float x) { const float u = 0.7978845608028654f * (x + 0.044715f * x * x * x); return x * sigmoidf_(2.f * u); }
__device__ __forceinline__ const float* xrow_ptr(const Args& a, int m) { return m < MP ? a.in[I_XP] + (size_t)m * DM : a.in[I_XS] + (size_t)(m - MP) * DM; }
__device__ __forceinline__ float wave_sum(float v) {
#pragma unroll
    for (int o = 1; o < 64; o <<= 1) v += __shfl_xor(v, o);
    return v;
}
__device__ __forceinline__ int crow(int r, int hi) { return (r & 3) + 8 * (r >> 2) + 4 * hi; }

__device__ __forceinline__ void transpose_item(const float* W, int ldw, bf16_t* WT, int ldk, LAS float* scr, int k0, int n0src, int n0dst, int lane) {
#pragma unroll 8
    for (int i = 0; i < 32; ++i) { const int kk = 2 * i + (lane >> 5); scr[kk * 33 + (lane & 31)] = W[(size_t)(k0 + kk) * ldw + n0src + (lane & 31)]; }
    asm volatile("s_waitcnt lgkmcnt(0)" ::: "memory");
    const int c = lane & 7;
#pragma unroll
    for (int j = 0; j < 4; ++j) { const int n = (lane >> 3) + 8 * j; const LAS float* s = scr + (8 * c) * 33 + n;
        u32x4 o; o.x = pk2(s[0 * 33], s[1 * 33]); o.y = pk2(s[2 * 33], s[3 * 33]); o.z = pk2(s[4 * 33], s[5 * 33]); o.w = pk2(s[6 * 33], s[7 * 33]);
        *(u32x4*)(WT + (size_t)(n0dst + n) * ldk + k0 + 8 * c) = o; }
    asm volatile("s_waitcnt lgkmcnt(0)" ::: "memory");
}
__device__ __forceinline__ void cvt8(const float* src, bf16_t* dst, size_t i) {
    const f32x4 v0 = *(const f32x4*)(src + i * 8), v1 = *(const f32x4*)(src + i * 8 + 4);
    u32x4 o; o.x = pk2(v0.x, v0.y); o.y = pk2(v0.z, v0.w); o.z = pk2(v1.x, v1.y); o.w = pk2(v1.z, v1.w);
    *(u32x4*)(dst + i * 8) = o;
}
constexpr float U8_SCALE = 256.f, V8_SCALE = 32.f;
__device__ __forceinline__ void cvt16_fp8(const float* src, unsigned char* dst, size_t i, float sc) {
    const f32x4 v0 = *(const f32x4*)(src + i * 16) * sc, v1 = *(const f32x4*)(src + i * 16 + 4) * sc, v2 = *(const f32x4*)(src + i * 16 + 8) * sc, v3 = *(const f32x4*)(src + i * 16 + 12) * sc;
    u32x4 o;
    o.x = (unsigned)__builtin_amdgcn_cvt_pk_fp8_f32(v0.z, v0.w, __builtin_amdgcn_cvt_pk_fp8_f32(v0.x, v0.y, 0, false), true);
    o.y = (unsigned)__builtin_amdgcn_cvt_pk_fp8_f32(v1.z, v1.w, __builtin_amdgcn_cvt_pk_fp8_f32(v1.x, v1.y, 0, false), true);
    o.z = (unsigned)__builtin_amdgcn_cvt_pk_fp8_f32(v2.z, v2.w, __builtin_amdgcn_cvt_pk_fp8_f32(v2.x, v2.y, 0, false), true);
    o.w = (unsigned)__builtin_amdgcn_cvt_pk_fp8_f32(v3.z, v3.w, __builtin_amdgcn_cvt_pk_fp8_f32(v3.x, v3.y, 0, false), true);
    *(u32x4*)(dst + i * 16) = o;
}
__device__ __forceinline__ void p0_prologue(const Args& a, LAS unsigned char* lds, int tid, int lane, int wave) {
    unsigned char* ws = a.ws;
    const int G = gridDim.x, gw = blockIdx.x * 8 + wave, NGW = G * 8;
    {
        LAS float* scr = (LAS float*)(lds + wave * 8448);
        constexpr int I0 = 16 * 144, I1 = 8 * 32, I2 = 8 * 32, I3 = 16 * 32, I4 = 16 * 64, I5 = 16, I6 = 16, NIT = I0 + I1 + I2 + I3 + I4 + I5 + I6;
        for (int it = gw; it < NIT; it += NGW) {
            int r = it;
            if (r < I0) { const int kb = r / 144, nb = r % 144, n0 = 32 * nb; transpose_item(a.in[I_WIN], DIN, (bf16_t*)(ws + WS_WIN), 1024, scr, 64 * kb, n0 + (n0 >= 1536 ? 8 : 0), n0, lane); continue; } r -= I0;
            if (r < I1) { transpose_item(a.in[I_WAUP], 1024, (bf16_t*)(ws + WS_WA), 512, scr, 64 * (r / 32), 32 * (r % 32), 32 * (r % 32), lane); continue; } r -= I1;
            if (r < I2) { transpose_item(a.in[I_WRUP], 1024, (bf16_t*)(ws + WS_WR), 512, scr, 64 * (r / 32), 32 * (r % 32), 32 * (r % 32), lane); continue; } r -= I2;
            if (r < I3) { transpose_item(a.in[I_WOUT], 1024, (bf16_t*)(ws + WS_WO), 1024, scr, 64 * (r / 32), 32 * (r % 32), 32 * (r % 32), lane); continue; } r -= I3;
            if (r < I4) { transpose_item(a.in[I_WQ], 2048, (bf16_t*)(ws + WS_WQ), 1024, scr, 64 * (r / 64), 32 * (r % 64), 32 * (r % 64), lane); continue; } r -= I4;
            if (r < I5) { const int n = r >> 1, nb = r & 1; transpose_item(a.in[I_RGA] + n * 4096, 64, (bf16_t*)(ws + WS_RGA) + n * 4096, 64, scr, 0, 32 * nb, 32 * nb, lane); continue; } r -= I5;
            { const int n = r >> 1, nb = r & 1; transpose_item(a.in[I_RGX] + n * 4096, 64, (bf16_t*)(ws + WS_RGX) + n * 4096, 64, scr, 0, 32 * nb, 32 * nb, lane); }
        }
    }
    {
        constexpr size_t N0 = (size_t)MP * DM / 8, N1 = (size_t)MS * DM / 8, N2 = (size_t)NE * DM / 16, N3 = N2, N4 = 2048, N5 = 2048, NTOT = N0 + N1 + N2 + N3 + N4 + N5;
        const size_t stride = (size_t)G * 512;
        for (size_t i = (size_t)blockIdx.x * 512 + tid; i < NTOT; i += stride) {
            size_t r = i;
            if (r < N0) { cvt8(a.in[I_XP], (bf16_t*)(ws + WS_XB), r); continue; } r -= N0;
            if (r < N1) { cvt8(a.in[I_XS], (bf16_t*)(ws + WS_XB) + (size_t)MP * DM, r); continue; } r -= N1;
            if (r < N2) { cvt16_fp8(a.in[I_PU], ws + WS_UT, r, U8_SCALE); continue; } r -= N2;
            if (r < N3) { cvt16_fp8(a.in[I_PV], ws + WS_VT, r, V8_SCALE); continue; } r -= N3;
            if (r < N4) { cvt8(a.in[I_K1], (bf16_t*)(ws + WS_KEYS), r); continue; } r -= N4;
            cvt8(a.in[I_K2], (bf16_t*)(ws + WS_KEYS) + 16384, r);
        }
    }
    __syncthreads();
    {
        LAS float* wf = (LAS float*)lds;
        LAS float* lfs = (LAS float*)(lds + 32768);
        const float* win = a.in[I_WIN];
        bool staged = false;
        for (int u = blockIdx.x; u < MT / 64; u += G) {
            if (!staged) { for (int i = tid; i < 8192; i += 512) wf[i] = win[(size_t)(i >> 3) * DIN + 1536 + (i & 7)]; staged = true; __syncthreads(); }
            const int m0 = 64 * u;
            for (int i = 0; i < 8; ++i) {
                const int m = m0 + 8 * wave + i; const float* xr = xrow_ptr(a, m);
                float acc[8];
#pragma unroll
                for (int h = 0; h < 8; ++h) acc[h] = 0.f;
#pragma unroll 4
                for (int kk = 0; kk < 16; ++kk) { const int k = lane + 64 * kk; const float xv = xr[k]; const f32x4 w0 = *(const LAS f32x4*)(wf + k * 8), w1 = *(const LAS f32x4*)(wf + k * 8 + 4);
                    acc[0] += xv * w0.x; acc[1] += xv * w0.y; acc[2] += xv * w0.z; acc[3] += xv * w0.w; acc[4] += xv * w1.x; acc[5] += xv * w1.y; acc[6] += xv * w1.z; acc[7] += xv * w1.w; }
                float z = 0.f;
#pragma unroll
                for (int h = 0; h < 8; ++h) { const float s = wave_sum(acc[h]); if (lane == h) z = s; }
                if (lane < 8) { z += a.in[I_BF][lane]; const float lf = fminf(z, 0.f) - log1pf(__expf(-fabsf(z)));
                    if (m < MP) a.out[OFF_FP + (size_t)m * 8 + lane] = lf; else a.out[OFF_FS + (size_t)(m - MP) * 8 + lane] = lf;
                    lfs[(8 * wave + i) * 8 + lane] = lf; }
            }
            __syncthreads();
            if (u < MP / 64) { float v = lfs[lane * 8 + wave];
#pragma unroll
                for (int o = 1; o < 64; o <<= 1) { const float t = __shfl_up(v, o); if (lane >= o) v += t; }
                ((float*)(ws + WS_LC))[(size_t)(m0 + lane) * 8 + wave] = v;
                if (lane == 63) ((float*)(ws + WS_SCH))[u * 8 + wave] = v; }
            __syncthreads();
        }
    }
}

struct Epi1 {
    static constexpr bool PERM = false, AFTER_DRAIN = false;
    float* out; unsigned char* ws;
    __device__ __forceinline__ void operator()(const f32x4 (&acc)[2][2][4][2], const pg8::Unit& u, int wr, int wc, int fr, int fq) const {
        const int pn = u.pn; const int rbase = u.pm * 256 + wr * 64 + fr; const int cbase = pn * 256 + wc * 32 + 4 * fq;
        const bool samp = u.pm >= MP / 256;
#pragma unroll
        for (int ai = 0; ai < 2; ++ai)
#pragma unroll
            for (int m = 0; m < 4; ++m) {
                const int row = rbase + ai * 128 + m * 16;
#pragma unroll
                for (int bj = 0; bj < 2; ++bj)
#pragma unroll
                    for (int n = 0; n < 2; ++n) {
                        const int col = cbase + bj * 128 + n * 16; const f32x4 v = acc[ai][bj][m][n];
                        if (pn < 2) { u32x2 w; w.x = pk2(v.x, v.y); w.y = pk2(v.z, v.w); *(u32x2*)((bf16_t*)(ws + WS_Q) + (size_t)row * 512 + col) = w; }
                        else if (pn < 6) { const int isv = pn >= 4; const int c = col - (isv ? 1024 : 512);
                            u32x2 w; w.x = pk2(v.x, v.y); w.y = pk2(v.z, v.w); *(u32x2*)((bf16_t*)(ws + (isv ? WS_V : WS_K)) + (size_t)row * 512 + c) = w;
                            float* o = samp ? out + (isv ? OFF_VS : OFF_KS) + (size_t)(row - MP) * 512 + c : out + (isv ? OFF_VP : OFF_KP) + (size_t)row * 512 + c;
                            *(f32x4*)o = v; }
                        else if (pn < 8) { const int c = col - 1536;
                            u32x2 w; w.x = pk2(v.x, v.y); w.y = pk2(v.z, v.w); *(u32x2*)((bf16_t*)(ws + WS_XR) + (size_t)row * 512 + c) = w;
                            if (!samp) { const int t = row & (SEQ - 1); if (t >= SEQ - 3) *(f32x4*)(out + OFF_CP + (size_t)((row >> 12) * 3 + (t - (SEQ - 3))) * 512 + c) = v; }
                            else { const int rs = row - MP, t = rs & 31; if (t >= DSEQ - 3) *(f32x4*)(out + OFF_CS + (size_t)((rs >> 5) * 3 + (t - (DSEQ - 3))) * 512 + c) = v; } }
                        else if (pn < 10) { const int c = col - 2048;
                            u32x2 w; w.x = pk2(gelu_tanh(v.x), gelu_tanh(v.y)); w.y = pk2(gelu_tanh(v.z), gelu_tanh(v.w)); *(u32x2*)((bf16_t*)(ws + WS_GG) + (size_t)row * 512 + c) = w; }
                        else { const int isr = pn >= 14; const int c = col - (isr ? 3584 : 2560);
                            u32x2 w; w.x = pk2(sigmoidf_(v.x), sigmoidf_(v.y)); w.y = pk2(sigmoidf_(v.z), sigmoidf_(v.w)); *(u32x2*)((bf16_t*)(ws + (isr ? WS_SR : WS_SA)) + (size_t)row * 1024 + c) = w; }
                    }
            }
    }
};
template <int SECOND> struct EpiUp {
    static constexpr bool PERM = false, AFTER_DRAIN = false;
    const bf16_t* gate; bf16_t* mg;
    __device__ __forceinline__ void operator()(const f32x4 (&acc)[2][2][4][2], const pg8::Unit& u, int wr, int wc, int fr, int fq) const {
        const int rbase = u.pm * 256 + wr * 64 + fr; const int cbase = u.pn * 256 + wc * 32 + 4 * fq;
#pragma unroll
        for (int ai = 0; ai < 2; ++ai)
#pragma unroll
            for (int m = 0; m < 4; ++m) {
                const size_t ro = (size_t)(rbase + ai * 128 + m * 16) * 1024;
#pragma unroll
                for (int bj = 0; bj < 2; ++bj)
#pragma unroll
                    for (int n = 0; n < 2; ++n) {
                        const size_t o = ro + cbase + bj * 128 + n * 16; const f32x4 v = acc[ai][bj][m][n];
                        const u32x2 g = *(const u32x2*)(gate + o);
                        float r0 = bflo(g.x) * v.x, r1 = bfhi(g.x) * v.y, r2 = bflo(g.y) * v.z, r3 = bfhi(g.y) * v.w;
                        if (SECOND) { const u32x2 p = *(const u32x2*)(mg + o); r0 += bflo(p.x); r1 += bfhi(p.x); r2 += bflo(p.y); r3 += bfhi(p.y); }
                        u32x2 w; w.x = pk2(r0, r1); w.y = pk2(r2, r3); *(u32x2*)(mg + o) = w;
                    }
            }
    }
};
struct EpiOut {
    static constexpr bool PERM = false, AFTER_DRAIN = false;
    const float* xp; const float* xs; float* y;
    __device__ __forceinline__ void operator()(const f32x4 (&acc)[2][2][4][2], const pg8::Unit& u, int wr, int wc, int fr, int fq) const {
        const int rbase = u.pm * 256 + wr * 64 + fr; const int cbase = u.pn * 256 + wc * 32 + 4 * fq;
#pragma unroll
        for (int ai = 0; ai < 2; ++ai)
#pragma unroll
            for (int m = 0; m < 4; ++m) {
                const int row = rbase + ai * 128 + m * 16; const float* xr = row < MP ? xp + (size_t)row * DM : xs + (size_t)(row - MP) * DM;
#pragma unroll
                for (int bj = 0; bj < 2; ++bj)
#pragma unroll
                    for (int n = 0; n < 2; ++n) { const int col = cbase + bj * 128 + n * 16; const f32x4 xv = *(const f32x4*)(xr + col);
                        *(f32x4*)(y + (size_t)row * DM + col) = xv * DN_ALPHA + acc[ai][bj][m][n]; }
            }
    }
};
struct EpiQy {
    static constexpr bool PERM = true, AFTER_DRAIN = false;
    bf16_t* O;
    __device__ __forceinline__ void operator()(const f32x4 (&acc)[2][2][4][2], const pg8::Unit& u, int wr, int wc, int fr, int fq) const {
        const int row0 = u.pm * 256 + wr * 64 + fr; const int col0 = u.pn * 256 + wc * 32 + 8 * fq;
#pragma unroll
        for (int ai = 0; ai < 2; ++ai)
#pragma unroll
            for (int m = 0; m < 4; ++m) { bf16_t* rowp = O + (size_t)(row0 + ai * 128 + m * 16) * NQ + col0;
#pragma unroll
                for (int bj = 0; bj < 2; ++bj) { const f32x4 v0 = acc[ai][bj][m][0], v1 = acc[ai][bj][m][1];
                    u32x4 w; w.x = pk2(v0[0], v0[1]); w.y = pk2(v0[2], v0[3]); w.z = pk2(v1[0], v1[1]); w.w = pk2(v1[2], v1[3]);
                    *(u32x4*)(rowp + bj * 128) = w; } }
    }
};
#define GAS __attribute__((address_space(1)))
#define XB_TMO      128
#define XB_XCNT(j)  (256  + 64 * (j))
#define XB_XSUB(j)  (1280 + 64 * (j))
#define XB_XGEN(j)  (2304 + 64 * (j))
#define XB_TOP      3328
#define XB_TOPGEN   3392
#define XCD_BAR_WORDS 3456
#define XB_SPIN_CAP (1u << 18)

__device__ __forceinline__ unsigned xb_ld(unsigned* p)              { return __hip_atomic_load(p, __ATOMIC_RELAXED, __HIP_MEMORY_SCOPE_AGENT); }
__device__ __forceinline__ unsigned xb_add(unsigned* p, unsigned v) { return __hip_atomic_fetch_add(p, v, __ATOMIC_RELAXED, __HIP_MEMORY_SCOPE_AGENT); }
__device__ __forceinline__ unsigned xb_xcc_id() { return (unsigned)__builtin_amdgcn_s_getreg((3 << 11) | 20) & 0xFu; }
#define XB_SPIN(cond, bar) do { unsigned _sp = 0; while (cond) { __builtin_amdgcn_s_sleep(1); \
    if ((++_sp & 255u) == 0u) { if (xb_ld(&(bar)[XB_TMO])) break; if (_sp > XB_SPIN_CAP) { atomicAdd(&(bar)[XB_TMO], 1u); break; } } } } while (0)

struct XcdBarrier {
    unsigned* bar; unsigned x;
    volatile LAS unsigned* st;
};

__device__ __forceinline__ XcdBarrier xcd_barrier_post(unsigned* bar, volatile LAS unsigned* st) {
    XcdBarrier b; b.bar = bar; b.x = xb_xcc_id(); b.st = st;
    if (threadIdx.x == 0) (void)xb_add(&bar[XB_XCNT(b.x)], 1u);
    return b;
}
__device__ __forceinline__ void xcd_barrier_complete(unsigned* bar, unsigned x, unsigned& nloc, unsigned& nx) {
    const unsigned G = gridDim.x * gridDim.y * gridDim.z;
    unsigned sum, cnt, mine, sp = 0u;
    for (;;) {
        sum = 0u; cnt = 0u; mine = 0u;
#pragma unroll
        for (unsigned j = 0; j < 16; ++j) { const unsigned c = xb_ld(&bar[XB_XCNT(j)]); sum += c; cnt += (c > 0u) ? 1u : 0u; mine = (j == x) ? c : mine; }
        if (sum == G) break;
        __builtin_amdgcn_s_sleep(1);
        if ((++sp & 255u) == 0u) { if (xb_ld(&bar[XB_TMO])) break; if (sp > XB_SPIN_CAP) { atomicAdd(&bar[XB_TMO], 1u); break; } }
    }
    nloc = mine > 0u ? mine : 1u; nx = cnt > 0u ? cnt : 1u;
}

__device__ __forceinline__ void xcd_barrier(const XcdBarrier& b) {
    asm volatile("s_waitcnt vmcnt(0)" ::: "memory");
    __syncthreads();
    if (threadIdx.x == 0) {
        unsigned* bar = b.bar;
        __builtin_amdgcn_s_waitcnt(0);
        unsigned nloc = b.st[0], nx = b.st[1];
        if (nloc == 0u) { xcd_barrier_complete(bar, b.x, nloc, nx); b.st[0] = nloc; b.st[1] = nx; }
        const unsigned old = xb_add(&bar[XB_XSUB(b.x)], 1u);
        const unsigned gen = old / nloc;
        if (old + 1u == (gen + 1u) * nloc) {
            __builtin_amdgcn_fence(__ATOMIC_RELEASE, "agent");
            asm volatile("s_waitcnt vmcnt(0)" ::: "memory");
            const unsigned og = xb_add(&bar[XB_TOP], 1u);
            const unsigned tg = og / nx;
            if (og + 1u == (tg + 1u) * nx) xb_add(&bar[XB_TOPGEN], 1u);
            else XB_SPIN(xb_ld(&bar[XB_TOPGEN]) == tg, bar);
            __builtin_amdgcn_fence(__ATOMIC_ACQUIRE, "agent");
            xb_add(&bar[XB_XGEN(b.x)], 1u);
            asm volatile("s_waitcnt vmcnt(0)" ::: "memory");
        } else {
            XB_SPIN(xb_ld(&bar[XB_XGEN(b.x)]) == gen, bar);
            __builtin_amdgcn_fence(__ATOMIC_ACQUIRE, "agent");
            asm volatile("s_waitcnt vmcnt(0)" ::: "memory");
        }
    }
    __syncthreads();
}

template <int NK>
__device__ __forceinline__ void attn_tile(float& mrun, float& lrun, f32x16 (&o)[2], const bf16x8 (&qf)[4], const LAS unsigned char* Kt, const LAS unsigned char* Vt, int vimg_stride,
                                          const LAS float* cb, bool masked, int qrel, int lane) {
    const int r32 = lane & 31, hi = lane >> 5;
    f32x16 p[NK];
#pragma unroll
    for (int ks = 0; ks < NK; ++ks) {
        f32x16 acc = {};
#pragma unroll
        for (int c = 0; c < 4; ++c) { const bf16x8 kf = *(const LAS bf16x8*)(Kt + (32 * ks + r32) * 144 + (16 * c + 8 * hi) * 2); acc = __builtin_amdgcn_mfma_f32_32x32x16_bf16(kf, qf[c], acc, 0, 0, 0); }
        p[ks] = acc;
    }
    constexpr float SC = 0.125f * LOG2E;
    float mx = -INFINITY;
#pragma unroll
    for (int ks = 0; ks < NK; ++ks)
#pragma unroll
        for (int g = 0; g < 4; ++g) { const f32x4 cbv = *(const LAS f32x4*)(cb + 32 * ks + 8 * g + 4 * hi);
#pragma unroll
            for (int i = 0; i < 4; ++i) { float t = p[ks][4 * g + i] * SC + cbv[i]; if (masked && (32 * ks + 8 * g + 4 * hi + i > qrel)) t = -INFINITY; p[ks][4 * g + i] = t; mx = fmaxf(mx, t); } }
    mx = fmaxf(mx, __shfl_xor(mx, 32));
    const float mnew = fmaxf(mrun, mx);
    const float alpha = __builtin_amdgcn_exp2f(mrun - mnew);
    mrun = mnew;
    float rs = 0.f;
#pragma unroll
    for (int ks = 0; ks < NK; ++ks)
#pragma unroll
        for (int r = 0; r < 16; ++r) { const float e = __builtin_amdgcn_exp2f(p[ks][r] - mnew); p[ks][r] = e; rs += e; }
    lrun = lrun * alpha + rs;
#pragma unroll
    for (int dh = 0; dh < 2; ++dh)
#pragma unroll
        for (int r = 0; r < 16; ++r) o[dh][r] *= alpha;
    const int li = lane & 15, cg2 = (lane >> 4) & 1;
    const int voff = (4 * hi + (li >> 2)) * 64 + (16 * cg2 + 4 * (li & 3)) * 2;
#pragma unroll
    for (int kc = 0; kc < 2 * NK; ++kc) {
        const int ks = kc >> 1, rb = 8 * (kc & 1);
        u32x4 pw; pw.x = pk2(p[ks][rb + 0], p[ks][rb + 1]); pw.y = pk2(p[ks][rb + 2], p[ks][rb + 3]); pw.z = pk2(p[ks][rb + 4], p[ks][rb + 5]); pw.w = pk2(p[ks][rb + 6], p[ks][rb + 7]);
        const bf16x8 pb = __builtin_bit_cast(bf16x8, pw);
#pragma unroll
        for (int dh = 0; dh < 2; ++dh) {
            const LAS unsigned char* vp = Vt + dh * vimg_stride + (16 * kc) * 64 + voff;
            const v4i16_t lo = __builtin_amdgcn_ds_read_tr16_b64_v4i16((LAS v4i16_t*)vp);
            const v4i16_t hh = __builtin_amdgcn_ds_read_tr16_b64_v4i16((LAS v4i16_t*)(vp + 8 * 64));
            const bf16x8 vf = {lo[0], lo[1], lo[2], lo[3], hh[0], hh[1], hh[2], hh[3]};
            o[dh] = __builtin_amdgcn_mfma_f32_32x32x16_bf16(vf, pb, o[dh], 0, 0, 0);
        }
    }
}

constexpr int AT_KB = 64 * 144, AT_VB = 8192, AT_K0 = 0, AT_V0 = 2 * AT_KB, AT_CB = AT_V0 + 2 * AT_VB;
__device__ __forceinline__ void attn_prompt_unit(const Args& a, LAS unsigned char* lds, int b, int h, int qb, int tid, int lane, int wave) {
    unsigned char* ws = a.ws;
    const bf16_t* Q = (const bf16_t*)(ws + WS_Q); const bf16_t* K = (const bf16_t*)(ws + WS_K); const bf16_t* V = (const bf16_t*)(ws + WS_V); bf16_t* O = (bf16_t*)(ws + WS_Q);
    const float* LC = (const float*)(ws + WS_LC); const float* SCH = (const float*)(ws + WS_SCH);
    const int r32 = lane & 31, hi = lane >> 5;
    const size_t rowb = (size_t)b * SEQ;
    const int q0 = qb * 256 + wave * 32;
    bf16x8 qf[4];
#pragma unroll
    for (int c = 0; c < 4; ++c) qf[c] = *(const bf16x8*)(Q + (rowb + q0 + r32) * 512 + h * 64 + 16 * c + 8 * hi);
    const int NT = (qb + 1) * 4;
    const int skey = tid >> 3, sch = tid & 7;
    const bf16_t* ksrc = K + (rowb + skey) * 512 + h * 64 + sch * 8; const bf16_t* vsrc = V + (rowb + skey) * 512 + h * 64 + sch * 8;
    const int kdst = skey * 144 + sch * 16, vdst = (sch >> 2) * 4096 + skey * 64 + (sch & 3) * 16;
    float off = 0.f;
    u32x4 kreg = *(const u32x4*)ksrc, vreg = *(const u32x4*)vsrc; float creg = 0.f;
    if (tid < 64) { creg = -(off + LC[(rowb + tid) * 8 + h]) * LOG2E; off += SCH[(b * NSEGP + 0) * 8 + h]; }
    *(LAS u32x4*)(lds + AT_K0 + kdst) = kreg; *(LAS u32x4*)(lds + AT_V0 + vdst) = vreg; if (tid < 64) ((LAS float*)(lds + AT_CB))[tid] = creg;
    __syncthreads();
    float mrun = -INFINITY, lrun = 0.f; f32x16 o[2]; o[0] = f32x16{}; o[1] = f32x16{};
    for (int j = 0; j < NT; ++j) {
        const int buf = j & 1;
        if (j + 1 < NT) { kreg = *(const u32x4*)(ksrc + (size_t)(j + 1) * 64 * 512); vreg = *(const u32x4*)(vsrc + (size_t)(j + 1) * 64 * 512);
            if (tid < 64) { creg = -(off + LC[(rowb + 64 * (j + 1) + tid) * 8 + h]) * LOG2E; off += SCH[(b * NSEGP + j + 1) * 8 + h]; } }
        if (64 * j <= q0 + 31) {
            const bool masked = (64 * j + 63 > q0);
            attn_tile<2>(mrun, lrun, o, qf, lds + AT_K0 + buf * AT_KB, lds + AT_V0 + buf * AT_VB, 4096, (const LAS float*)(lds + AT_CB) + buf * 64, masked, q0 + r32 - 64 * j, lane);
        }
        if (j + 1 < NT) { *(LAS u32x4*)(lds + AT_K0 + (buf ^ 1) * AT_KB + kdst) = kreg; *(LAS u32x4*)(lds + AT_V0 + (buf ^ 1) * AT_VB + vdst) = vreg; if (tid < 64) ((LAS float*)(lds + AT_CB))[(buf ^ 1) * 64 + tid] = creg; }
        __syncthreads();
    }
    const float lt = lrun + __shfl_xor(lrun, 32); const float inv = 1.f / lt;
    bf16_t* orow = O + (rowb + q0 + r32) * 512 + h * 64;
#pragma unroll
    for (int dh = 0; dh < 2; ++dh)
#pragma unroll
        for (int g = 0; g < 4; ++g) { u32x2 w; w.x = pk2(o[dh][4 * g] * inv, o[dh][4 * g + 1] * inv); w.y = pk2(o[dh][4 * g + 2] * inv, o[dh][4 * g + 3] * inv);
            *(u32x2*)(orow + 32 * dh + 8 * g + 4 * hi) = w; }
}

constexpr int SA_WV = 4608 + 4096, SA_CB = 8 * SA_WV, SA_CMB = 0;
__device__ __forceinline__ void attn_sample_unit(const Args& a, LAS unsigned char* lds, int bs, int h, int tid, int lane, int wave) {
    unsigned char* ws = a.ws;
    const bf16_t* Q = (const bf16_t*)(ws + WS_Q); const bf16_t* Kn = (const bf16_t*)(ws + WS_K); const bf16_t* Vn = (const bf16_t*)(ws + WS_V); bf16_t* O = (bf16_t*)(ws + WS_Q);
    const int r32 = lane & 31, hi = lane >> 5;
    const size_t row0 = (size_t)MP + (size_t)bs * DSEQ;
    LAS float* cbs = (LAS float*)(lds + SA_CB);
    if (wave == 0) {
        float v[17]; float s = 0.f;
#pragma unroll
        for (int i = 0; i < 17; ++i) { const int k = lane * 17 + i; float x = 0.f;
            if (k < PAST) x = a.in[I_CLF][((size_t)bs * PAST + k) * 8 + h]; else if (k < PAST + DSEQ) x = a.out[OFF_FS + ((size_t)bs * DSEQ + (k - PAST)) * 8 + h];
            s += x; v[i] = s; }
        float inc = s;
#pragma unroll
        for (int o = 1; o < 64; o <<= 1) { const float t = __shfl_up(inc, o); if (lane >= o) inc += t; }
        const float excl = inc - s;
#pragma unroll
        for (int i = 0; i < 17; ++i) cbs[lane * 17 + i] = -(excl + v[i]) * LOG2E;
    }
    bf16x8 qf[4];
#pragma unroll
    for (int c = 0; c < 4; ++c) qf[c] = *(const bf16x8*)(Q + (row0 + r32) * 512 + h * 64 + 16 * c + 8 * hi);
    __syncthreads();
    LAS unsigned char* Kw = lds + wave * SA_WV; LAS unsigned char* Vw = Kw + 4608;
    float mrun = -INFINITY, lrun = 0.f; f32x16 o[2]; o[0] = f32x16{}; o[1] = f32x16{};
    for (int g = wave; g < 33; g += 8) {
        if (g < 32) {
            const float* kc = a.in[I_CK] + (((size_t)bs * PAST + 32 * g) * NH + h) * HD; const float* vc = a.in[I_CV] + (((size_t)bs * PAST + 32 * g) * NH + h) * HD;
#pragma unroll
            for (int i = 0; i < 8; ++i) { const int id = i * 64 + lane, key = id >> 4, part = id & 15;
                const f32x4 kv = *(const f32x4*)(kc + (size_t)key * NH * HD + part * 4), vv = *(const f32x4*)(vc + (size_t)key * NH * HD + part * 4);
                u32x2 kw; kw.x = pk2(kv.x, kv.y); kw.y = pk2(kv.z, kv.w); u32x2 vw; vw.x = pk2(vv.x, vv.y); vw.y = pk2(vv.z, vv.w);
                *(LAS u32x2*)(Kw + key * 144 + part * 8) = kw; *(LAS u32x2*)(Vw + (part >> 3) * 2048 + key * 64 + (part & 7) * 8) = vw; }
        } else {
#pragma unroll
            for (int i = 0; i < 4; ++i) { const int id = i * 64 + lane, key = id >> 3, ch = id & 7;
                const u32x4 kv = *(const u32x4*)(Kn + (row0 + key) * 512 + h * 64 + ch * 8), vv = *(const u32x4*)(Vn + (row0 + key) * 512 + h * 64 + ch * 8);
                *(LAS u32x4*)(Kw + key * 144 + ch * 16) = kv; *(LAS u32x4*)(Vw + (ch >> 2) * 2048 + key * 64 + (ch & 3) * 16) = vv; }
        }
        asm volatile("s_waitcnt lgkmcnt(0)" ::: "memory");
        attn_tile<1>(mrun, lrun, o, qf, Kw, Vw, 2048, cbs + 32 * g, g == 32, r32, lane);
        asm volatile("s_waitcnt lgkmcnt(0)" ::: "memory");
    }
    __syncthreads();
    LAS float* cm = (LAS float*)(lds + SA_CMB) + wave * 2112;
    const float lt = lrun + __shfl_xor(lrun, 32);
    if (hi == 0) { cm[r32] = mrun; cm[32 + r32] = lt; }
#pragma unroll
    for (int dh = 0; dh < 2; ++dh)
#pragma unroll
        for (int r = 0; r < 16; ++r) cm[64 + (32 * dh + crow(r, hi)) * 32 + r32] = o[dh][r];
    __syncthreads();
    {
        const int q = tid & 31, d0 = (tid >> 5) * 4;
        const LAS float* base = (const LAS float*)(lds + SA_CMB);
        float M = -INFINITY;
#pragma unroll
        for (int w = 0; w < 8; ++w) M = fmaxf(M, base[w * 2112 + q]);
        float L = 0.f, acc[4] = {0.f, 0.f, 0.f, 0.f};
#pragma unroll
        for (int w = 0; w < 8; ++w) { const float f = __builtin_amdgcn_exp2f(base[w * 2112 + q] - M); L += f * base[w * 2112 + 32 + q];
#pragma unroll
            for (int i = 0; i < 4; ++i) acc[i] += f * base[w * 2112 + 64 + (d0 + i) * 32 + q]; }
        const float inv = 1.f / L;
        u32x2 w; w.x = pk2(acc[0] * inv, acc[1] * inv); w.y = pk2(acc[2] * inv, acc[3] * inv);
        *(u32x2*)(O + (row0 + q) * 512 + h * 64 + d0) = w;
    }
    __syncthreads();
}

constexpr int RN_XC = 0, RN_XCS = 1040, RN_HIN = 64 * RN_XCS;
template <bool FINAL>
__device__ __forceinline__ void rnn_tile(const Args& a, LAS unsigned char* lds, int tile, int tid, int lane, int wave) {
    unsigned char* ws = a.ws;
    const bf16_t* XR = (const bf16_t*)(ws + WS_XR); bf16_t* GGRO = (bf16_t*)(ws + WS_GG);
    float* RA = (float*)(ws + WS_RA); float* RB = (float*)(ws + WS_RB);
    const bool samp = tile >= NBATCH * NSEGP;
    const int b = samp ? tile - NBATCH * NSEGP : tile / NSEGP, seg = samp ? 0 : tile % NSEGP;
    const size_t m0 = samp ? (size_t)MP + (size_t)b * DSEQ : (size_t)b * SEQ + (size_t)seg * 64;
    const int nrow = samp ? 32 : 64;
    for (int it = tid; it < nrow * 64; it += 512) {
        const int t = it >> 6, c0 = (it & 63) * 8;
        float acc[8];
        const f32x4 cb0 = *(const f32x4*)(a.in[I_CONVB] + c0), cb1 = *(const f32x4*)(a.in[I_CONVB] + c0 + 4);
        acc[0] = cb0.x; acc[1] = cb0.y; acc[2] = cb0.z; acc[3] = cb0.w; acc[4] = cb1.x; acc[5] = cb1.y; acc[6] = cb1.z; acc[7] = cb1.w;
#pragma unroll
        for (int w = 0; w < 4; ++w) {
            const int tt = (samp ? 0 : seg * 64) + t - 3 + w;
            float xv[8];
            if (tt >= 0) { const u32x4 x = *(const u32x4*)(XR + (m0 + t - 3 + w) * 512 + c0);
                xv[0] = bflo(x.x); xv[1] = bfhi(x.x); xv[2] = bflo(x.y); xv[3] = bfhi(x.y); xv[4] = bflo(x.z); xv[5] = bfhi(x.z); xv[6] = bflo(x.w); xv[7] = bfhi(x.w); }
            else if (samp) { const float* sc = a.in[I_SCONV] + ((size_t)b * 3 + (3 + tt)) * 512 + c0; const f32x4 s0 = *(const f32x4*)sc, s1 = *(const f32x4*)(sc + 4);
                xv[0] = s0.x; xv[1] = s0.y; xv[2] = s0.z; xv[3] = s0.w; xv[4] = s1.x; xv[5] = s1.y; xv[6] = s1.z; xv[7] = s1.w; }
            else {
#pragma unroll
                for (int i = 0; i < 8; ++i) xv[i] = 0.f; }
            const f32x4 w0 = *(const f32x4*)(a.in[I_CONVW] + w * 512 + c0), w1 = *(const f32x4*)(a.in[I_CONVW] + w * 512 + c0 + 4);
            acc[0] += xv[0] * w0.x; acc[1] += xv[1] * w0.y; acc[2] += xv[2] * w0.z; acc[3] += xv[3] * w0.w; acc[4] += xv[4] * w1.x; acc[5] += xv[5] * w1.y; acc[6] += xv[6] * w1.z; acc[7] += xv[7] * w1.w;
        }
        u32x4 o; o.x = pk2(acc[0], acc[1]); o.y = pk2(acc[2], acc[3]); o.z = pk2(acc[4], acc[5]); o.w = pk2(acc[6], acc[7]);
        *(LAS u32x4*)(lds + RN_XC + t * RN_XCS + c0 * 2) = o;
    }
    if (FINAL) {
        LAS float* hin = (LAS float*)(lds + RN_HIN);
        float hc;
        if (samp) hc = a.in[I_SRNN][(size_t)b * 512 + tid];
        else { hc = 0.f; const float* pa = RA + (size_t)(b * NSEGP) * 512 + tid; const float* pb = RB + (size_t)(b * NSEGP) * 512 + tid;
#pragma unroll 8
            for (int s = 0; s < seg; ++s) hc = pa[(size_t)s * 512] * hc + pb[(size_t)s * 512]; }
        hin[tid] = hc;
    }
    __syncthreads();
    const int r32 = lane & 31, hi = lane >> 5, n = wave;
    const bf16_t* WAt = (const bf16_t*)(ws + WS_RGA) + n * 4096; const bf16_t* WXt = (const bf16_t*)(ws + WS_RGX) + n * 4096;
    float carry[2], aprod[2];
#pragma unroll 1
    for (int jh = 0; jh < 2; ++jh) {
        const int ch = 64 * n + 32 * jh + r32;
        bf16x8 wa[4], wx[4];
#pragma unroll
        for (int c = 0; c < 4; ++c) { wa[c] = *(const bf16x8*)(WAt + (32 * jh + r32) * 64 + 16 * c + 8 * hi); wx[c] = *(const bf16x8*)(WXt + (32 * jh + r32) * 64 + 16 * c + 8 * hi); }
        const float ba = a.in[I_BRGA][ch], bx = a.in[I_BRGX][ch];
        const float lam = a.in[I_LAM][ch]; const float sp = fmaxf(-lam, 0.f) + log1pf(__expf(-fabsf(lam)));
        float cr = FINAL ? ((const LAS float*)(lds + RN_HIN))[ch] : 0.f; float ap = 1.f;
#pragma unroll 1
        for (int th = 0; th < (samp ? 1 : 2); ++th) {
            f32x16 ya = {}, yx = {};
#pragma unroll
            for (int c = 0; c < 4; ++c) { const bf16x8 af = *(const LAS bf16x8*)(lds + RN_XC + (32 * th + r32) * RN_XCS + (64 * n + 16 * c + 8 * hi) * 2);
                ya = __builtin_amdgcn_mfma_f32_32x32x16_bf16(af, wa[c], ya, 0, 0, 0); yx = __builtin_amdgcn_mfma_f32_32x32x16_bf16(af, wx[c], yx, 0, 0, 0); }
#pragma unroll
            for (int r = 0; r < 16; ++r) {
                const int t = 32 * th + crow(r, hi);
                const float xc = bf1(*(const LAS bf16_t*)(lds + RN_XC + t * RN_XCS + ch * 2));
                const float rg = sigmoidf_(ya[r] + ba), ig = sigmoidf_(yx[r] + bx);
                const float la = -8.f * rg * sp; const float av = __expf(la);
                const float mult = sqrtf(fmaxf(1.f - av * av, 0.f));
                ya[r] = av; yx[r] = mult * ig * xc;
            }
#pragma unroll
            for (int g = 0; g < 4; ++g) {
                float h0 = ya[4 * g] * cr + yx[4 * g], h1 = ya[4 * g + 1] * h0 + yx[4 * g + 1], h2 = ya[4 * g + 2] * h1 + yx[4 * g + 2], h3 = ya[4 * g + 3] * h2 + yx[4 * g + 3];
                const float rv = __shfl_xor(h3, 32);
                const float k0 = ya[4 * g] * rv + yx[4 * g], k1 = ya[4 * g + 1] * k0 + yx[4 * g + 1], k2 = ya[4 * g + 2] * k1 + yx[4 * g + 2], k3 = ya[4 * g + 3] * k2 + yx[4 * g + 3];
                ap *= (ya[4 * g] * ya[4 * g + 1]) * (ya[4 * g + 2] * ya[4 * g + 3]);
                if (hi) { h0 = k0; h1 = k1; h2 = k2; h3 = k3; }
                const float back = __shfl_xor(k3, 32);
                cr = hi ? k3 : back;
                if (FINAL) { yx[4 * g] = h0; yx[4 * g + 1] = h1; yx[4 * g + 2] = h2; yx[4 * g + 3] = h3; }
            }
            if (FINAL) {
#pragma unroll
                for (int r = 0; r < 16; ++r) { const int t = 32 * th + crow(r, hi); bf16_t* p = GGRO + (m0 + t) * 512 + ch; *p = (bf16_t)(pk2(yx[r] * bf1(*p), 0.f) & 0xffffu); }
            }
        }
        carry[jh] = cr; aprod[jh] = ap;
    }
#pragma unroll
    for (int jh = 0; jh < 2; ++jh) {
        const int ch = 64 * n + 32 * jh + r32;
        if (!FINAL) { const float ap = aprod[jh] * __shfl_xor(aprod[jh], 32); if (hi == 0) { RA[(size_t)tile * 512 + ch] = ap; RB[(size_t)tile * 512 + ch] = carry[jh]; } }
        else if (hi == 0) { if (samp) a.out[OFF_RS + (size_t)b * 512 + ch] = carry[jh]; else if (seg == NSEGP - 1) a.out[OFF_RP + (size_t)b * 512 + ch] = carry[jh]; }
    }
    __syncthreads();
}

__device__ __forceinline__ void ln1_phase(const Args& a, int lane, int wave) {
    const int gw = blockIdx.x * 8 + wave, NGW = gridDim.x * 8;
    bf16_t* HB = (bf16_t*)(a.ws + WS_XB);
    f32x4 gv[4], bv[4];
#pragma unroll
    for (int j = 0; j < 4; ++j) { gv[j] = *((const f32x4*)a.in[I_LN1G] + lane + 64 * j); bv[j] = *((const f32x4*)a.in[I_LN1B] + lane + 64 * j); }
    for (int m = gw; m < MT; m += NGW) {
        f32x4* row = (f32x4*)(a.out + (size_t)m * DM) + lane;
        f32x4 v[4]; float s = 0.f;
#pragma unroll
        for (int j = 0; j < 4; ++j) { v[j] = row[64 * j]; s += (v[j].x + v[j].y) + (v[j].z + v[j].w); }
        const float mean = wave_sum(s) * (1.f / DM); float s2 = 0.f;
#pragma unroll
        for (int j = 0; j < 4; ++j) { v[j] = v[j] - mean; s2 += (v[j].x * v[j].x + v[j].y * v[j].y) + (v[j].z * v[j].z + v[j].w * v[j].w); }
        const float rstd = 1.f / sqrtf(wave_sum(s2) * (1.f / DM) + LN_EPS);
        u32x2* o8 = (u32x2*)(HB + (size_t)m * DM) + lane;
#pragma unroll
        for (int j = 0; j < 4; ++j) { const f32x4 y = v[j] * rstd * gv[j] + bv[j]; row[64 * j] = y; u32x2 w; w.x = pk2(y.x, y.y); w.y = pk2(y.z, y.w); o8[64 * j] = w; }
    }
}

__device__ __forceinline__ unsigned fkey(float f) { const unsigned u = __float_as_uint(f); return (u & 0x80000000u) ? ~u : (u | 0x80000000u); }
__device__ __forceinline__ float funkey(unsigned k) { const unsigned u = (k & 0x80000000u) ? (k & 0x7fffffffu) : ~k; return __uint_as_float(u); }
__device__ __forceinline__ void cex(unsigned& hi_, unsigned& lo_) { const unsigned x = hi_, y = lo_; hi_ = x > y ? x : y; lo_ = x > y ? y : x; }
__device__ __forceinline__ void sort16_desc(unsigned (&v)[16]) {
#pragma unroll
    for (int k = 2; k <= 16; k <<= 1)
#pragma unroll
        for (int j = k >> 1; j > 0; j >>= 1)
#pragma unroll
            for (int i = 0; i < 16; ++i) { const int l = i ^ j; if (l > i) { if ((i & k) == 0) cex(v[i], v[l]); else cex(v[l], v[i]); } }
}
__device__ __forceinline__ void merge16_desc(unsigned (&v)[16]) {
#pragma unroll
    for (int j = 8; j > 0; j >>= 1)
#pragma unroll
        for (int i = 0; i < 16; ++i) { const int l = i ^ j; if (l > i) cex(v[i], v[l]); }
}
__device__ __forceinline__ void top16_of_two(unsigned (&a_)[16], const unsigned (&b_)[16]) {
#pragma unroll
    for (int i = 0; i < 16; ++i) a_[i] = a_[i] > b_[15 - i] ? a_[i] : b_[15 - i];
    merge16_desc(a_);
}
__device__ __forceinline__ void lane_top16(const f32x16 (&acc)[4], int hi, unsigned (&res)[16]) {
    unsigned g[16];
#pragma unroll
    for (int kt = 0; kt < 4; ++kt) {
#pragma unroll
        for (int r = 0; r < 16; ++r) g[r] = (fkey(acc[kt][r]) & ~127u) | (unsigned)(32 * kt + crow(r, 0));
        sort16_desc(g);
        if (kt == 0) {
#pragma unroll
            for (int r = 0; r < 16; ++r) res[r] = g[r];
        } else top16_of_two(res, g);
    }
#pragma unroll
    for (int r = 0; r < 16; ++r) res[r] |= (unsigned)(4 * hi);
}
constexpr int TK_KEYS = 0, TK_KS = 272, TK_LUT = 2 * 128 * TK_KS;
__device__ __forceinline__ void topk_phase(const Args& a, LAS unsigned char* lds, int tid, int lane, int wave) {
    unsigned char* ws = a.ws;
    const bf16_t* KEYS = (const bf16_t*)(ws + WS_KEYS); const bf16_t* QY = (const bf16_t*)(ws + WS_Q);
    int* IDX = (int*)(ws + WS_IDX); float* GW = (float*)(ws + WS_G);
    for (int i = tid; i < 2 * 128 * 16; i += 512) { const int row = i >> 4, ch = i & 15; *(LAS u32x4*)(lds + TK_KEYS + row * TK_KS + ch * 16) = *(const u32x4*)(KEYS + (size_t)row * 128 + ch * 8); }
    __syncthreads();
    const int r32 = lane & 31, hi = lane >> 5;
    LAS unsigned* lut = (LAS unsigned*)(lds + TK_LUT) + (wave * 64 + lane) * 33;
    const int gw = blockIdx.x * 8 + wave, NGW = gridDim.x * 8;
    for (int task = gw; task < MT * 8 / 32; task += NGW) {
        const size_t R = (size_t)task * 32 + r32;
        unsigned L[2][16];
#pragma unroll
        for (int p = 0; p < 2; ++p) {
            bf16x8 qf[8];
#pragma unroll
            for (int c = 0; c < 8; ++c) qf[c] = *(const bf16x8*)(QY + R * 256 + p * 128 + 16 * c + 8 * hi);
            f32x16 acc[4];
#pragma unroll
            for (int kt = 0; kt < 4; ++kt) { f32x16 s = {};
#pragma unroll
                for (int c = 0; c < 8; ++c) { const bf16x8 kf = *(const LAS bf16x8*)(lds + TK_KEYS + (p * 128 + 32 * kt + r32) * TK_KS + (16 * c + 8 * hi) * 2); s = __builtin_amdgcn_mfma_f32_32x32x16_bf16(kf, qf[c], s, 0, 0, 0); }
                acc[kt] = s; }
            lane_top16(acc, hi, L[p]);
        }
        unsigned mine[16], recv[16];
#pragma unroll
        for (int i = 0; i < 16; ++i) { const unsigned send = hi ? L[0][i] : L[1][i]; recv[i] = __shfl_xor(send, 32); mine[i] = hi ? L[1][i] : L[0][i]; }
        top16_of_two(mine, recv);
        unsigned P[16], Qk[16];
#pragma unroll
        for (int i = 0; i < 16; ++i) { P[i] = mine[i]; Qk[i] = __shfl_xor(mine[i], 32); }
#pragma unroll
        for (int i = 0; i < 16; ++i) { lut[i] = hi ? Qk[i] : P[i]; lut[16 + i] = hi ? P[i] : Qk[i]; }
        float pv[16], qv[16];
#pragma unroll
        for (int i = 0; i < 16; ++i) { pv[i] = funkey(P[i] & ~127u); qv[i] = funkey(Qk[i] & ~127u); }
        unsigned c0[16], c1[16];
        {
            int cnt = 0;
#pragma unroll
            for (int x = 0; x < 4; ++x)
#pragma unroll
                for (int y = x; y < 16; ++y) {
                    if ((x + 1) * (y + 1) <= 16) {
                        const float s = pv[x] + qv[y];
                        unsigned key = (fkey(s) & ~255u) | (hi ? (unsigned)(y * 16 + x) : (unsigned)(x * 16 + y));
                        if (x == y && hi) key = 0u;
                        if (cnt < 16) c0[cnt] = key; else c1[cnt - 16] = key;
                        ++cnt;
                    }
                }
#pragma unroll
            for (int i = 11; i < 16; ++i) c1[i] = 0u;
        }
        sort16_desc(c0); sort16_desc(c1); top16_of_two(c0, c1);
#pragma unroll
        for (int i = 0; i < 16; ++i) c1[i] = __shfl_xor(c0[i], 32);
        top16_of_two(c0, c1);
        asm volatile("s_waitcnt lgkmcnt(0)" ::: "memory");
        float top[16]; int eidx[16]; float mxv = -INFINITY;
#pragma unroll
        for (int w = 0; w < 16; ++w) { const unsigned pay = c0[w] & 255u; const unsigned k1 = lut[pay >> 4], k2 = lut[16 + (pay & 15u)];
            top[w] = funkey(k1 & ~127u) + funkey(k2 & ~127u); eidx[w] = (int)((k1 & 127u) * 128u + (k2 & 127u)); mxv = fmaxf(mxv, top[w]); }
        float se = 0.f;
#pragma unroll
        for (int w = 0; w < 16; ++w) { top[w] = __expf(top[w] - mxv); se += top[w]; }
        const float inv = 1.f / se;
        if (hi == 0) {
#pragma unroll
            for (int w = 0; w < 16; w += 4) { *(int4*)(IDX + R * 16 + w) = make_int4(eidx[w], eidx[w + 1], eidx[w + 2], eidx[w + 3]);
                *(f32x4*)(GW + R * 16 + w) = (f32x4){top[w] * inv, top[w + 1] * inv, top[w + 2] * inv, top[w + 3] * inv}; }
        }
        asm volatile("s_waitcnt lgkmcnt(0)" ::: "memory");
    }
}

constexpr int GA_PART = 0, GA_RED = 8 * 1024 * 4;
__device__ __forceinline__ float dot16_fp8(const u32x4 u, const float (&x)[16]) {
    float s = 0.f;
#pragma unroll
    for (int d = 0; d < 4; ++d) { const f32x2 lo = __builtin_amdgcn_cvt_pk_f32_fp8((int)u[d], false), hi = __builtin_amdgcn_cvt_pk_f32_fp8((int)u[d], true);
        s += lo.x * x[4 * d] + lo.y * x[4 * d + 1] + hi.x * x[4 * d + 2] + hi.y * x[4 * d + 3]; }
    return s;
}
__device__ __forceinline__ void fma16_fp8(float (&acc)[16], const u32x4 v, float w) {
#pragma unroll
    for (int d = 0; d < 4; ++d) { const f32x2 lo = __builtin_amdgcn_cvt_pk_f32_fp8((int)v[d], false), hi = __builtin_amdgcn_cvt_pk_f32_fp8((int)v[d], true);
        acc[4 * d] += w * lo.x; acc[4 * d + 1] += w * lo.y; acc[4 * d + 2] += w * hi.x; acc[4 * d + 3] += w * hi.y; }
}
__device__ __forceinline__ void gather_phase(const Args& a, LAS unsigned char* lds, int tid, int lane, int wave) {
    unsigned char* ws = a.ws;
    const unsigned char* UT = ws + WS_UT; const unsigned char* VT = ws + WS_VT;
    const int* IDX = (const int*)(ws + WS_IDX); const float* GW = (const float*)(ws + WS_G);
    LAS float* part = (LAS float*)(lds + GA_PART); LAS float* red = (LAS float*)(lds + GA_RED);
    const f32x2 g2 = *((const f32x2*)a.in[I_LN2G] + tid), b2 = *((const f32x2*)a.in[I_LN2B] + tid);
    for (int tok = blockIdx.x; tok < MT; tok += gridDim.x) {
        float* hrow = a.out + (size_t)tok * DM;
        const size_t R = (size_t)tok * 8 + wave;
        const int myidx = IDX[R * 16 + (lane & 15)]; const float myg = GW[R * 16 + (lane & 15)];
        float x[16];
#pragma unroll
        for (int j = 0; j < 4; ++j) { const f32x4 t = *(const f32x4*)(hrow + lane * 16 + 4 * j); x[4 * j] = t.x; x[4 * j + 1] = t.y; x[4 * j + 2] = t.z; x[4 * j + 3] = t.w; }
        float pd[16];
#pragma unroll
        for (int k = 0; k < 16; ++k) { const int e = __builtin_amdgcn_readlane(myidx, k); const u32x4 ur = *(const u32x4*)(UT + (size_t)e * DM + lane * 16); pd[k] = dot16_fp8(ur, x); }
        float q8[8], q4[4], q2[2], q1;
#pragma unroll
        for (int i = 0; i < 8; ++i) { const bool up = lane & 1; const float send = up ? pd[i] : pd[i + 8], keep = up ? pd[i + 8] : pd[i]; q8[i] = keep + __shfl_xor(send, 1); }
#pragma unroll
        for (int i = 0; i < 4; ++i) { const bool up = lane & 2; const float send = up ? q8[i] : q8[i + 4], keep = up ? q8[i + 4] : q8[i]; q4[i] = keep + __shfl_xor(send, 2); }
#pragma unroll
        for (int i = 0; i < 2; ++i) { const bool up = lane & 4; const float send = up ? q4[i] : q4[i + 2], keep = up ? q4[i + 2] : q4[i]; q2[i] = keep + __shfl_xor(send, 4); }
        { const bool up = lane & 8; const float send = up ? q2[0] : q2[1], keep = up ? q2[1] : q2[0]; q1 = keep + __shfl_xor(send, 8); }
        q1 += __shfl_xor(q1, 16); q1 += __shfl_xor(q1, 32);
        const int kmap = ((lane & 1) << 3) | ((lane & 2) << 1) | ((lane & 4) >> 1) | ((lane & 8) >> 3);
        const float wgt = __shfl(myg, kmap) * gelu_tanh(q1 * (1.f / U8_SCALE)) * (1.f / V8_SCALE);
        float oa[16];
#pragma unroll
        for (int i = 0; i < 16; ++i) oa[i] = 0.f;
#pragma unroll
        for (int k = 0; k < 16; ++k) { const int e = __builtin_amdgcn_readlane(myidx, k);
            const int src = ((k & 1) << 3) | ((k & 2) << 1) | ((k & 4) >> 1) | ((k & 8) >> 3);
            const float wk = __uint_as_float(__builtin_amdgcn_readlane(__float_as_uint(wgt), src));
            const u32x4 vr = *(const u32x4*)(VT + (size_t)e * DM + lane * 16); fma16_fp8(oa, vr, wk); }
        LAS float* pw = part + wave * 1024 + lane * 16;
#pragma unroll
        for (int j = 0; j < 4; ++j) *(LAS f32x4*)(pw + 4 * j) = (f32x4){oa[4 * j], oa[4 * j + 1], oa[4 * j + 2], oa[4 * j + 3]};
        __syncthreads();
        const f32x2 hv = *((const f32x2*)hrow + tid);
        float v0 = DN_ALPHA * hv.x, v1 = DN_ALPHA * hv.y;
#pragma unroll
        for (int w = 0; w < 8; ++w) { const f32x2 p = *(const LAS f32x2*)(part + w * 1024 + 2 * tid); v0 += p.x; v1 += p.y; }
        float s = wave_sum(v0 + v1);
        if (lane == 0) red[wave] = s;
        __syncthreads();
        float tot = 0.f;
#pragma unroll
        for (int w = 0; w < 8; ++w) tot += red[w];
        const float mean = tot * (1.f / DM);
        const float d0 = v0 - mean, d1 = v1 - mean;
        float s2 = wave_sum(d0 * d0 + d1 * d1);
        if (lane == 0) red[8 + wave] = s2;
        __syncthreads();
        float tot2 = 0.f;
#pragma unroll
        for (int w = 0; w < 8; ++w) tot2 += red[8 + w];
        const float rstd = 1.f / sqrtf(tot2 * (1.f / DM) + LN_EPS);
        *((f32x2*)hrow + tid) = (f32x2){d0 * rstd * g2.x + b2.x, d1 * rstd * g2.y + b2.y};
    }
}

constexpr int NPH = 10;
__global__ void __launch_bounds__(512, 2) fox_peer_fwd(Args a) {
    extern __shared__ __attribute__((aligned(16))) unsigned char lds_raw[];
    LAS unsigned char* lds = (LAS unsigned char*)lds_raw;
    cg::grid_group grid = cg::this_grid();
    const int tid = threadIdx.x, lane = tid & 63, wave = __builtin_amdgcn_readfirstlane(tid >> 6);
    const int G = gridDim.x;
    unsigned char* ws = a.ws;
    const int lo = a.ph_lo, hi_ = a.ph_hi;
    volatile LAS unsigned* xst = (volatile LAS unsigned*)(lds + LDS_BYTES - 16);
    if (tid < 2) xst[tid] = 0u;
    __syncthreads();
    XcdBarrier xbar = xcd_barrier_post((unsigned*)(ws + WS_CTL), xst);
#ifndef PHMASK
#define PHMASK 0x3ff
#endif
#define IN(k) (((PHMASK >> (k)) & 1) && lo <= (k) && (k) < hi_)
#define SEAM(k) do { if (IN(k) && IN((k) + 1)) { if ((k) == 0) grid.sync(); else xcd_barrier(xbar); } } while (0)

    if (IN(0)) { p0_prologue(a, lds, tid, lane, wave); }
    SEAM(0);
    if (IN(1)) {
        pg8::Gemm g{(const bf16_t*)(ws + WS_XB), (const bf16_t*)(ws + WS_WIN), MT, NIN, DM}; pg8::StaticOrder S; S.init(MT, NIN, G, (int)blockIdx.x);
        Epi1 E{a.out, ws};
        pg8::gemm_phase<Epi1, pg8::StaticOrder, true, true>(lds, g, S, E);
    }
    SEAM(1);
    if (IN(2)) {
        for (int t = blockIdx.x; t < NBATCH * NSEGP; t += G) rnn_tile<false>(a, lds, t, tid, lane, wave);
        for (int u = blockIdx.x; u < DBATCH * NH; u += G) attn_sample_unit(a, lds, u >> 3, u & 7, tid, lane, wave);
        for (int v = blockIdx.x; v < 256; v += G) {
            const int bh = v >> 2, s = v & 3;
#pragma unroll 1
            for (int i = 0; i < 4; ++i) { const int qb = (i == 0) ? s : (i == 1) ? 7 - s : (i == 2) ? 8 + s : 15 - s; attn_prompt_unit(a, lds, bh >> 3, bh & 7, qb, tid, lane, wave); __syncthreads(); }
        }
    }
    SEAM(2);
    if (IN(3)) { for (int t = blockIdx.x; t < NBATCH * NSEGP + DBATCH; t += G) rnn_tile<true>(a, lds, t, tid, lane, wave); }
    SEAM(3);
    if (IN(4)) {
        { pg8::Gemm g{(const bf16_t*)(ws + WS_Q), (const bf16_t*)(ws + WS_WA), MT, DM, DA}; pg8::StaticOrder S; S.init(MT, DM, G, (int)blockIdx.x);
          EpiUp<0> E{(const bf16_t*)(ws + WS_SA), (bf16_t*)(ws + WS_K)}; pg8::gemm_phase<EpiUp<0>, pg8::StaticOrder, true, true>(lds, g, S, E); }
        { pg8::Gemm g{(const bf16_t*)(ws + WS_GG), (const bf16_t*)(ws + WS_WR), MT, DM, DR}; pg8::StaticOrder S; S.init(MT, DM, G, (int)blockIdx.x);
          EpiUp<1> E{(const bf16_t*)(ws + WS_SR), (bf16_t*)(ws + WS_K)}; pg8::gemm_phase<EpiUp<1>, pg8::StaticOrder, true, true>(lds, g, S, E); }
    }
    SEAM(4);
    if (IN(5)) {
        pg8::Gemm g{(const bf16_t*)(ws + WS_K), (const bf16_t*)(ws + WS_WO), MT, DM, DM}; pg8::StaticOrder S; S.init(MT, DM, G, (int)blockIdx.x);
        EpiOut E{a.in[I_XP], a.in[I_XS], a.out}; pg8::gemm_phase<EpiOut, pg8::StaticOrder, true, true>(lds, g, S, E);
    }
    SEAM(5);
    if (IN(6)) { ln1_phase(a, lane, wave); }
    SEAM(6);
    if (IN(7)) {
        pg8::Gemm g{(const bf16_t*)(ws + WS_XB), (const bf16_t*)(ws + WS_WQ), MT, NQ, DM}; pg8::StaticOrder S; S.init(MT, NQ, G, (int)blockIdx.x);
        EpiQy E{(bf16_t*)(ws + WS_Q)}; pg8::gemm_phase<EpiQy, pg8::StaticOrder, true, true>(lds, g, S, E);
    }
    SEAM(7);
    if (IN(8)) { topk_phase(a, lds, tid, lane, wave); }
    SEAM(8);
    if (IN(9)) { gather_phase(a, lds, tid, lane, wave); }
#undef IN
#undef SEAM
}

#ifndef N_LAUNCHES
#define N_LAUNCHES 1
#endif
extern "C" void kernel_launch(void* const* d_in, const int* in_sizes, int n_in, void* d_out, int out_size, void* d_ws, size_t ws_size, hipStream_t stream) {
    static int grid = 0;
    if (grid == 0) {
        if (n_in != 28 || (size_t)out_size != OUT_TOTAL || ws_size < WS_END) { fprintf(stderr, "kernel_launch: unexpected problem: n_in %d out %d ws %zu\n", n_in, out_size, ws_size); grid = -1; return; }
        int dev = 0, cus = 0, per_cu = 0;
        hipGetDevice(&dev); hipDeviceGetAttribute(&cus, hipDeviceAttributeMultiprocessorCount, dev);
        if (hipFuncSetAttribute((const void*)fox_peer_fwd, hipFuncAttributeMaxDynamicSharedMemorySize, LDS_BYTES) != hipSuccess) { fprintf(stderr, "kernel_launch: hipFuncSetAttribute failed\n"); grid = -1; return; }
        if (hipOccupancyMaxActiveBlocksPerMultiprocessor(&per_cu, (const void*)fox_peer_fwd, 512, LDS_BYTES) != hipSuccess || per_cu < 1) { fprintf(stderr, "kernel_launch: occupancy query gave %d\n", per_cu); per_cu = 1; }
        (void)hipGetLastError();
        grid = cus * (per_cu < 1 ? 1 : per_cu);
    }
    if (grid < 0) return;
    if (hipMemsetAsync((char*)d_ws + WS_CTL, 0, 16384, stream) != hipSuccess) { fprintf(stderr, "kernel_launch: memset failed\n"); return; }
    Args a{};
    for (int i = 0; i < 28; ++i) a.in[i] = (const float*)d_in[i];
    a.out = (float*)d_out; a.ws = (unsigned char*)d_ws;
#if N_LAUNCHES == 1
    a.ph_lo = 0; a.ph_hi = NPH;
    void* args[] = {&a};
    hipError_t e = hipLaunchCooperativeKernel((const void*)fox_peer_fwd, dim3(grid), dim3(512), args, LDS_BYTES, stream);
    if (e != hipSuccess) fprintf(stderr, "cooperative launch failed: %s (grid %d)\n", hipGetErrorString(e), grid);
#else
    for (int p = 0; p < NPH; ++p) { a.ph_lo = p; a.ph_hi = p + 1; hipLaunchKernelGGL(fox_peer_fwd, dim3(grid), dim3(512), LDS_BYTES, stream, a); }
#endif
}
```

```cpp
#include <hip/hip_runtime.h>
#include <hip/hip_cooperative_groups.h>
#include <cstdio>
#include <cstdint>
namespace cg = cooperative_groups;
namespace pg8 {
#define PG8_LAS __attribute__((address_space(3)))
typedef unsigned short bf16_t;
typedef short bf16x8 __attribute__((ext_vector_type(8)));
typedef float f32x4 __attribute__((ext_vector_type(4)));
typedef unsigned u32x4 __attribute__((ext_vector_type(4)));
constexpr int BM = 256, BK = 64, HALF = 128, HTB = HALF * BK * 2  , STAGE_BYTES = 8 * HTB, NXCD = 8, WGM = 8;

__host__ __device__ __forceinline__ int lds_byte(int r, int c) { const int st = (r >> 4) * 2 + (c >> 5), rr = r & 15, cc = c & 31, ob = rr * 64 + cc * 2; return st * 1024 + (ob ^ (((ob >> 9) & 1) << 5)); }
__host__ __device__ __forceinline__ void stage_rc(int b, int& R, int& C) { const int st = b / 1024, sb = b % 1024, swz = sb ^ (((sb >> 9) & 1) << 5); R = (st >> 1) * 16 + swz / 64; C = (st & 1) * 32 + (swz % 64) / 2; }
__host__ __device__ __forceinline__ int perm32(int rho) { const int n = rho >> 4, i = rho & 15; return 8 * (i >> 2) + 4 * n + (i & 3); }

struct Unit { int pm, pn; };
struct Gemm { const bf16_t* A; const bf16_t* Bt; int M, N, K; };

struct StaticOrder {
    int nM, nN, nwg, G, c;
    __host__ __device__ void init(int M, int N, int G_, int c_) { nM = M / BM; nN = N / BM; nwg = nM * nN; G = G_; c = c_; }
    __host__ __device__ bool next(int i, Unit& u) const {
        const long L = (long)i * G + c; if (L >= nwg) return false;
        int wgid = (int)L; { const int q = nwg / NXCD, r = nwg % NXCD, xcd = wgid % NXCD, off = wgid / NXCD; wgid = (xcd < r ? xcd * (q + 1) : r * (q + 1) + (xcd - r) * q) + off; }
        const int nig = WGM * nN, gid = wgid / nig, fm = gid * WGM, gsz = (nM - fm) < WGM ? (nM - fm) : WGM;
        u.pm = fm + ((wgid % nig) % gsz); u.pn = (wgid % nig) / gsz; return true;
    }
    __device__ __forceinline__ void a_ready(const Unit&) const {}
    __device__ __forceinline__ void done(const Unit&) const {}
};

__device__ __forceinline__ unsigned cvt_pk_bf16(float lo, float hi) { unsigned r; asm volatile("v_cvt_pk_bf16_f32 %0, %1, %2" : "=v"(r) : "v"(lo), "v"(hi)); return r; }
template <class Epi, class Sched, bool ALIGN_EPI = false, bool SP2 = false>
__device__ __forceinline__ void gemm_phase(PG8_LAS unsigned char* lds, const Gemm g, const Sched& S, const Epi& E) {
    const int tid = threadIdx.x, wid = __builtin_amdgcn_readfirstlane(tid >> 6), lane = tid & 63, wr = wid >> 2, wc = wid & 3, fr = lane & 15, fq = lane >> 4;
    const int K = g.K, nt = K / BK;
    unsigned voffA[2], voffB[2];
#pragma unroll
    for (int i = 0; i < 2; ++i) { int R, C; stage_rc(tid * 16 + i * 8192, R, C); const int Rb = Epi::PERM ? ((R & ~31) + perm32(R & 31)) : R;
        voffA[i] = (unsigned)(R * K + C) * 2u; voffB[i] = (unsigned)(Rb * K + C) * 2u; }
    const size_t kstep = (size_t)(BK * 2);
    const size_t hstep = (size_t)HALF * K * 2;
    const size_t tstep = 2 * hstep;
    const unsigned ldsw = (unsigned)wid * 1024u;
    const int aoff = lds_byte(wr * 64 + fr, fq * 8), boff = lds_byte(wc * 32 + fr, fq * 8);
#define PG8_SA(b, h) (((b) * 2 + (h)) * HTB)
#define PG8_SB(b, h) ((4 + (b) * 2 + (h)) * HTB)
#define PG8_STAGE(bufoff, gbase, voff) do { _Pragma("unroll") for (int _i = 0; _i < 2; ++_i) \
        __builtin_amdgcn_global_load_lds((const unsigned*)((const char*)(gbase) + (voff)[_i]), (PG8_LAS unsigned*)(lds + (bufoff) + ldsw + _i * 8192), 16, 0, 0); } while (0)
#define PG8_LDA(dst, b, h) do { _Pragma("unroll") for (int m = 0; m < 4; ++m) _Pragma("unroll") for (int k = 0; k < 2; ++k) dst[m][k] = *(const PG8_LAS bf16x8*)(lds + PG8_SA(b, h) + aoff + m * 2048 + k * 1024); } while (0)
#define PG8_LDB(dst, b, h) do { _Pragma("unroll") for (int n = 0; n < 2; ++n) _Pragma("unroll") for (int k = 0; k < 2; ++k) dst[n][k] = *(const PG8_LAS bf16x8*)(lds + PG8_SB(b, h) + boff + n * 2048 + k * 1024); } while (0)
#define PG8_MMA(ai, bj, At, Bt) do { __builtin_amdgcn_s_setprio(1); _Pragma("unroll") for (int m = 0; m < 4; ++m) _Pragma("unroll") for (int n = 0; n < 2; ++n) _Pragma("unroll") for (int k = 0; k < 2; ++k) \
        acc[ai][bj][m][n] = __builtin_amdgcn_mfma_f32_16x16x32_bf16(Bt[n][k], At[m][k], acc[ai][bj][m][n], 0, 0, 0); __builtin_amdgcn_s_setprio(0); } while (0)
#define PG8_WAIT_V(n) asm volatile("s_waitcnt vmcnt(" #n ")" ::: "memory")
#define PG8_WAIT_L(n) asm volatile("s_waitcnt lgkmcnt(" #n ")" ::: "memory")
#define PG8_BAR __builtin_amdgcn_s_barrier()
#define PG8_SCHED __builtin_amdgcn_sched_barrier(0)
    Unit cur, nxt; int ui = 0;
    if (!S.next(0, cur)) return;
    f32x4 acc[2][2][4][2];
#pragma unroll
    for (int a = 0; a < 2; ++a)
#pragma unroll
        for (int b = 0; b < 2; ++b)
#pragma unroll
            for (int m = 0; m < 4; ++m)
#pragma unroll
                for (int n = 0; n < 2; ++n) acc[a][b][m][n] = (f32x4){0.f, 0.f, 0.f, 0.f};
    bf16x8 At[4][2], B0[2][2], B1[2][2];
    const char* cA = (const char*)g.A + (size_t)cur.pm * tstep; const char* cB = (const char*)g.Bt + (size_t)cur.pn * tstep;
    S.a_ready(cur);
    if constexpr (SP2) {
        PG8_STAGE(PG8_SB(0, 0), cB, voffB); PG8_STAGE(PG8_SB(0, 1), cB + hstep, voffB); PG8_STAGE(PG8_SA(0, 0), cA, voffA); PG8_STAGE(PG8_SA(0, 1), cA + hstep, voffA);
        if (wr == 1) PG8_BAR;
        PG8_WAIT_V(2); PG8_BAR;
        PG8_STAGE(PG8_SB(1, 0), cB + kstep, voffB); PG8_STAGE(PG8_SA(1, 0), cA + kstep, voffA); PG8_STAGE(PG8_SB(1, 1), cB + hstep + kstep, voffB);
        PG8_WAIT_V(6); PG8_BAR;
    } else {
        PG8_STAGE(PG8_SB(0, 0), cB, voffB); PG8_STAGE(PG8_SA(0, 0), cA, voffA); PG8_STAGE(PG8_SB(0, 1), cB + hstep, voffB); PG8_STAGE(PG8_SA(0, 1), cA + hstep, voffA);
        if (wr == 1) PG8_BAR;
        PG8_WAIT_V(4); PG8_BAR;
        PG8_STAGE(PG8_SB(1, 0), cB + kstep, voffB); PG8_STAGE(PG8_SA(1, 0), cA + kstep, voffA); PG8_STAGE(PG8_SB(1, 1), cB + hstep + kstep, voffB);
        PG8_WAIT_V(6); PG8_BAR;
    }
    for (;;) {
        const bool has_next = S.next(ui + 1, nxt);
        const char* nA = has_next ? (const char*)g.A + (size_t)nxt.pm * tstep : cA; const char* nB = has_next ? (const char*)g.Bt + (size_t)nxt.pn * tstep : cB;
        for (int t = 0; t < nt; t += 2) {
            const bool last = (t == nt - 2);
            const char* a1 = cA + (size_t)(t + 1) * kstep;
            const char* a2 = last ? nA : cA + (size_t)(t + 2) * kstep; const char* b2 = last ? nB : cB + (size_t)(t + 2) * kstep;
            const char* a3 = a2 + kstep; const char* b3 = b2 + kstep;
            if (last && has_next) S.a_ready(nxt);
            if constexpr (SP2) {
            PG8_LDB(B0, 0, 0); PG8_LDB(B1, 0, 1); PG8_SCHED; PG8_LDA(At, 0, 0); PG8_STAGE(PG8_SA(1, 1), a1 + hstep, voffA);
            PG8_WAIT_V(8); PG8_WAIT_L(0); PG8_BAR; PG8_MMA(0, 0, At, B0); PG8_MMA(0, 1, At, B1); PG8_BAR; PG8_SCHED;
            PG8_LDA(At, 0, 1); PG8_STAGE(PG8_SB(0, 0), b2, voffB); PG8_STAGE(PG8_SB(0, 1), b2 + hstep, voffB); PG8_STAGE(PG8_SA(0, 0), a2, voffA);
            PG8_WAIT_V(8); PG8_WAIT_L(0); PG8_BAR; PG8_MMA(1, 0, At, B0); PG8_MMA(1, 1, At, B1); PG8_BAR; PG8_SCHED;
            PG8_LDB(B0, 1, 0); PG8_LDB(B1, 1, 1); PG8_SCHED; PG8_LDA(At, 1, 0); PG8_STAGE(PG8_SA(0, 1), a2 + hstep, voffA);
            PG8_WAIT_V(8); PG8_WAIT_L(0); PG8_BAR; PG8_MMA(0, 0, At, B0); PG8_MMA(0, 1, At, B1); PG8_BAR; PG8_SCHED;
            PG8_LDA(At, 1, 1); PG8_STAGE(PG8_SB(1, 0), b3, voffB); PG8_STAGE(PG8_SB(1, 1), b3 + hstep, voffB); PG8_STAGE(PG8_SA(1, 0), a3, voffA);
            PG8_WAIT_V(8); PG8_WAIT_L(0); PG8_BAR; PG8_MMA(1, 0, At, B0); PG8_MMA(1, 1, At, B1); PG8_BAR; PG8_SCHED;
            } else {
            PG8_LDB(B0, 0, 0); PG8_SCHED; PG8_LDA(At, 0, 0); PG8_STAGE(PG8_SA(1, 1), a1 + hstep, voffA);
            PG8_WAIT_L(8); PG8_BAR; PG8_WAIT_L(0); PG8_MMA(0, 0, At, B0); PG8_BAR; PG8_SCHED;
            PG8_LDB(B1, 0, 1); PG8_STAGE(PG8_SB(0, 0), b2, voffB);
            PG8_BAR; PG8_WAIT_L(0); PG8_MMA(0, 1, At, B1); PG8_BAR;
            PG8_LDA(At, 0, 1); PG8_STAGE(PG8_SA(0, 0), a2, voffA);
            PG8_BAR; PG8_WAIT_L(0); PG8_MMA(1, 0, At, B0); PG8_BAR; PG8_SCHED;
            PG8_STAGE(PG8_SB(0, 1), b2 + hstep, voffB);
            PG8_WAIT_V(6); PG8_BAR; PG8_MMA(1, 1, At, B1); PG8_BAR;
            PG8_LDB(B0, 1, 0); PG8_SCHED; PG8_LDA(At, 1, 0); PG8_STAGE(PG8_SA(0, 1), a2 + hstep, voffA);
            PG8_WAIT_L(8); PG8_BAR; PG8_WAIT_L(0); PG8_MMA(0, 0, At, B0); PG8_BAR; PG8_SCHED;
            PG8_LDB(B1, 1, 1); PG8_STAGE(PG8_SB(1, 0), b3, voffB);
            PG8_BAR; PG8_WAIT_L(0); PG8_MMA(0, 1, At, B1); PG8_BAR;
            PG8_LDA(At, 1, 1); PG8_STAGE(PG8_SA(1, 0), a3, voffA);
            PG8_BAR; PG8_WAIT_L(0); PG8_MMA(1, 0, At, B0); PG8_BAR; PG8_SCHED;
            PG8_STAGE(PG8_SB(1, 1), b3 + hstep, voffB);
            PG8_WAIT_V(6); PG8_BAR; PG8_MMA(1, 1, At, B1); PG8_BAR;
            }
        }
        if constexpr (ALIGN_EPI) { if (wr == 0) PG8_BAR; }
        if constexpr (!Epi::AFTER_DRAIN) { E(acc, cur, wr, wc, fr, fq); S.done(cur); }
        if (!has_next) break;
#pragma unroll
        for (int a = 0; a < 2; ++a)
#pragma unroll
            for (int b = 0; b < 2; ++b)
#pragma unroll
                for (int m = 0; m < 4; ++m)
#pragma unroll
                    for (int n = 0; n < 2; ++n) acc[a][b][m][n] = (f32x4){0.f, 0.f, 0.f, 0.f};
        cur = nxt; cA = nA; cB = nB; ++ui;
        if constexpr (ALIGN_EPI) { if (wr == 1) PG8_BAR; }
    }
    PG8_WAIT_V(0);
    if constexpr (!ALIGN_EPI) { if (wr == 0) PG8_BAR; }
    PG8_BAR;
    if constexpr (Epi::AFTER_DRAIN) { E.fused(acc, cur, wr, wc, fr, fq, lds, wid, lane); S.done(cur); }
#undef PG8_SA
#undef PG8_SB
#undef PG8_STAGE
#undef PG8_LDA
#undef PG8_LDB
#undef PG8_MMA
#undef PG8_WAIT_V
#undef PG8_WAIT_L
#undef PG8_BAR
#undef PG8_SCHED
}
}

#define LAS __attribute__((address_space(3)))
typedef unsigned short bf16_t;
typedef short bf16x8 __attribute__((ext_vector_type(8)));
typedef float f32x4 __attribute__((ext_vector_type(4)));
typedef float f32x2 __attribute__((ext_vector_type(2)));
typedef float f32x16 __attribute__((ext_vector_type(16)));
typedef unsigned u32x4 __attribute__((ext_vector_type(4)));
typedef unsigned u32x2 __attribute__((ext_vector_type(2)));
typedef short v4i16_t __attribute__((ext_vector_type(4)));
typedef __bf16 bf16x2_t __attribute__((ext_vector_type(2)));

constexpr int DM = 1024, NBATCH = 8, SEQ = 4096, DBATCH = 16, DSEQ = 32, PAST = 1024, NH = 8, HD = 64, DA = 512, DR = 512;
constexpr int MP = NBATCH * SEQ, MS = DBATCH * DSEQ, MT = MP + MS;
constexpr int DIN = 4616, NIN = 4608, NE = 16384, NQ = 2048;
constexpr float LN_EPS = 1e-5f, DN_ALPHA = 1.189207115002721f, LOG2E = 1.4426950408889634f;
constexpr int NSEGP = SEQ / 64;
constexpr size_t OFF_KP = 34078720, OFF_VP = 50855936, OFF_FP = 67633152, OFF_CP = 67895296, OFF_RP = 67907584,
                 OFF_KS = 67911680, OFF_VS = 68173824, OFF_FS = 68435968, OFF_CS = 68440064, OFF_RS = 68464640, OUT_TOTAL = 68472832;
constexpr size_t MiB = 1u << 20;
constexpr size_t WS_XB = 0;
constexpr size_t WS_WIN = 65 * MiB;
constexpr size_t WS_WA = 74 * MiB, WS_WR = 75 * MiB, WS_WO = 76 * MiB, WS_WQ = 78 * MiB;
constexpr size_t WS_KEYS = 82 * MiB, WS_RGA = 82 * MiB + 65536, WS_RGX = 82 * MiB + 131072;
constexpr size_t WS_UT = 83 * MiB, WS_VT = 115 * MiB;
constexpr size_t QKV_BYTES = (size_t)MT * 512 * 2;
constexpr size_t WS_Q = 147 * MiB, WS_K = WS_Q + QKV_BYTES, WS_V = WS_K + QKV_BYTES, WS_XR = WS_V + QKV_BYTES;
constexpr size_t WS_GG = 277 * MiB;
constexpr size_t WS_SA = WS_GG + QKV_BYTES, WS_SR = WS_SA + 2 * QKV_BYTES;
constexpr size_t WS_LC = 440 * MiB, WS_SCH = 442 * MiB, WS_RA = 442 * MiB + 65536, WS_RB = WS_RA + MiB;
constexpr size_t WS_IDX = 445 * MiB, WS_G = 462 * MiB, WS_CTL = 479 * MiB, WS_END = 480 * MiB;
static_assert(WS_XR + QKV_BYTES <= WS_GG && WS_SR + 2 * QKV_BYTES <= WS_LC && WS_IDX + (size_t)MT * 8 * 16 * 4 <= WS_G && WS_G + (size_t)MT * 8 * 16 * 4 <= WS_END, "ws map");

constexpr int LDS_BYTES = 147456;

struct Args { const float* in[28]; float* out; unsigned char* ws; int ph_lo, ph_hi; };
#define ARGS_T const __attribute__((address_space(4))) Args&
enum { I_XP = 0, I_XS, I_CK, I_CV, I_CLF, I_SCONV, I_SRNN, I_WIN, I_BF, I_CONVW, I_CONVB, I_RGA, I_BRGA, I_RGX, I_BRGX, I_LAM, I_WAUP, I_WRUP, I_WOUT, I_LN1G, I_LN1B,
       I_WQ, I_K1, I_K2, I_PU, I_PV, I_LN2G, I_LN2B };

__device__ __forceinline__ unsigned pk2(float lo, float hi) { f32x2 v = {lo, hi}; bf16x2_t b = __builtin_convertvector(v, bf16x2_t); return __builtin_bit_cast(unsigned, b); }
__device__ __forceinline__ float bflo(unsigned u) { return __uint_as_float(u << 16); }
__device__ __forceinline__ float bfhi(unsigned u) { return __uint_as_float(u & 0xffff0000u); }
__device__ __forceinline__ float bf1(bf16_t b) { return __uint_as_float((unsigned)b << 16); }
__device__ __forceinline__ float sigmoidf_(float x) { return __builtin_amdgcn_rcpf(1.f + __expf(-x)); }
__device__ __forceinline__ float gelu_tanh(float x) { const float u = 0.7978845608028654f * (x + 0.044715f * x * x * x); return x * sigmoidf_(2.f * u); }
__device__ __forceinline__ const float* xrow_ptr(ARGS_T a, int m) { return m < MP ? a.in[I_XP] + (size_t)m * DM : a.in[I_XS] + (size_t)(m - MP) * DM; }
__device__ __forceinline__ float wave_sum(float v) {
#pragma unroll
    for (int o = 1; o < 64; o <<= 1) v += __shfl_xor(v, o);
    return v;
}
__device__ __forceinline__ int crow(int r, int hi) { return (r & 3) + 8 * (r >> 2) + 4 * hi; }

__device__ __forceinline__ void transpose_item(const float* W, int ldw, bf16_t* WT, int ldk, LAS float* scr, int k0, int n0src, int n0dst, int lane) {
#pragma unroll 8
    for (int i = 0; i < 32; ++i) { const int kk = 2 * i + (lane >> 5); scr[kk * 33 + (lane & 31)] = W[(size_t)(k0 + kk) * ldw + n0src + (lane & 31)]; }
    asm volatile("s_waitcnt lgkmcnt(0)" ::: "memory");
    const int c = lane & 7;
#pragma unroll
    for (int j = 0; j < 4; ++j) { const int n = (lane >> 3) + 8 * j; const LAS float* s = scr + (8 * c) * 33 + n;
        u32x4 o; o.x = pk2(s[0 * 33], s[1 * 33]); o.y = pk2(s[2 * 33], s[3 * 33]); o.z = pk2(s[4 * 33], s[5 * 33]); o.w = pk2(s[6 * 33], s[7 * 33]);
        *(u32x4*)(WT + (size_t)(n0dst + n) * ldk + k0 + 8 * c) = o; }
    asm volatile("s_waitcnt lgkmcnt(0)" ::: "memory");
}
__device__ __forceinline__ void cvt8(const float* src, bf16_t* dst, size_t i) {
    const f32x4 v0 = *(const f32x4*)(src + i * 8), v1 = *(const f32x4*)(src + i * 8 + 4);
    u32x4 o; o.x = pk2(v0.x, v0.y); o.y = pk2(v0.z, v0.w); o.z = pk2(v1.x, v1.y); o.w = pk2(v1.z, v1.w);
    *(u32x4*)(dst + i * 8) = o;
}
constexpr float U4_SCALE = 64.f, V4_SCALE = 9.5f;
__device__ __forceinline__ void cvt16_fp4(const float* src, unsigned char* dst, size_t i, float sc) {
    const f32x4 v0 = *(const f32x4*)(src + i * 16) * sc, v1 = *(const f32x4*)(src + i * 16 + 4) * sc, v2 = *(const f32x4*)(src + i * 16 + 8) * sc, v3 = *(const f32x4*)(src + i * 16 + 12) * sc;
    unsigned lo = 0u, hi = 0u;
    lo = __builtin_amdgcn_cvt_scalef32_pk_fp4_f32(lo, v0.x, v0.y, 1.0f, 0); lo = __builtin_amdgcn_cvt_scalef32_pk_fp4_f32(lo, v0.z, v0.w, 1.0f, 1);
    lo = __builtin_amdgcn_cvt_scalef32_pk_fp4_f32(lo, v1.x, v1.y, 1.0f, 2); lo = __builtin_amdgcn_cvt_scalef32_pk_fp4_f32(lo, v1.z, v1.w, 1.0f, 3);
    hi = __builtin_amdgcn_cvt_scalef32_pk_fp4_f32(hi, v2.x, v2.y, 1.0f, 0); hi = __builtin_amdgcn_cvt_scalef32_pk_fp4_f32(hi, v2.z, v2.w, 1.0f, 1);
    hi = __builtin_amdgcn_cvt_scalef32_pk_fp4_f32(hi, v3.x, v3.y, 1.0f, 2); hi = __builtin_amdgcn_cvt_scalef32_pk_fp4_f32(hi, v3.z, v3.w, 1.0f, 3);
    *(u32x2*)(dst + i * 8) = (u32x2){lo, hi};
}
template <int PART> __device__ __forceinline__ void p0_prologue(ARGS_T a, LAS unsigned char* lds, int tid, int lane, int wave, int vblk, int nblk) {
    unsigned char* ws = a.ws;
    const int G = nblk, gw = vblk * 8 + wave, NGW = G * 8;
    {
        LAS float* scr = (LAS float*)(lds + wave * 8448);
        constexpr int I0 = 16 * 144, I1 = 8 * 32, I2 = 8 * 32, I3 = 16 * 32, I4 = 16 * 64, I5 = 16, I6 = 16, NIT = I0 + I1 + I2 + I3 + I4 + I5 + I6;
        const int TF = NIT / NGW, TL = NIT - TF * NGW, tl_idx = wave * G + vblk;
        const int tmine = TF + (tl_idx < TL ? 1 : 0);
        for (int k2 = 0; k2 < tmine; ++k2) {
            const int it = k2 < TF ? gw + k2 * NGW : TF * NGW + tl_idx;
            { const bool deferred = (it >= I0 && it < I0 + I1 + I2 + I3 + I4); if (deferred != (PART == 1)) continue; }
            int r = it;
            if (r < I0) { const int kb = r / 144, nb = r % 144, n0 = 32 * nb; transpose_item(a.in[I_WIN], DIN, (bf16_t*)(ws + WS_WIN), 1024, scr, 64 * kb, n0 + (n0 >= 1536 ? 8 : 0), n0, lane); continue; } r -= I0;
            if (r < I1) { transpose_item(a.in[I_WAUP], 1024, (bf16_t*)(ws + WS_WA), 512, scr, 64 * (r / 32), 32 * (r % 32), 32 * (r % 32), lane); continue; } r -= I1;
            if (r < I2) { transpose_item(a.in[I_WRUP], 1024, (bf16_t*)(ws + WS_WR), 512, scr, 64 * (r / 32), 32 * (r % 32), 32 * (r % 32), lane); continue; } r -= I2;
            if (r < I3) { transpose_item(a.in[I_WOUT], 1024, (bf16_t*)(ws + WS_WO), 1024, scr, 64 * (r / 32), 32 * (r % 32), 32 * (r % 32), lane); continue; } r -= I3;
            if (r < I4) { transpose_item(a.in[I_WQ], 2048, (bf16_t*)(ws + WS_WQ), 1024, scr, 64 * (r / 64), 32 * (r % 64), 32 * (r % 64), lane); continue; } r -= I4;
            if (r < I5) { const int n = r >> 1, nb = r & 1; transpose_item(a.in[I_RGA] + n * 4096, 64, (bf16_t*)(ws + WS_RGA) + n * 4096, 64, scr, 0, 32 * nb, 32 * nb, lane); continue; } r -= I5;
            { const int n = r >> 1, nb = r & 1; transpose_item(a.in[I_RGX] + n * 4096, 64, (bf16_t*)(ws + WS_RGX) + n * 4096, 64, scr, 0, 32 * nb, 32 * nb, lane); }
        }
    }
    {
        const unsigned stride = (unsigned)G * 512u, t0 = (unsigned)vblk * 512u + (unsigned)tid;
#define CVT_LOOP(NITEMS, LOADN, BODY) { unsigned i = t0; \
            for (; i + 3u * stride < (unsigned)(NITEMS); i += 4u * stride) { f32x4 r_[4][LOADN]; \
                _Pragma("unroll") for (int q = 0; q < 4; ++q) { const unsigned ii = i + q * stride; _Pragma("unroll") for (int e = 0; e < LOADN; ++e) r_[q][e] = *(const f32x4*)(SRC + (size_t)ii * (4 * LOADN) + 4 * e); } \
                _Pragma("unroll") for (int q = 0; q < 4; ++q) { const unsigned ii = i + q * stride; BODY } } \
            for (; i < (unsigned)(NITEMS); i += stride) { f32x4 r_[1][LOADN]; constexpr int q = 0; const unsigned ii = i; \
                _Pragma("unroll") for (int e = 0; e < LOADN; ++e) r_[0][e] = *(const f32x4*)(SRC + (size_t)ii * (4 * LOADN) + 4 * e); BODY } }
#define BF8_BODY(DST) { u32x4 o_; o_.x = pk2(r_[q][0].x, r_[q][0].y); o_.y = pk2(r_[q][0].z, r_[q][0].w); o_.z = pk2(r_[q][1].x, r_[q][1].y); o_.w = pk2(r_[q][1].z, r_[q][1].w); *(u32x4*)((DST) + (size_t)ii * 8) = o_; }
#define FP4_BODY(DST, SCL) { const f32x4 v0 = r_[q][0] * (SCL), v1 = r_[q][1] * (SCL), v2 = r_[q][2] * (SCL), v3 = r_[q][3] * (SCL); unsigned lo = 0u, hi = 0u; \
            lo = __builtin_amdgcn_cvt_scalef32_pk_fp4_f32(lo, v0.x, v0.y, 1.0f, 0); lo = __builtin_amdgcn_cvt_scalef32_pk_fp4_f32(lo, v0.z, v0.w, 1.0f, 1); \
            lo = __builtin_amdgcn_cvt_scalef32_pk_fp4_f32(lo, v1.x, v1.y, 1.0f, 2); lo = __builtin_amdgcn_cvt_scalef32_pk_fp4_f32(lo, v1.z, v1.w, 1.0f, 3); \
            hi = __builtin_amdgcn_cvt_scalef32_pk_fp4_f32(hi, v2.x, v2.y, 1.0f, 0); hi = __builtin_amdgcn_cvt_scalef32_pk_fp4_f32(hi, v2.z, v2.w, 1.0f, 1); \
            hi = __builtin_amdgcn_cvt_scalef32_pk_fp4_f32(hi, v3.x, v3.y, 1.0f, 2); hi = __builtin_amdgcn_cvt_scalef32_pk_fp4_f32(hi, v3.z, v3.w, 1.0f, 3); \
            *(u32x2*)((DST) + (size_t)ii * 8) = (u32x2){lo, hi}; }
        if (PART == 0) {
        { const float* SRC = a.in[I_XP]; bf16_t* D = (bf16_t*)(ws + WS_XB); CVT_LOOP((size_t)MP * DM / 8, 2, BF8_BODY(D)) }
        { const float* SRC = a.in[I_XS]; bf16_t* D = (bf16_t*)(ws + WS_XB) + (size_t)MP * DM; CVT_LOOP((size_t)MS * DM / 8, 2, BF8_BODY(D)) }
        { const float* SRC = a.in[I_K1]; bf16_t* D = (bf16_t*)(ws + WS_KEYS); CVT_LOOP((size_t)2048, 2, BF8_BODY(D)) }
        { const float* SRC = a.in[I_K2]; bf16_t* D = (bf16_t*)(ws + WS_KEYS) + 16384; CVT_LOOP((size_t)2048, 2, BF8_BODY(D)) }
        } else {
        { const float* SRC = a.in[I_PU]; unsigned char* D = ws + WS_UT; CVT_LOOP((size_t)NE * DM / 16, 4, FP4_BODY(D, U4_SCALE)) }
        { const float* SRC = a.in[I_PV]; unsigned char* D = ws + WS_VT; CVT_LOOP((size_t)NE * DM / 16, 4, FP4_BODY(D, V4_SCALE)) }
        }
#undef CVT_LOOP
#undef BF8_BODY
#undef FP4_BODY
    }
    __syncthreads();
    if (PART == 0) {
        LAS float* wf = (LAS float*)lds;
        LAS float* lfs = (LAS float*)(lds + 32768);
        const float* win = a.in[I_WIN];
        bool staged = false;
        const bool spread = (MS % (2 * G) == 0) && (MS / (2 * G) <= 8);
        const int NU = spread ? MP / 64 : MT / 64;
        const int nloops = (vblk < NU ? (NU - vblk + G - 1) / G : 0) + (spread ? 1 : 0);
        for (int lp = 0; lp < nloops; ++lp) {
            const int u = vblk + lp * G; const bool spass = spread && u >= NU;
            if (!staged) { for (int i = tid; i < 8192; i += 512) wf[i] = win[(size_t)(i >> 3) * DIN + 1536 + (i & 7)]; staged = true; __syncthreads(); }
            const int m0 = spass ? 0 : 64 * u; const int ni = spass ? (wave < MS / (2 * G) ? 2 : 0) : 8;
            for (int i = 0; i < ni; i += 2) {
                const int m = spass ? MP + 2 * (wave * G + vblk) : m0 + 8 * wave + i; const float* xr0 = xrow_ptr(a, m); const float* xr1 = xrow_ptr(a, m + 1);
                float xv0[16], xv1[16];
#pragma unroll
                for (int kk = 0; kk < 16; ++kk) { xv0[kk] = xr0[lane + 64 * kk]; xv1[kk] = xr1[lane + 64 * kk]; }
                float acc[16];
#pragma unroll
                for (int h = 0; h < 16; ++h) acc[h] = 0.f;
#pragma unroll
                for (int kk = 0; kk < 16; ++kk) { const int k = lane + 64 * kk; const f32x4 w0 = *(const LAS f32x4*)(wf + k * 8), w1 = *(const LAS f32x4*)(wf + k * 8 + 4);
                    acc[0] += xv0[kk] * w0.x; acc[1] += xv0[kk] * w0.y; acc[2] += xv0[kk] * w0.z; acc[3] += xv0[kk] * w0.w; acc[4] += xv0[kk] * w1.x; acc[5] += xv0[kk] * w1.y; acc[6] += xv0[kk] * w1.z; acc[7] += xv0[kk] * w1.w;
                    acc[8] += xv1[kk] * w0.x; acc[9] += xv1[kk] * w0.y; acc[10] += xv1[kk] * w0.z; acc[11] += xv1[kk] * w0.w; acc[12] += xv1[kk] * w1.x; acc[13] += xv1[kk] * w1.y; acc[14] += xv1[kk] * w1.z; acc[15] += xv1[kk] * w1.w; }
                float q8[8], q4[4], q2[2], q1;
#pragma unroll
                for (int j = 0; j < 8; ++j) { const bool up = lane & 1; const float send = up ? acc[j] : acc[j + 8], keep = up ? acc[j + 8] : acc[j]; q8[j] = keep + __shfl_xor(send, 1); }
#pragma unroll
                for (int j = 0; j < 4; ++j) { const bool up = lane & 2; const float send = up ? q8[j] : q8[j + 4], keep = up ? q8[j + 4] : q8[j]; q4[j] = keep + __shfl_xor(send, 2); }
#pragma unroll
                for (int j = 0; j < 2; ++j) { const bool up = lane & 4; const float send = up ? q4[j] : q4[j + 2], keep = up ? q4[j + 2] : q4[j]; q2[j] = keep + __shfl_xor(send, 4); }
                { const bool up = lane & 8; const float send = up ? q2[0] : q2[1], keep = up ? q2[1] : q2[0]; q1 = keep + __shfl_xor(send, 8); }
                q1 += __shfl_xor(q1, 16); q1 += __shfl_xor(q1, 32);
                if (lane < 16) { const int km = ((lane & 1) << 3) | ((lane & 2) << 1) | ((lane & 4) >> 1) | ((lane & 8) >> 3); const int rr = km >> 3, hh = km & 7; const int mm = m + rr;
                    const float z = q1 + a.in[I_BF][hh]; const float lf = fminf(z, 0.f) - log1pf(__expf(-fabsf(z)));
                    if (mm < MP) a.out[OFF_FP + (size_t)mm * 8 + hh] = lf; else a.out[OFF_FS + (size_t)(mm - MP) * 8 + hh] = lf;
                    lfs[(8 * wave + i + rr) * 8 + hh] = lf; }
            }
            __syncthreads();
            if (!spass && u < MP / 64) { float v = lfs[lane * 8 + wave];
#pragma unroll
                for (int o = 1; o < 64; o <<= 1) { const float t = __shfl_up(v, o); if (lane >= o) v += t; }
                ((float*)(ws + WS_LC))[(size_t)(m0 + lane) * 8 + wave] = v;
                if (lane == 63) ((float*)(ws + WS_SCH))[u * 8 + wave] = v; }
            __syncthreads();
        }
    }
}

struct Epi1 {
    static constexpr bool PERM = true, AFTER_DRAIN = false;
    float* out; unsigned char* ws;
    template <int ACT> static __device__ __forceinline__ u32x4 pack8(const f32x4 a, const f32x4 b) {
        u32x4 w;
        if (ACT == 0) { w.x = pk2(a.x, a.y); w.y = pk2(a.z, a.w); w.z = pk2(b.x, b.y); w.w = pk2(b.z, b.w); }
        else if (ACT == 1) { w.x = pk2(gelu_tanh(a.x), gelu_tanh(a.y)); w.y = pk2(gelu_tanh(a.z), gelu_tanh(a.w)); w.z = pk2(gelu_tanh(b.x), gelu_tanh(b.y)); w.w = pk2(gelu_tanh(b.z), gelu_tanh(b.w)); }
        else { w.x = pk2(sigmoidf_(a.x), sigmoidf_(a.y)); w.y = pk2(sigmoidf_(a.z), sigmoidf_(a.w)); w.z = pk2(sigmoidf_(b.x), sigmoidf_(b.y)); w.w = pk2(sigmoidf_(b.z), sigmoidf_(b.w)); }
        return w;
    }
    __device__ __forceinline__ void elem8(int row, int col, const f32x4 v0, const f32x4 v1, int pn) const {
        const bool samp = row >= MP;
        if (pn < 2) { *(u32x4*)((bf16_t*)(ws + WS_Q) + (size_t)row * 512 + col) = pack8<0>(v0, v1); }
        else if (pn < 6) { const int isv = pn >= 4; const int c = col - (isv ? 1024 : 512);
            *(u32x4*)((bf16_t*)(ws + (isv ? WS_V : WS_K)) + (size_t)row * 512 + c) = pack8<0>(v0, v1);
            float* o = samp ? out + (isv ? OFF_VS : OFF_KS) + (size_t)(row - MP) * 512 + c : out + (isv ? OFF_VP : OFF_KP) + (size_t)row * 512 + c;
            *(f32x4*)o = v0; *(f32x4*)(o + 4) = v1; }
        else if (pn < 8) { const int c = col - 1536;
            *(u32x4*)((bf16_t*)(ws + WS_XR) + (size_t)row * 512 + c) = pack8<0>(v0, v1);
            if (!samp) { const int t = row & (SEQ - 1); if (t >= SEQ - 3) { float* o = out + OFF_CP + (size_t)((row >> 12) * 3 + (t - (SEQ - 3))) * 512 + c; *(f32x4*)o = v0; *(f32x4*)(o + 4) = v1; } }
            else { const int rs = row - MP, t = rs & 31; if (t >= DSEQ - 3) { float* o = out + OFF_CS + (size_t)((rs >> 5) * 3 + (t - (DSEQ - 3))) * 512 + c; *(f32x4*)o = v0; *(f32x4*)(o + 4) = v1; } } }
        else if (pn < 10) { *(u32x4*)((bf16_t*)(ws + WS_GG) + (size_t)row * 512 + (col - 2048)) = pack8<1>(v0, v1); }
        else { const int isr = pn >= 14; *(u32x4*)((bf16_t*)(ws + (isr ? WS_SR : WS_SA)) + (size_t)row * 1024 + (col - (isr ? 3584 : 2560))) = pack8<2>(v0, v1); }
    }
    __device__ __forceinline__ void operator()(const f32x4 (&acc)[2][2][4][2], const pg8::Unit& u, int wr, int wc, int fr, int fq) const {
        const int rbase = u.pm * 256 + wr * 64 + fr; const int cbase = u.pn * 256 + wc * 32 + 8 * fq;
#pragma unroll
        for (int ai = 0; ai < 2; ++ai)
#pragma unroll
            for (int m = 0; m < 4; ++m)
#pragma unroll
                for (int bj = 0; bj < 2; ++bj) elem8(rbase + ai * 128 + m * 16, cbase + bj * 128, acc[ai][bj][m][0], acc[ai][bj][m][1], u.pn);
    }
};
template <int SECOND> struct EpiUp {
    static constexpr bool PERM = true, AFTER_DRAIN = false;
    const bf16_t* gate; bf16_t* mg;
    __device__ __forceinline__ void elem(size_t o, const f32x4 v) const {
        const u32x2 g = *(const u32x2*)(gate + o);
        float r0 = bflo(g.x) * v.x, r1 = bfhi(g.x) * v.y, r2 = bflo(g.y) * v.z, r3 = bfhi(g.y) * v.w;
        if (SECOND) { const u32x2 p = *(const u32x2*)(mg + o); r0 += bflo(p.x); r1 += bfhi(p.x); r2 += bflo(p.y); r3 += bfhi(p.y); }
        u32x2 w; w.x = pk2(r0, r1); w.y = pk2(r2, r3); *(u32x2*)(mg + o) = w;
    }
    __device__ __forceinline__ void elem8(size_t o, const f32x4 v0, const f32x4 v1) const {
        const u32x4 g = *(const u32x4*)(gate + o);
        float r[8] = {bflo(g.x) * v0.x, bfhi(g.x) * v0.y, bflo(g.y) * v0.z, bfhi(g.y) * v0.w, bflo(g.z) * v1.x, bfhi(g.z) * v1.y, bflo(g.w) * v1.z, bfhi(g.w) * v1.w};
        if (SECOND) { const u32x4 p = *(const u32x4*)(mg + o); r[0] += bflo(p.x); r[1] += bfhi(p.x); r[2] += bflo(p.y); r[3] += bfhi(p.y); r[4] += bflo(p.z); r[5] += bfhi(p.z); r[6] += bflo(p.w); r[7] += bfhi(p.w); }
        u32x4 w; w.x = pk2(r[0], r[1]); w.y = pk2(r[2], r[3]); w.z = pk2(r[4], r[5]); w.w = pk2(r[6], r[7]); *(u32x4*)(mg + o) = w;
    }
    __device__ __forceinline__ void operator()(const f32x4 (&acc)[2][2][4][2], const pg8::Unit& u, int wr, int wc, int fr, int fq) const {
        const int rbase = u.pm * 256 + wr * 64 + fr; const int cbase = u.pn * 256 + wc * 32 + 8 * fq;
#pragma unroll
        for (int ai = 0; ai < 2; ++ai)
#pragma unroll
            for (int m = 0; m < 4; ++m)
#pragma unroll
                for (int bj = 0; bj < 2; ++bj) elem8((size_t)(rbase + ai * 128 + m * 16) * 1024 + cbase + bj * 128, acc[ai][bj][m][0], acc[ai][bj][m][1]);
    }
};
struct EpiOut {
    static constexpr bool PERM = true, AFTER_DRAIN = false;
    const bf16_t* xb; bf16_t* u1;
    __device__ __forceinline__ void elem(size_t o, const f32x4 v) const {
        const u32x2 xv = *(const u32x2*)(xb + o);
        u32x2 w; w.x = pk2(bflo(xv.x) * DN_ALPHA + v.x, bfhi(xv.x) * DN_ALPHA + v.y); w.y = pk2(bflo(xv.y) * DN_ALPHA + v.z, bfhi(xv.y) * DN_ALPHA + v.w); *(u32x2*)(u1 + o) = w;
    }
    __device__ __forceinline__ void elem8(size_t o, const f32x4 v0, const f32x4 v1) const {
        const u32x4 xv = *(const u32x4*)(xb + o);
        u32x4 w; w.x = pk2(bflo(xv.x) * DN_ALPHA + v0.x, bfhi(xv.x) * DN_ALPHA + v0.y); w.y = pk2(bflo(xv.y) * DN_ALPHA + v0.z, bfhi(xv.y) * DN_ALPHA + v0.w);
        w.z = pk2(bflo(xv.z) * DN_ALPHA + v1.x, bfhi(xv.z) * DN_ALPHA + v1.y); w.w = pk2(bflo(xv.w) * DN_ALPHA + v1.z, bfhi(xv.w) * DN_ALPHA + v1.w); *(u32x4*)(u1 + o) = w;
    }
    __device__ __forceinline__ void operator()(const f32x4 (&acc)[2][2][4][2], const pg8::Unit& u, int wr, int wc, int fr, int fq) const {
        const int rbase = u.pm * 256 + wr * 64 + fr; const int cbase = u.pn * 256 + wc * 32 + 8 * fq;
#pragma unroll
        for (int ai = 0; ai < 2; ++ai)
#pragma unroll
            for (int m = 0; m < 4; ++m)
#pragma unroll
                for (int bj = 0; bj < 2; ++bj) elem8((size_t)(rbase + ai * 128 + m * 16) * DM + cbase + bj * 128, acc[ai][bj][m][0], acc[ai][bj][m][1]);
    }
};
struct EpiQy {
    static constexpr bool PERM = true, AFTER_DRAIN = false;
    bf16_t* O;
    __device__ __forceinline__ void elem(size_t o, const f32x4 v) const { u32x2 w; w.x = pk2(v.x, v.y); w.y = pk2(v.z, v.w); *(u32x2*)(O + o) = w; }
    __device__ __forceinline__ void operator()(const f32x4 (&acc)[2][2][4][2], const pg8::Unit& u, int wr, int wc, int fr, int fq) const {
        const int row0 = u.pm * 256 + wr * 64 + fr; const int col0 = u.pn * 256 + wc * 32 + 8 * fq;
#pragma unroll
        for (int ai = 0; ai < 2; ++ai)
#pragma unroll
            for (int m = 0; m < 4; ++m) { bf16_t* rowp = O + (size_t)(row0 + ai * 128 + m * 16) * NQ + col0;
#pragma unroll
                for (int bj = 0; bj < 2; ++bj) { const f32x4 v0 = acc[ai][bj][m][0], v1 = acc[ai][bj][m][1];
                    u32x4 w; w.x = pk2(v0[0], v0[1]); w.y = pk2(v0[2], v0[3]); w.z = pk2(v1[0], v1[1]); w.w = pk2(v1[2], v1[3]);
                    *(u32x4*)(rowp + bj * 128) = w; } }
    }
};

template <class Epi>
__device__ __forceinline__ void small_gemm(const bf16_t* A, const bf16_t* Bt, int N, int K, const Epi& E, int lane, int wave) {
    const int gw = blockIdx.x * 8 + wave, NGW = gridDim.x * 8;
    const int r32 = lane & 31, hi = lane >> 5;
    for (int t = wave * (int)gridDim.x + (int)blockIdx.x; t < (MS / 32) * (N / 32); t += NGW) {
        const int tm = t & 15, tn = t >> 4;
        const bf16_t* ap = A + (size_t)(MP + tm * 32 + r32) * K + 8 * hi;
        const bf16_t* bp = Bt + (size_t)(tn * 32 + r32) * K + 8 * hi;
        f32x16 acc = {};
        bf16x8 a0[8], b0[8], a1[8], b1[8];
#pragma unroll
        for (int c = 0; c < 8; ++c) { a0[c] = *(const bf16x8*)(ap + 16 * c); b0[c] = *(const bf16x8*)(bp + 16 * c); }
#pragma unroll 1
        for (int k0 = 0; k0 < K; k0 += 256) {
#pragma unroll
            for (int c = 0; c < 8; ++c) { a1[c] = *(const bf16x8*)(ap + k0 + 128 + 16 * c); b1[c] = *(const bf16x8*)(bp + k0 + 128 + 16 * c); }
#pragma unroll
            for (int c = 0; c < 8; ++c) acc = __builtin_amdgcn_mfma_f32_32x32x16_bf16(b0[c], a0[c], acc, 0, 0, 0);
            if (k0 + 256 < K) {
#pragma unroll
                for (int c = 0; c < 8; ++c) { a0[c] = *(const bf16x8*)(ap + k0 + 256 + 16 * c); b0[c] = *(const bf16x8*)(bp + k0 + 256 + 16 * c); }
            }
#pragma unroll
            for (int c = 0; c < 8; ++c) acc = __builtin_amdgcn_mfma_f32_32x32x16_bf16(b1[c], a1[c], acc, 0, 0, 0);
        }
        const size_t ro = (size_t)(MP + tm * 32 + r32) * N + tn * 32 + 4 * hi;
#pragma unroll
        for (int g = 0; g < 4; ++g) E.elem(ro + 8 * g, (f32x4){acc[4 * g], acc[4 * g + 1], acc[4 * g + 2], acc[4 * g + 3]});
    }
}
#define GAS __attribute__((address_space(1)))
#define XB_TMO      128
#define XB_XCNT(j)  (256  + 64 * (j))
#define XB_XSUB(j)  (1280 + 64 * (j))
#define XB_XGEN(j)  (2304 + 64 * (j))
#define XB_TOP      3328
#define XB_TOPGEN   3392
#define XCD_BAR_WORDS 3456
#define XB_SPIN_CAP (1u << 18)

__device__ __forceinline__ unsigned xb_ld(unsigned* p)              { return __hip_atomic_load(p, __ATOMIC_RELAXED, __HIP_MEMORY_SCOPE_AGENT); }
__device__ __forceinline__ unsigned xb_add(unsigned* p, unsigned v) { return __hip_atomic_fetch_add(p, v, __ATOMIC_RELAXED, __HIP_MEMORY_SCOPE_AGENT); }
__device__ __forceinline__ unsigned xb_xcc_id() { return (unsigned)__builtin_amdgcn_s_getreg((3 << 11) | 20) & 0xFu; }
#define XB_SPIN(cond, bar) do { unsigned _sp = 0; while (cond) { __builtin_amdgcn_s_sleep(1); \
    if ((++_sp & 255u) == 0u) { if (xb_ld(&(bar)[XB_TMO])) break; if (_sp > XB_SPIN_CAP) { atomicAdd(&(bar)[XB_TMO], 1u); break; } } } } while (0)

struct XcdBarrier {
    unsigned* bar; unsigned x;
    volatile LAS unsigned* st;
};

__device__ __forceinline__ XcdBarrier xcd_barrier_post(unsigned* bar, volatile LAS unsigned* st) {
    XcdBarrier b; b.bar = bar; b.x = xb_xcc_id(); b.st = st;
    if (threadIdx.x == 0) (void)xb_add(&bar[XB_XCNT(b.x)], 1u);
    return b;
}
__device__ __forceinline__ void xcd_barrier_complete(unsigned* bar, unsigned x, unsigned& nloc, unsigned& nx) {
    const unsigned G = gridDim.x * gridDim.y * gridDim.z;
    unsigned sum, cnt, mine, sp = 0u;
    for (;;) {
        sum = 0u; cnt = 0u; mine = 0u;
#pragma unroll
        for (unsigned j = 0; j < 16; ++j) { const unsigned c = xb_ld(&bar[XB_XCNT(j)]); sum += c; cnt += (c > 0u) ? 1u : 0u; mine = (j == x) ? c : mine; }
        if (sum == G) break;
        __builtin_amdgcn_s_sleep(1);
        if ((++sp & 255u) == 0u) { if (xb_ld(&bar[XB_TMO])) break; if (sp > XB_SPIN_CAP) { atomicAdd(&bar[XB_TMO], 1u); break; } }
    }
    nloc = mine > 0u ? mine : 1u; nx = cnt > 0u ? cnt : 1u;
}

__device__ __forceinline__ void xcd_barrier(const XcdBarrier& b) {
    asm volatile("s_waitcnt vmcnt(0)" ::: "memory");
    __syncthreads();
    if (threadIdx.x == 0) {
        unsigned* bar = b.bar;
        __builtin_amdgcn_s_waitcnt(0);
        unsigned nloc = b.st[0], nx = b.st[1];
        if (nloc == 0u) { xcd_barrier_complete(bar, b.x, nloc, nx); b.st[0] = nloc; b.st[1] = nx; }
        const unsigned old = xb_add(&bar[XB_XSUB(b.x)], 1u);
        const unsigned gen = old / nloc;
        if (old + 1u == (gen + 1u) * nloc) {
            __builtin_amdgcn_fence(__ATOMIC_RELEASE, "agent");
            asm volatile("s_waitcnt vmcnt(0)" ::: "memory");
            const unsigned og = xb_add(&bar[XB_TOP], 1u);
            const unsigned tg = og / nx;
            if (og + 1u == (tg + 1u) * nx) xb_add(&bar[XB_TOPGEN], 1u);
            else XB_SPIN(xb_ld(&bar[XB_TOPGEN]) == tg, bar);
            __builtin_amdgcn_fence(__ATOMIC_ACQUIRE, "agent");
            xb_add(&bar[XB_XGEN(b.x)], 1u);
            asm volatile("s_waitcnt vmcnt(0)" ::: "memory");
        } else {
            XB_SPIN(xb_ld(&bar[XB_XGEN(b.x)]) == gen, bar);
            __builtin_amdgcn_fence(__ATOMIC_ACQUIRE, "agent");
            asm volatile("s_waitcnt vmcnt(0)" ::: "memory");
        }
    }
    __syncthreads();
}

template <int NK, bool MASKED>
__device__ __forceinline__ void attn_tile(float& lrun, f32x16 (&o)[2], const bf16x8 (&qf)[4], const LAS unsigned char* Kt, const LAS unsigned char* Vt, int vimg_stride,
                                          const LAS float* cb, float fq, int qrel, int lane) {
    const int r32 = lane & 31, hi = lane >> 5;
    f32x16 p[NK];
#pragma unroll
    for (int ks = 0; ks < NK; ++ks) {
        f32x16 acc;
#pragma unroll
        for (int g = 0; g < 4; ++g) { const f32x4 cbv = *(const LAS f32x4*)(cb + 32 * ks + 8 * g + 4 * hi); acc[4 * g] = cbv.x + fq; acc[4 * g + 1] = cbv.y + fq; acc[4 * g + 2] = cbv.z + fq; acc[4 * g + 3] = cbv.w + fq; }
#pragma unroll
        for (int c = 0; c < 4; ++c) { const bf16x8 kf = *(const LAS bf16x8*)(Kt + (32 * ks + r32) * 144 + (16 * c + 8 * hi) * 2); acc = __builtin_amdgcn_mfma_f32_32x32x16_bf16(kf, qf[c], acc, 0, 0, 0); }
        p[ks] = acc;
    }
    float rs = 0.f;
#pragma unroll
    for (int ks = 0; ks < NK; ++ks)
#pragma unroll
        for (int r = 0; r < 16; ++r) { float e = __builtin_amdgcn_exp2f(p[ks][r]); if (MASKED && (32 * ks + crow(r, 0) + 4 * hi > qrel)) e = 0.f; p[ks][r] = e; rs += e; }
    lrun += rs;
    const int li = lane & 15, cg2 = (lane >> 4) & 1;
    const int voff = (4 * hi + (li >> 2)) * 64 + (16 * cg2 + 4 * (li & 3)) * 2;
#pragma unroll
    for (int kc = 0; kc < 2 * NK; ++kc) {
        const int ks = kc >> 1, rb = 8 * (kc & 1);
        u32x4 pw; pw.x = pk2(p[ks][rb + 0], p[ks][rb + 1]); pw.y = pk2(p[ks][rb + 2], p[ks][rb + 3]); pw.z = pk2(p[ks][rb + 4], p[ks][rb + 5]); pw.w = pk2(p[ks][rb + 6], p[ks][rb + 7]);
        const bf16x8 pb = __builtin_bit_cast(bf16x8, pw);
#pragma unroll
        for (int dh = 0; dh < 2; ++dh) {
            const LAS unsigned char* vp = Vt + dh * vimg_stride + (16 * kc) * 64 + voff;
            const v4i16_t lo = __builtin_amdgcn_ds_read_tr16_b64_v4i16((LAS v4i16_t*)vp);
            const v4i16_t hh = __builtin_amdgcn_ds_read_tr16_b64_v4i16((LAS v4i16_t*)(vp + 8 * 64));
            const bf16x8 vf = {lo[0], lo[1], lo[2], lo[3], hh[0], hh[1], hh[2], hh[3]};
            o[dh] = __builtin_amdgcn_mfma_f32_32x32x16_bf16(vf, pb, o[dh], 0, 0, 0);
        }
    }
}

constexpr int AT_KB = 64 * 144, AT_VB = 8192, AT_K0 = 0, AT_V0 = 2 * AT_KB, AT_CB = AT_V0 + 2 * AT_VB, AT_OFF = AT_CB + 512;
__device__ __forceinline__ void attn_prompt_unit(ARGS_T a, LAS unsigned char* lds, int b, int h, int qb, int tid, int lane, int wave) {
    unsigned char* ws = a.ws;
    const bf16_t* Q = (const bf16_t*)(ws + WS_Q); const bf16_t* K = (const bf16_t*)(ws + WS_K); const bf16_t* V = (const bf16_t*)(ws + WS_V); bf16_t* O = (bf16_t*)(ws + WS_Q);
    const float* LC = (const float*)(ws + WS_LC); const float* SCH = (const float*)(ws + WS_SCH);
    const int r32 = lane & 31, hi = lane >> 5;
    const size_t rowb = (size_t)b * SEQ;
    const int q0 = qb * 256 + wave * 32;
    bf16x8 qf[4];
#pragma unroll
    for (int c = 0; c < 4; ++c) { const u32x4 t = *(const u32x4*)(Q + (rowb + q0 + r32) * 512 + h * 64 + 16 * c + 8 * hi); constexpr float SC = 0.125f * LOG2E; u32x4 s;
        s.x = pk2(bflo(t.x) * SC, bfhi(t.x) * SC); s.y = pk2(bflo(t.y) * SC, bfhi(t.y) * SC); s.z = pk2(bflo(t.z) * SC, bfhi(t.z) * SC); s.w = pk2(bflo(t.w) * SC, bfhi(t.w) * SC); qf[c] = __builtin_bit_cast(bf16x8, s); }
    LAS float* offs = (LAS float*)(lds + AT_OFF);
    if (wave == 0) { const float v = SCH[(b * NSEGP + lane) * 8 + h]; float inc = v;
#pragma unroll
        for (int o = 1; o < 64; o <<= 1) { const float t = __shfl_up(inc, o); if (lane >= o) inc += t; }
        offs[lane] = inc - v; }
    __syncthreads();
    const float fq = (offs[(q0 + r32) >> 6] + LC[(rowb + q0 + r32) * 8 + h]) * LOG2E;
    const int NT = (qb + 1) * 4;
    const int skey = tid >> 3, sch = tid & 7;
    const bf16_t* ksrc = K + (rowb + skey) * 512 + h * 64 + sch * 8; const bf16_t* vsrc = V + (rowb + skey) * 512 + h * 64 + sch * 8;
    const int kdst = skey * 144 + sch * 16, vdst = (sch >> 2) * 4096 + skey * 64 + (sch & 3) * 16;
#define AT_LOAD(KR, VR, CR, t) do { KR = *(const u32x4*)(ksrc + (size_t)(t) * 64 * 512); VR = *(const u32x4*)(vsrc + (size_t)(t) * 64 * 512); \
        if (tid < 64) CR = -(offs[(t)] + LC[(rowb + 64 * (t) + tid) * 8 + h]) * LOG2E; } while (0)
#define AT_STORE(KR, VR, CR, bf) do { *(LAS u32x4*)(lds + AT_K0 + (bf) * AT_KB + kdst) = KR; *(LAS u32x4*)(lds + AT_V0 + (bf) * AT_VB + vdst) = VR; if (tid < 64) ((LAS float*)(lds + AT_CB))[(bf) * 64 + tid] = CR; } while (0)
#define AT_BAR() asm volatile("s_waitcnt lgkmcnt(0)\n\ts_barrier" ::: "memory")
#define AT_COMPUTE(t, bf) do { if (64 * (t) + 63 <= q0) attn_tile<2, false>(lrun, o, qf, lds + AT_K0 + (bf) * AT_KB, lds + AT_V0 + (bf) * AT_VB, 4096, (const LAS float*)(lds + AT_CB) + (bf) * 64, fq, 0, lane); \
        else if (64 * (t) <= q0 + 31) attn_tile<2, true>(lrun, o, qf, lds + AT_K0 + (bf) * AT_KB, lds + AT_V0 + (bf) * AT_VB, 4096, (const LAS float*)(lds + AT_CB) + (bf) * 64, fq, q0 + r32 - 64 * (t), lane); } while (0)
    u32x4 kA, vA, kB, vB; float cA = 0.f, cB = 0.f;
    AT_LOAD(kA, vA, cA, 0); AT_LOAD(kB, vB, cB, 1);
    AT_STORE(kA, vA, cA, 0);
    AT_BAR();
    float lrun = 0.f; f32x16 o[2]; o[0] = f32x16{}; o[1] = f32x16{};
    for (int j = 0; j < NT; j += 2) {
        if (j + 2 < NT) AT_LOAD(kA, vA, cA, j + 2);
        AT_COMPUTE(j, 0);
        AT_STORE(kB, vB, cB, 1);
        AT_BAR();
        if (j + 3 < NT) AT_LOAD(kB, vB, cB, j + 3);
        AT_COMPUTE(j + 1, 1);
        if (j + 2 < NT) AT_STORE(kA, vA, cA, 0);
        AT_BAR();
    }
#undef AT_LOAD
#undef AT_STORE
#undef AT_BAR
#undef AT_COMPUTE
    const float lt = lrun + __shfl_xor(lrun, 32); const float inv = 1.f / lt;
    bf16_t* orow = O + (rowb + q0 + r32) * 512 + h * 64;
#pragma unroll
    for (int dh = 0; dh < 2; ++dh)
#pragma unroll
        for (int g = 0; g < 4; ++g) { u32x2 w; w.x = pk2(o[dh][4 * g] * inv, o[dh][4 * g + 1] * inv); w.y = pk2(o[dh][4 * g + 2] * inv, o[dh][4 * g + 3] * inv);
            *(u32x2*)(orow + 32 * dh + 8 * g + 4 * hi) = w; }
}

constexpr int SA_WV = 4608 + 4096, SA_CB = 8 * SA_WV, SA_CMB = 0;
__device__ __forceinline__ void attn_sample_unit(ARGS_T a, LAS unsigned char* lds, int bs, int h, int tid, int lane, int wave) {
    unsigned char* ws = a.ws;
    const bf16_t* Q = (const bf16_t*)(ws + WS_Q); const bf16_t* Kn = (const bf16_t*)(ws + WS_K); const bf16_t* Vn = (const bf16_t*)(ws + WS_V); bf16_t* O = (bf16_t*)(ws + WS_Q);
    const int r32 = lane & 31, hi = lane >> 5;
    const size_t row0 = (size_t)MP + (size_t)bs * DSEQ;
    LAS float* cbs = (LAS float*)(lds + SA_CB);
    if (wave == 0) {
        float v[17]; float s = 0.f;
#pragma unroll
        for (int i = 0; i < 17; ++i) { const int k = lane * 17 + i; float x = 0.f;
            if (k < PAST) x = a.in[I_CLF][((size_t)bs * PAST + k) * 8 + h]; else if (k < PAST + DSEQ) x = a.out[OFF_FS + ((size_t)bs * DSEQ + (k - PAST)) * 8 + h];
            s += x; v[i] = s; }
        float inc = s;
#pragma unroll
        for (int o = 1; o < 64; o <<= 1) { const float t = __shfl_up(inc, o); if (lane >= o) inc += t; }
        const float excl = inc - s;
#pragma unroll
        for (int i = 0; i < 17; ++i) cbs[lane * 17 + i] = -(excl + v[i]) * LOG2E;
    }
    bf16x8 qf[4];
#pragma unroll
    for (int c = 0; c < 4; ++c) { const u32x4 t = *(const u32x4*)(Q + (row0 + r32) * 512 + h * 64 + 16 * c + 8 * hi); constexpr float SC = 0.125f * LOG2E; u32x4 s;
        s.x = pk2(bflo(t.x) * SC, bfhi(t.x) * SC); s.y = pk2(bflo(t.y) * SC, bfhi(t.y) * SC); s.z = pk2(bflo(t.z) * SC, bfhi(t.z) * SC); s.w = pk2(bflo(t.w) * SC, bfhi(t.w) * SC); qf[c] = __builtin_bit_cast(bf16x8, s); }
    __syncthreads();
    const float fq = -cbs[PAST + r32];
    LAS unsigned char* Kw = lds + wave * SA_WV; LAS unsigned char* Vw = Kw + 4608;
    float lrun = 0.f; f32x16 o[2]; o[0] = f32x16{}; o[1] = f32x16{};
    for (int g = wave; g < 33; g += 8) {
        if (g < 32) {
            const float* kc = a.in[I_CK] + (((size_t)bs * PAST + 32 * g) * NH + h) * HD; const float* vc = a.in[I_CV] + (((size_t)bs * PAST + 32 * g) * NH + h) * HD;
#pragma unroll
            for (int i = 0; i < 8; ++i) { const int id = i * 64 + lane, key = id >> 4, part = id & 15;
                const f32x4 kv = *(const f32x4*)(kc + (size_t)key * NH * HD + part * 4), vv = *(const f32x4*)(vc + (size_t)key * NH * HD + part * 4);
                u32x2 kw; kw.x = pk2(kv.x, kv.y); kw.y = pk2(kv.z, kv.w); u32x2 vw; vw.x = pk2(vv.x, vv.y); vw.y = pk2(vv.z, vv.w);
                *(LAS u32x2*)(Kw + key * 144 + part * 8) = kw; *(LAS u32x2*)(Vw + (part >> 3) * 2048 + key * 64 + (part & 7) * 8) = vw; }
        } else {
#pragma unroll
            for (int i = 0; i < 4; ++i) { const int id = i * 64 + lane, key = id >> 3, ch = id & 7;
                const u32x4 kv = *(const u32x4*)(Kn + (row0 + key) * 512 + h * 64 + ch * 8), vv = *(const u32x4*)(Vn + (row0 + key) * 512 + h * 64 + ch * 8);
                *(LAS u32x4*)(Kw + key * 144 + ch * 16) = kv; *(LAS u32x4*)(Vw + (ch >> 2) * 2048 + key * 64 + (ch & 3) * 16) = vv; }
        }
        asm volatile("s_waitcnt lgkmcnt(0)" ::: "memory");
        if (g == 32) attn_tile<1, true>(lrun, o, qf, Kw, Vw, 2048, cbs + 32 * g, fq, r32, lane); else attn_tile<1, false>(lrun, o, qf, Kw, Vw, 2048, cbs + 32 * g, fq, 0, lane);
        asm volatile("s_waitcnt lgkmcnt(0)" ::: "memory");
    }
    __syncthreads();
    LAS float* cm = (LAS float*)(lds + SA_CMB) + wave * 2112;
    const float lt = lrun + __shfl_xor(lrun, 32);
    if (hi == 0) cm[32 + r32] = lt;
#pragma unroll
    for (int dh = 0; dh < 2; ++dh)
#pragma unroll
        for (int r = 0; r < 16; ++r) cm[64 + (32 * dh + crow(r, hi)) * 32 + r32] = o[dh][r];
    __syncthreads();
    {
        const int q = tid & 31, d0 = (tid >> 5) * 4;
        const LAS float* base = (const LAS float*)(lds + SA_CMB);
        float L = 0.f, acc[4] = {0.f, 0.f, 0.f, 0.f};
#pragma unroll
        for (int w = 0; w < 8; ++w) { L += base[w * 2112 + 32 + q];
#pragma unroll
            for (int i = 0; i < 4; ++i) acc[i] += base[w * 2112 + 64 + (d0 + i) * 32 + q]; }
        const float inv = 1.f / L;
        u32x2 w; w.x = pk2(acc[0] * inv, acc[1] * inv); w.y = pk2(acc[2] * inv, acc[3] * inv);
        *(u32x2*)(O + (row0 + q) * 512 + h * 64 + d0) = w;
    }
    __syncthreads();
}

constexpr int RN_XC = 0, RN_XCS = 1040, RN_HIN = 64 * RN_XCS, RN_GG = RN_HIN + 2048;
template <bool FINAL>
__device__ __forceinline__ void rnn_tile(ARGS_T a, LAS unsigned char* lds, int tile, int tid, int lane, int wave) {
    unsigned char* ws = a.ws;
    const bf16_t* XR = (const bf16_t*)(ws + WS_XR); bf16_t* GGRO = (bf16_t*)(ws + WS_GG);
    float* RA = (float*)(ws + WS_RA); float* RB = (float*)(ws + WS_RB);
    const bool samp = tile >= NBATCH * NSEGP;
    const int b = samp ? tile - NBATCH * NSEGP : tile / NSEGP, seg = samp ? 0 : tile % NSEGP;
    const size_t m0 = samp ? (size_t)MP + (size_t)b * DSEQ : (size_t)b * SEQ + (size_t)seg * 64;
    const int nrow = samp ? 32 : 64;
    {
        const int c0 = (tid & 63) * 8, t0 = (tid >> 6) * 8;
        if (t0 < nrow) {
            const int tbase = samp ? 0 : seg * 64;
            u32x4 xr[11];
#pragma unroll
            for (int r = 0; r < 11; ++r) { const int tt = tbase + t0 - 3 + r;
                if (tt >= 0) xr[r] = *(const u32x4*)(XR + (m0 + t0 - 3 + r) * 512 + c0);
                else if (samp) { const float* sc = a.in[I_SCONV] + ((size_t)b * 3 + (3 + tt)) * 512 + c0; const f32x4 s0 = *(const f32x4*)sc, s1 = *(const f32x4*)(sc + 4);
                    xr[r] = (u32x4){pk2(s0.x, s0.y), pk2(s0.z, s0.w), pk2(s1.x, s1.y), pk2(s1.z, s1.w)}; }
                else xr[r] = (u32x4){0u, 0u, 0u, 0u}; }
            u32x4 gg[8];
            if (FINAL) {
#pragma unroll
                for (int r = 0; r < 8; ++r) gg[r] = *(const u32x4*)(GGRO + (m0 + t0 + r) * 512 + c0); }
            float cw[4][8], cbias[8];
#pragma unroll
            for (int w = 0; w < 4; ++w) { const f32x4 w0 = *(const f32x4*)(a.in[I_CONVW] + w * 512 + c0), w1 = *(const f32x4*)(a.in[I_CONVW] + w * 512 + c0 + 4);
                cw[w][0] = w0.x; cw[w][1] = w0.y; cw[w][2] = w0.z; cw[w][3] = w0.w; cw[w][4] = w1.x; cw[w][5] = w1.y; cw[w][6] = w1.z; cw[w][7] = w1.w; }
            { const f32x4 b0 = *(const f32x4*)(a.in[I_CONVB] + c0), b1 = *(const f32x4*)(a.in[I_CONVB] + c0 + 4);
              cbias[0] = b0.x; cbias[1] = b0.y; cbias[2] = b0.z; cbias[3] = b0.w; cbias[4] = b1.x; cbias[5] = b1.y; cbias[6] = b1.z; cbias[7] = b1.w; }
#pragma unroll
            for (int r = 0; r < 8; ++r) {
                float acc[8];
#pragma unroll
                for (int i = 0; i < 8; ++i) acc[i] = cbias[i];
#pragma unroll
                for (int w = 0; w < 4; ++w) { const u32x4 x = xr[r + w];
                    acc[0] += bflo(x.x) * cw[w][0]; acc[1] += bfhi(x.x) * cw[w][1]; acc[2] += bflo(x.y) * cw[w][2]; acc[3] += bfhi(x.y) * cw[w][3];
                    acc[4] += bflo(x.z) * cw[w][4]; acc[5] += bfhi(x.z) * cw[w][5]; acc[6] += bflo(x.w) * cw[w][6]; acc[7] += bfhi(x.w) * cw[w][7]; }
                u32x4 o; o.x = pk2(acc[0], acc[1]); o.y = pk2(acc[2], acc[3]); o.z = pk2(acc[4], acc[5]); o.w = pk2(acc[6], acc[7]);
                *(LAS u32x4*)(lds + RN_XC + (t0 + r) * RN_XCS + c0 * 2) = o;
                if (FINAL) *(LAS u32x4*)(lds + RN_GG + (t0 + r) * RN_XCS + c0 * 2) = gg[r];
            }
        }
    }
    if (FINAL) {
        LAS float* hin = (LAS float*)(lds + RN_HIN);
        float hc;
        if (samp) hc = a.in[I_SRNN][(size_t)b * 512 + tid];
        else { hc = 0.f; const float* pa = RA + (size_t)(b * NSEGP) * 512 + tid; const float* pb = RB + (size_t)(b * NSEGP) * 512 + tid;
#pragma unroll 8
            for (int s = 0; s < seg; ++s) hc = pa[(size_t)s * 512] * hc + pb[(size_t)s * 512]; }
        hin[tid] = hc;
    }
    __syncthreads();
    const int r32 = lane & 31, hi = lane >> 5, n = wave;
    const bf16_t* WAt = (const bf16_t*)(ws + WS_RGA) + n * 4096; const bf16_t* WXt = (const bf16_t*)(ws + WS_RGX) + n * 4096;
    float carry[2], aprod[2];
#pragma unroll 1
    for (int jh = 0; jh < 2; ++jh) {
        const int ch = 64 * n + 32 * jh + r32;
        bf16x8 wa[4], wx[4];
#pragma unroll
        for (int c = 0; c < 4; ++c) { wa[c] = *(const bf16x8*)(WAt + (32 * jh + r32) * 64 + 16 * c + 8 * hi); wx[c] = *(const bf16x8*)(WXt + (32 * jh + r32) * 64 + 16 * c + 8 * hi); }
        const float ba = a.in[I_BRGA][ch], bx = a.in[I_BRGX][ch];
        const float lam = a.in[I_LAM][ch]; const float sp = fmaxf(-lam, 0.f) + log1pf(__expf(-fabsf(lam)));
        float cr = FINAL ? ((const LAS float*)(lds + RN_HIN))[ch] : 0.f; float ap = 1.f;
#pragma unroll 1
        for (int th = 0; th < (samp ? 1 : 2); ++th) {
            f32x16 ya = {}, yx = {};
#pragma unroll
            for (int c = 0; c < 4; ++c) { const bf16x8 af = *(const LAS bf16x8*)(lds + RN_XC + (32 * th + r32) * RN_XCS + (64 * n + 16 * c + 8 * hi) * 2);
                ya = __builtin_amdgcn_mfma_f32_32x32x16_bf16(af, wa[c], ya, 0, 0, 0); yx = __builtin_amdgcn_mfma_f32_32x32x16_bf16(af, wx[c], yx, 0, 0, 0); }
#pragma unroll
            for (int r = 0; r < 16; ++r) {
                const int t = 32 * th + crow(r, hi);
                const float xc = bf1(*(const LAS bf16_t*)(lds + RN_XC + t * RN_XCS + ch * 2));
                const float rg = sigmoidf_(ya[r] + ba), ig = sigmoidf_(yx[r] + bx);
                const float la = -8.f * rg * sp; const float av = __expf(la);
                const float mult = sqrtf(fmaxf(1.f - av * av, 0.f));
                ya[r] = av; yx[r] = mult * ig * xc;
            }
#pragma unroll
            for (int g = 0; g < 4; ++g) {
                float h0 = ya[4 * g] * cr + yx[4 * g], h1 = ya[4 * g + 1] * h0 + yx[4 * g + 1], h2 = ya[4 * g + 2] * h1 + yx[4 * g + 2], h3 = ya[4 * g + 3] * h2 + yx[4 * g + 3];
                const float rv = __shfl_xor(h3, 32);
                const float k0 = ya[4 * g] * rv + yx[4 * g], k1 = ya[4 * g + 1] * k0 + yx[4 * g + 1], k2 = ya[4 * g + 2] * k1 + yx[4 * g + 2], k3 = ya[4 * g + 3] * k2 + yx[4 * g + 3];
                ap *= (ya[4 * g] * ya[4 * g + 1]) * (ya[4 * g + 2] * ya[4 * g + 3]);
                if (hi) { h0 = k0; h1 = k1; h2 = k2; h3 = k3; }
                const float back = __shfl_xor(k3, 32);
                cr = hi ? k3 : back;
                if (FINAL) { yx[4 * g] = h0; yx[4 * g + 1] = h1; yx[4 * g + 2] = h2; yx[4 * g + 3] = h3; }
            }
            if (FINAL) {
#pragma unroll
                for (int r = 0; r < 16; ++r) { const int t = 32 * th + crow(r, hi); LAS bf16_t* p = (LAS bf16_t*)(lds + RN_GG + t * RN_XCS + ch * 2); *p = (bf16_t)(pk2(yx[r] * bf1(*p), 0.f) & 0xffffu); }
            }
        }
        carry[jh] = cr; aprod[jh] = ap;
    }
#pragma unroll
    for (int jh = 0; jh < 2; ++jh) {
        const int ch = 64 * n + 32 * jh + r32;
        if (!FINAL) { const float ap = aprod[jh] * __shfl_xor(aprod[jh], 32); if (hi == 0) { RA[(size_t)tile * 512 + ch] = ap; RB[(size_t)tile * 512 + ch] = carry[jh]; } }
        else if (hi == 0) { if (samp) a.out[OFF_RS + (size_t)b * 512 + ch] = carry[jh]; else if (seg == NSEGP - 1) a.out[OFF_RP + (size_t)b * 512 + ch] = carry[jh]; }
    }
    if (FINAL) {
        __syncthreads();
        const int c0 = (tid & 63) * 8, t0 = (tid >> 6) * 8;
        if (t0 < nrow) {
#pragma unroll
            for (int r = 0; r < 8; ++r) *(u32x4*)(GGRO + (m0 + t0 + r) * 512 + c0) = *(const LAS u32x4*)(lds + RN_GG + (t0 + r) * RN_XCS + c0 * 2);
        }
    }
    __syncthreads();
}

__device__ __forceinline__ void ln1_phase(ARGS_T a, int lane, int wave) {
    const int gw = blockIdx.x * 8 + wave, NGW = gridDim.x * 8;
    const bf16_t* U1 = (const bf16_t*)(a.ws + WS_SA); bf16_t* HB = (bf16_t*)(a.ws + WS_XB);
    f32x4 gv[4], bv[4];
#pragma unroll
    for (int j = 0; j < 4; ++j) { gv[j] = *((const f32x4*)a.in[I_LN1G] + lane + 64 * j); bv[j] = *((const f32x4*)a.in[I_LN1B] + lane + 64 * j); }
    for (int m = gw; m < MT; m += NGW) {
        const u32x2* row = (const u32x2*)(U1 + (size_t)m * DM) + lane;
        f32x4 v[4]; float s = 0.f;
#pragma unroll
        for (int j = 0; j < 4; ++j) { const u32x2 t = row[64 * j]; v[j] = (f32x4){bflo(t.x), bfhi(t.x), bflo(t.y), bfhi(t.y)}; s += (v[j].x + v[j].y) + (v[j].z + v[j].w); }
        const float mean = wave_sum(s) * (1.f / DM); float s2 = 0.f;
#pragma unroll
        for (int j = 0; j < 4; ++j) { v[j] = v[j] - mean; s2 += (v[j].x * v[j].x + v[j].y * v[j].y) + (v[j].z * v[j].z + v[j].w * v[j].w); }
        const float rstd = 1.f / sqrtf(wave_sum(s2) * (1.f / DM) + LN_EPS);
        u32x2* o8 = (u32x2*)(HB + (size_t)m * DM) + lane;
        f32x4* hrow = (f32x4*)(a.out + (size_t)m * DM) + lane;
#pragma unroll
        for (int j = 0; j < 4; ++j) { const f32x4 y = v[j] * rstd * gv[j] + bv[j]; hrow[64 * j] = y; u32x2 w; w.x = pk2(y.x, y.y); w.y = pk2(y.z, y.w); o8[64 * j] = w; }
    }
}

__device__ __forceinline__ unsigned fkey(float f) { const unsigned u = __float_as_uint(f); return (u & 0x80000000u) ? ~u : (u | 0x80000000u); }
__device__ __forceinline__ float funkey(unsigned k) { const unsigned u = (k & 0x80000000u) ? (k & 0x7fffffffu) : ~k; return __uint_as_float(u); }
__device__ __forceinline__ void cex(unsigned& hi_, unsigned& lo_) { const unsigned x = hi_, y = lo_; hi_ = x > y ? x : y; lo_ = x > y ? y : x; }
__device__ __forceinline__ void sort16_desc(unsigned (&v)[16]) {
#pragma unroll
    for (int k = 2; k <= 16; k <<= 1)
#pragma unroll
        for (int j = k >> 1; j > 0; j >>= 1)
#pragma unroll
            for (int i = 0; i < 16; ++i) { const int l = i ^ j; if (l > i) { if ((i & k) == 0) cex(v[i], v[l]); else cex(v[l], v[i]); } }
}
__device__ __forceinline__ void merge16_desc(unsigned (&v)[16]) {
#pragma unroll
    for (int j = 8; j > 0; j >>= 1)
#pragma unroll
        for (int i = 0; i < 16; ++i) { const int l = i ^ j; if (l > i) cex(v[i], v[l]); }
}
__device__ __forceinline__ void top16_of_two(unsigned (&a_)[16], const unsigned (&b_)[16]) {
#pragma unroll
    for (int i = 0; i < 16; ++i) a_[i] = a_[i] > b_[15 - i] ? a_[i] : b_[15 - i];
    merge16_desc(a_);
}
__device__ __forceinline__ void lane_top16(const f32x16 (&acc)[4], int hi, unsigned (&res)[16]) {
    unsigned g[16];
#pragma unroll
    for (int kt = 0; kt < 4; ++kt) {
#pragma unroll
        for (int r = 0; r < 16; ++r) g[r] = (fkey(acc[kt][r]) & ~127u) | (unsigned)(32 * kt + crow(r, 0));
        sort16_desc(g);
        if (kt == 0) {
#pragma unroll
            for (int r = 0; r < 16; ++r) res[r] = g[r];
        } else top16_of_two(res, g);
    }
#pragma unroll
    for (int r = 0; r < 16; ++r) res[r] |= (unsigned)(4 * hi);
}
constexpr int TK_KEYS = 0, TK_KS = 272, TK_LUT = 2 * 128 * TK_KS;
__device__ __forceinline__ void topk_phase(ARGS_T a, LAS unsigned char* lds, int tid, int lane, int wave) {
    unsigned char* ws = a.ws;
    const bf16_t* KEYS = (const bf16_t*)(ws + WS_KEYS); const bf16_t* QY = (const bf16_t*)(ws + WS_Q);
    int* IDX = (int*)(ws + WS_IDX); float* GW = (float*)(ws + WS_G);
    for (int i = tid; i < 2 * 128 * 16; i += 512) { const int row = i >> 4, ch = i & 15; *(LAS u32x4*)(lds + TK_KEYS + row * TK_KS + ch * 16) = *(const u32x4*)(KEYS + (size_t)row * 128 + ch * 8); }
    __syncthreads();
    const int r32 = lane & 31, hi = lane >> 5;
    LAS unsigned* lut = (LAS unsigned*)(lds + TK_LUT) + (wave * 64 + lane) * 33;
    const int gw = blockIdx.x * 8 + wave, NGW = gridDim.x * 8;
    const int NTASK = MT * 8 / 32, NFULL = NTASK / NGW, NLEFT = NTASK - NFULL * NGW, SPREAD = NLEFT > 0 ? NGW / NLEFT : 1;
    const int nmine = NFULL + ((NLEFT > 0 && gw % SPREAD == 0 && gw / SPREAD < NLEFT) ? 1 : 0);
    for (int kk = 0; kk < nmine; ++kk) {
        const int task = kk < NFULL ? gw + kk * NGW : NFULL * NGW + gw / SPREAD;
        const size_t R = (size_t)task * 32 + r32;
        unsigned L[2][16];
#pragma unroll
        for (int p = 0; p < 2; ++p) {
            bf16x8 qf[8];
#pragma unroll
            for (int c = 0; c < 8; ++c) qf[c] = *(const bf16x8*)(QY + R * 256 + p * 128 + 16 * c + 8 * hi);
            f32x16 acc[4];
#pragma unroll
            for (int kt = 0; kt < 4; ++kt) { f32x16 s = {};
#pragma unroll
                for (int c = 0; c < 8; ++c) { const bf16x8 kf = *(const LAS bf16x8*)(lds + TK_KEYS + (p * 128 + 32 * kt + r32) * TK_KS + (16 * c + 8 * hi) * 2); s = __builtin_amdgcn_mfma_f32_32x32x16_bf16(kf, qf[c], s, 0, 0, 0); }
                acc[kt] = s; }
            lane_top16(acc, hi, L[p]);
        }
        unsigned mine[16], recv[16];
#pragma unroll
        for (int i = 0; i < 16; ++i) { const unsigned send = hi ? L[0][i] : L[1][i]; recv[i] = __shfl_xor(send, 32); mine[i] = hi ? L[1][i] : L[0][i]; }
        top16_of_two(mine, recv);
        unsigned P[16], Qk[16];
#pragma unroll
        for (int i = 0; i < 16; ++i) { P[i] = mine[i]; Qk[i] = __shfl_xor(mine[i], 32); }
#pragma unroll
        for (int i = 0; i < 16; ++i) { lut[i] = hi ? Qk[i] : P[i]; lut[16 + i] = hi ? P[i] : Qk[i]; }
        float pv[16], qv[16];
#pragma unroll
        for (int i = 0; i < 16; ++i) { pv[i] = funkey(P[i] & ~127u); qv[i] = funkey(Qk[i] & ~127u); }
        unsigned c0[16], c1[16];
        {
            int cnt = 0;
#pragma unroll
            for (int x = 0; x < 4; ++x)
#pragma unroll
                for (int y = x; y < 16; ++y) {
                    if ((x + 1) * (y + 1) <= 16) {
                        const float s = pv[x] + qv[y];
                        unsigned key = (fkey(s) & ~255u) | (hi ? (unsigned)(y * 16 + x) : (unsigned)(x * 16 + y));
                        if (x == y && hi) key = 0u;
                        if (cnt < 16) c0[cnt] = key; else c1[cnt - 16] = key;
                        ++cnt;
                    }
                }
#pragma unroll
            for (int i = 11; i < 16; ++i) c1[i] = 0u;
        }
        sort16_desc(c0); sort16_desc(c1); top16_of_two(c0, c1);
#pragma unroll
        for (int i = 0; i < 16; ++i) c1[i] = __shfl_xor(c0[i], 32);
        top16_of_two(c0, c1);
        asm volatile("s_waitcnt lgkmcnt(0)" ::: "memory");
        float top[16]; int eidx[16]; float mxv = -INFINITY;
#pragma unroll
        for (int w = 0; w < 16; ++w) { const unsigned pay = c0[w] & 255u; const unsigned k1 = lut[pay >> 4], k2 = lut[16 + (pay & 15u)];
            top[w] = funkey(k1 & ~127u) + funkey(k2 & ~127u); eidx[w] = (int)((k1 & 127u) * 128u + (k2 & 127u)); mxv = fmaxf(mxv, top[w]); }
        float se = 0.f;
#pragma unroll
        for (int w = 0; w < 16; ++w) { top[w] = __expf(top[w] - mxv); se += top[w]; }
        const float inv = 1.f / se;
        if (hi == 0) {
#pragma unroll
            for (int w = 0; w < 16; w += 4) { *(int4*)(IDX + R * 16 + w) = make_int4(eidx[w], eidx[w + 1], eidx[w + 2], eidx[w + 3]);
                *(f32x4*)(GW + R * 16 + w) = (f32x4){top[w] * inv, top[w + 1] * inv, top[w + 2] * inv, top[w + 3] * inv}; }
        }
        asm volatile("s_waitcnt lgkmcnt(0)" ::: "memory");
    }
}

constexpr int GA_PART = 0, GA_RED = 8 * 1024 * 4;
#define FP4PAIR(w, b) __builtin_amdgcn_cvt_scalef32_pk_f32_fp4((w), 1.0f, (b))
__device__ __forceinline__ float dot16_fp4(const u32x2 u, const f32x2 (&x)[8]) {
    f32x2 s = FP4PAIR(u.x, 0) * x[0];
    s += FP4PAIR(u.x, 1) * x[1]; s += FP4PAIR(u.x, 2) * x[2]; s += FP4PAIR(u.x, 3) * x[3];
    s += FP4PAIR(u.y, 0) * x[4]; s += FP4PAIR(u.y, 1) * x[5]; s += FP4PAIR(u.y, 2) * x[6]; s += FP4PAIR(u.y, 3) * x[7];
    return s.x + s.y;
}
__device__ __forceinline__ void fma16_fp4(f32x2 (&acc)[8], const u32x2 v, float w) {
    const f32x2 w2 = {w, w};
    acc[0] += FP4PAIR(v.x, 0) * w2; acc[1] += FP4PAIR(v.x, 1) * w2; acc[2] += FP4PAIR(v.x, 2) * w2; acc[3] += FP4PAIR(v.x, 3) * w2;
    acc[4] += FP4PAIR(v.y, 0) * w2; acc[5] += FP4PAIR(v.y, 1) * w2; acc[6] += FP4PAIR(v.y, 2) * w2; acc[7] += FP4PAIR(v.y, 3) * w2;
}
__device__ __forceinline__ void gather_phase(ARGS_T a, LAS unsigned char* lds, int tid, int lane, int wave) {
    unsigned char* ws = a.ws;
    const unsigned char* UT = ws + WS_UT; const unsigned char* VT = ws + WS_VT;
    const int* IDX = (const int*)(ws + WS_IDX); const float* GW = (const float*)(ws + WS_G);
    const int gw = blockIdx.x * 8 + wave, NGW = gridDim.x * 8;
    const int kmap = ((lane & 1) << 3) | ((lane & 2) << 1) | ((lane & 4) >> 1) | ((lane & 8) >> 3);
    const int NFULL = MT / NGW, NLEFT = MT - NFULL * NGW, G_ = gridDim.x;
    const bool spread = NLEFT > 0 && NLEFT % G_ == 0 && NLEFT / G_ <= 8;
    const int nmine = spread ? NFULL + (wave < NLEFT / G_ ? 1 : 0) : (MT - gw + NGW - 1) / NGW;
    for (int kk = 0; kk < nmine; ++kk) {
        const int tok = (spread && kk == NFULL) ? NFULL * NGW + wave * G_ + (int)blockIdx.x : gw + kk * NGW;
        float* hrow = a.out + (size_t)tok * DM;
        const int idxA = IDX[(size_t)tok * 128 + lane], idxB = IDX[(size_t)tok * 128 + 64 + lane];
        const float gA = GW[(size_t)tok * 128 + lane], gB = GW[(size_t)tok * 128 + 64 + lane];
        f32x2 x[8];
#pragma unroll
        for (int j = 0; j < 4; ++j) { const f32x4 t = *(const f32x4*)(hrow + lane * 16 + 4 * j); x[2 * j] = (f32x2){t.x, t.y}; x[2 * j + 1] = (f32x2){t.z, t.w}; }
        f32x2 oa[8];
#pragma unroll
        for (int i = 0; i < 8; ++i) oa[i] = (f32x2){0.f, 0.f};
        u32x2 ur[16];
#pragma unroll
        for (int k = 0; k < 16; ++k) { const int e = __builtin_amdgcn_readlane(idxA, k); ur[k] = *(const u32x2*)(UT + (size_t)e * 512 + lane * 8); }
#pragma unroll
        for (int hd = 0; hd < 8; ++hd) {
            float pd[16];
#pragma unroll
            for (int k = 0; k < 16; ++k) pd[k] = dot16_fp4(ur[k], x);
            u32x2 vr[16];
#pragma unroll
            for (int k = 0; k < 16; ++k) { const int e = __builtin_amdgcn_readlane(hd < 4 ? idxA : idxB, (hd & 3) * 16 + k); vr[k] = *(const u32x2*)(VT + (size_t)e * 512 + lane * 8); }
            if (hd < 7) {
#pragma unroll
                for (int k = 0; k < 16; ++k) { const int e = __builtin_amdgcn_readlane(hd + 1 < 4 ? idxA : idxB, ((hd + 1) & 3) * 16 + k); ur[k] = *(const u32x2*)(UT + (size_t)e * 512 + lane * 8); }
            }
            float q8[8], q4[4], q2[2], q1;
#pragma unroll
            for (int i = 0; i < 8; ++i) { const bool up = lane & 1; const float send = up ? pd[i] : pd[i + 8], keep = up ? pd[i + 8] : pd[i]; q8[i] = keep + __shfl_xor(send, 1); }
#pragma unroll
            for (int i = 0; i < 4; ++i) { const bool up = lane & 2; const float send = up ? q8[i] : q8[i + 4], keep = up ? q8[i + 4] : q8[i]; q4[i] = keep + __shfl_xor(send, 2); }
#pragma unroll
            for (int i = 0; i < 2; ++i) { const bool up = lane & 4; const float send = up ? q4[i] : q4[i + 2], keep = up ? q4[i + 2] : q4[i]; q2[i] = keep + __shfl_xor(send, 4); }
            { const bool up = lane & 8; const float send = up ? q2[0] : q2[1], keep = up ? q2[1] : q2[0]; q1 = keep + __shfl_xor(send, 8); }
            q1 += __shfl_xor(q1, 16); q1 += __shfl_xor(q1, 32);
            const float gk = __shfl(hd < 4 ? gA : gB, (hd & 3) * 16 + kmap);
            const float wgt = gk * gelu_tanh(q1 * (1.f / U4_SCALE)) * (1.f / V4_SCALE);
#pragma unroll
            for (int k = 0; k < 16; ++k) {
                const int src = ((k & 1) << 3) | ((k & 2) << 1) | ((k & 4) >> 1) | ((k & 8) >> 3);
                const float wk = __uint_as_float(__builtin_amdgcn_readlane(__float_as_uint(wgt), src));
                fma16_fp4(oa, vr[k], wk); }
        }
        float v[16]; float s = 0.f;
#pragma unroll
        for (int j = 0; j < 8; ++j) { v[2 * j] = DN_ALPHA * x[j].x + oa[j].x; v[2 * j + 1] = DN_ALPHA * x[j].y + oa[j].y; s += v[2 * j] + v[2 * j + 1]; }
        const float mean = wave_sum(s) * (1.f / DM); float s2 = 0.f;
#pragma unroll
        for (int j = 0; j < 16; ++j) { v[j] -= mean; s2 += v[j] * v[j]; }
        const float rstd = 1.f / sqrtf(wave_sum(s2) * (1.f / DM) + LN_EPS);
#pragma unroll
        for (int j = 0; j < 4; ++j) { const f32x4 g = *(const f32x4*)(a.in[I_LN2G] + lane * 16 + 4 * j), b = *(const f32x4*)(a.in[I_LN2B] + lane * 16 + 4 * j);
            *(f32x4*)(hrow + lane * 16 + 4 * j) = (f32x4){v[4 * j] * rstd * g.x + b.x, v[4 * j + 1] * rstd * g.y + b.y, v[4 * j + 2] * rstd * g.z + b.z, v[4 * j + 3] * rstd * g.w + b.w}; }
    }
}

constexpr int NPH = 10;
__global__ void __launch_bounds__(512, 2) fox_peer_fwd(Args a_unused) {
    extern __shared__ __attribute__((aligned(16))) unsigned char lds_raw[];
    LAS unsigned char* lds = (LAS unsigned char*)lds_raw;
    cg::grid_group grid = cg::this_grid();
    const int tid = threadIdx.x, lane = tid & 63, wave = __builtin_amdgcn_readfirstlane(tid >> 6);
    const int G = gridDim.x;
    typedef const __attribute__((address_space(4))) Args CArgs;
    CArgs* ap0 = (CArgs*)__builtin_amdgcn_kernarg_segment_ptr();
    unsigned char* ws = ap0->ws;
    const int lo = ap0->ph_lo, hi_ = ap0->ph_hi;
#define a (*apx)
#define PHASE_ARGS() CArgs* apx = ap0; asm volatile("" : "+s"(apx))
    volatile LAS unsigned* xst = (volatile LAS unsigned*)(lds + LDS_BYTES - 16);
    if (tid < 2) xst[tid] = 0u;
    __syncthreads();
    XcdBarrier xbar = xcd_barrier_post((unsigned*)(ws + WS_CTL), xst);
#ifndef PHMASK
#define PHMASK 0x3ff
#endif
#define IN(k) (((PHMASK >> (k)) & 1) && lo <= (k) && (k) < hi_)
#define FRESH() int tid_ = tid, lane_ = lane; asm volatile("" : "+v"(tid_), "+v"(lane_))
#define SEAM(k) do { if (IN(k) && IN((k) + 1)) { if ((k) == 0) grid.sync(); else xcd_barrier(xbar); } } while (0)

#ifdef PROBE_PH
    unsigned long long pt0 = 0, pt1 = 0;
#define PSTAMP(k) do { if ((k) == PROBE_PH) pt0 = __builtin_amdgcn_s_memrealtime(); if ((k) == PROBE_PH + 1) pt1 = __builtin_amdgcn_s_memrealtime(); } while (0)
#else
#define PSTAMP(k) do { } while (0)
#endif
    PSTAMP(0);
    if (IN(0)) { PHASE_ARGS(); FRESH(); p0_prologue<0>(a, lds, tid_, lane_, wave, (int)blockIdx.x, G); }
    SEAM(0); PSTAMP(1);
    if (IN(1)) { PHASE_ARGS();
        pg8::Gemm g{(const bf16_t*)(ws + WS_XB), (const bf16_t*)(ws + WS_WIN), MT, NIN, DM}; pg8::StaticOrder S; S.init(MT, NIN, G, (int)blockIdx.x);
        Epi1 E{a.out, ws};
        pg8::gemm_phase<Epi1, pg8::StaticOrder, true, true>(lds, g, S, E);
        { const int extra = ((MT / 256) * (NIN / 256)) % G; FRESH();
          if (extra > 0) { if ((int)blockIdx.x >= extra) p0_prologue<1>(a, lds, tid_, lane_, wave, (int)blockIdx.x - extra, G - extra); }
          else p0_prologue<1>(a, lds, tid_, lane_, wave, (int)blockIdx.x, G); }
    }
    SEAM(1); PSTAMP(2);
    if (IN(2)) { PHASE_ARGS();
#ifdef PROBE_PH
        if (PROBE_PH == 20) pt0 = __builtin_amdgcn_s_memrealtime();
#endif
        if (G == 2 * DBATCH * NH && NBATCH * NSEGP == 4 * DBATCH * NH) {
            if ((int)blockIdx.x < DBATCH * NH) rnn_tile<false>(a, lds, (int)blockIdx.x, tid, lane, wave);
            else for (int i = 0; i < 3; ++i) rnn_tile<false>(a, lds, DBATCH * NH + 3 * ((int)blockIdx.x - DBATCH * NH) + i, tid, lane, wave);
        } else
        for (int t = blockIdx.x; t < NBATCH * NSEGP; t += G) rnn_tile<false>(a, lds, t, tid, lane, wave);
#ifdef PROBE_PH
        if (PROBE_PH == 20) pt1 = __builtin_amdgcn_s_memrealtime();
        if (PROBE_PH == 21) pt0 = __builtin_amdgcn_s_memrealtime();
#endif
        for (int u = blockIdx.x; u < DBATCH * NH; u += G) attn_sample_unit(a, lds, u >> 3, u & 7, tid, lane, wave);
#ifdef PROBE_PH
        if (PROBE_PH == 21) pt1 = __builtin_amdgcn_s_memrealtime();
        if (PROBE_PH == 22) pt0 = __builtin_amdgcn_s_memrealtime();
#endif
        for (int v = blockIdx.x; v < 256; v += G) {
            const int vv = (G == 256) ? (v & 7) * 32 + (v >> 3) : v;
            const int bh = vv >> 2, s = vv & 3;
#pragma unroll 1
            for (int i = 0; i < 4; ++i) { const int qb = (i == 0) ? s : (i == 1) ? 7 - s : (i == 2) ? 8 + s : 15 - s; attn_prompt_unit(a, lds, bh >> 3, bh & 7, qb, tid, lane, wave); __syncthreads(); }
        }
    }
#ifdef PROBE_PH
    if (PROBE_PH == 22) pt1 = __builtin_amdgcn_s_memrealtime();
#endif
    SEAM(2); PSTAMP(3);
    if (IN(3)) { PHASE_ARGS(); FRESH(); for (int t = blockIdx.x; t < NBATCH * NSEGP + DBATCH; t += G) rnn_tile<true>(a, lds, t, tid_, lane_, wave); }
    SEAM(3); PSTAMP(4);
    if (IN(4)) { PHASE_ARGS();
        { pg8::Gemm g{(const bf16_t*)(ws + WS_Q), (const bf16_t*)(ws + WS_WA), MP, DM, DA}; pg8::StaticOrder S; S.init(MP, DM, G, (int)blockIdx.x);
          EpiUp<0> E{(const bf16_t*)(ws + WS_SA), (bf16_t*)(ws + WS_K)}; pg8::gemm_phase<EpiUp<0>, pg8::StaticOrder, true, true>(lds, g, S, E);
          small_gemm<EpiUp<0>>((const bf16_t*)(ws + WS_Q), (const bf16_t*)(ws + WS_WA), DM, DA, E, lane, wave); }
        { pg8::Gemm g{(const bf16_t*)(ws + WS_GG), (const bf16_t*)(ws + WS_WR), MP, DM, DR}; pg8::StaticOrder S; S.init(MP, DM, G, (int)blockIdx.x);
          EpiUp<1> E{(const bf16_t*)(ws + WS_SR), (bf16_t*)(ws + WS_K)}; pg8::gemm_phase<EpiUp<1>, pg8::StaticOrder, true, true>(lds, g, S, E);
          small_gemm<EpiUp<1>>((const bf16_t*)(ws + WS_GG), (const bf16_t*)(ws + WS_WR), DM, DR, E, lane, wave); }
    }
    SEAM(4); PSTAMP(5);
    if (IN(5)) { PHASE_ARGS();
        pg8::Gemm g{(const bf16_t*)(ws + WS_K), (const bf16_t*)(ws + WS_WO), MP, DM, DM}; pg8::StaticOrder S; S.init(MP, DM, G, (int)blockIdx.x);
        EpiOut E{(const bf16_t*)(ws + WS_XB), (bf16_t*)(ws + WS_SA)}; pg8::gemm_phase<EpiOut, pg8::StaticOrder, true, true>(lds, g, S, E);
        small_gemm<EpiOut>((const bf16_t*)(ws + WS_K), (const bf16_t*)(ws + WS_WO), DM, DM, E, lane, wave);
    }
    SEAM(5); PSTAMP(6);
    if (IN(6)) { PHASE_ARGS(); FRESH(); ln1_phase(a, lane_, wave); }
    SEAM(6); PSTAMP(7);
    if (IN(7)) { PHASE_ARGS();
        pg8::Gemm g{(const bf16_t*)(ws + WS_XB), (const bf16_t*)(ws + WS_WQ), MP, NQ, DM}; pg8::StaticOrder S; S.init(MP, NQ, G, (int)blockIdx.x);
        EpiQy E{(bf16_t*)(ws + WS_Q)}; pg8::gemm_phase<EpiQy, pg8::StaticOrder, true, true>(lds, g, S, E);
        small_gemm<EpiQy>((const bf16_t*)(ws + WS_XB), (const bf16_t*)(ws + WS_WQ), NQ, DM, E, lane, wave);
    }
    SEAM(7); PSTAMP(8);
    if (IN(8)) { PHASE_ARGS(); FRESH(); topk_phase(a, lds, tid_, lane_, wave); }
    SEAM(8); PSTAMP(9);
    if (IN(9)) { PHASE_ARGS(); FRESH(); gather_phase(a, lds, tid_, lane_, wave); }
#ifdef PROBE_PH
    if (PROBE_PH == 9) pt1 = __builtin_amdgcn_s_memrealtime();
#ifndef PROBE_BLK
#define PROBE_BLK 0
#endif
    if (blockIdx.x == PROBE_BLK && tid == 0) { const unsigned long long te = __builtin_amdgcn_s_memrealtime(), want = 2ull * (pt1 - pt0); while (__builtin_amdgcn_s_memrealtime() - te < want) __builtin_amdgcn_s_sleep(16); }
#endif
#undef a
#undef IN
#undef SEAM
}

#ifndef N_LAUNCHES
#define N_LAUNCHES 1
#endif
extern "C" void kernel_launch(void* const* d_in, const int* in_sizes, int n_in, void* d_out, int out_size, void* d_ws, size_t ws_size, hipStream_t stream) {
    static int grid = 0;
    if (grid == 0) {
        if (n_in != 28 || (size_t)out_size != OUT_TOTAL || ws_size < WS_END) { fprintf(stderr, "kernel_launch: unexpected problem: n_in %d out %d ws %zu\n", n_in, out_size, ws_size); grid = -1; return; }
        int dev = 0, cus = 0, per_cu = 0;
        hipGetDevice(&dev); hipDeviceGetAttribute(&cus, hipDeviceAttributeMultiprocessorCount, dev);
        if (hipFuncSetAttribute((const void*)fox_peer_fwd, hipFuncAttributeMaxDynamicSharedMemorySize, LDS_BYTES) != hipSuccess) { fprintf(stderr, "kernel_launch: hipFuncSetAttribute failed\n"); grid = -1; return; }
        if (hipOccupancyMaxActiveBlocksPerMultiprocessor(&per_cu, (const void*)fox_peer_fwd, 512, LDS_BYTES) != hipSuccess || per_cu < 1) { fprintf(stderr, "kernel_launch: occupancy query gave %d\n", per_cu); per_cu = 1; }
        (void)hipGetLastError();
        grid = cus * (per_cu < 1 ? 1 : per_cu);
    }
    if (grid < 0) return;
    if (hipMemsetAsync((char*)d_ws + WS_CTL, 0, 16384, stream) != hipSuccess) { fprintf(stderr, "kernel_launch: memset failed\n"); return; }
    Args a{};
    for (int i = 0; i < 28; ++i) a.in[i] = (const float*)d_in[i];
    a.out = (float*)d_out; a.ws = (unsigned char*)d_ws;
#if N_LAUNCHES == 1
    a.ph_lo = 0; a.ph_hi = NPH;
    void* args[] = {&a};
    hipError_t e = hipLaunchCooperativeKernel((const void*)fox_peer_fwd, dim3(grid), dim3(512), args, LDS_BYTES, stream);
    if (e != hipSuccess) fprintf(stderr, "cooperative launch failed: %s (grid %d)\n", hipGetErrorString(e), grid);
#else
    for (int p = 0; p < NPH; ++p) { a.ph_lo = p; a.ph_hi = p + 1; hipLaunchKernelGGL(fox_peer_fwd, dim3(grid), dim3(512), LDS_BYTES, stream, a); }
#endif
}
```

```cpp
#include <hip/hip_runtime.h>
#include <hip/hip_cooperative_groups.h>
#include <cstdio>
#include <cstdint>
namespace cg = cooperative_groups;
namespace pg8 {
#define PG8_LAS __attribute__((address_space(3)))
typedef unsigned short bf16_t;
typedef short bf16x8 __attribute__((ext_vector_type(8)));
typedef float f32x4 __attribute__((ext_vector_type(4)));
typedef unsigned u32x4 __attribute__((ext_vector_type(4)));
constexpr int BM = 256, BK = 64, HALF = 128, HTB = HALF * BK * 2  , STAGE_BYTES = 8 * HTB, NXCD = 8, WGM = 8;

__host__ __device__ __forceinline__ int lds_byte(int r, int c) { const int st = (r >> 4) * 2 + (c >> 5), rr = r & 15, cc = c & 31, ob = rr * 64 + cc * 2; return st * 1024 + (ob ^ (((ob >> 9) & 1) << 5)); }
__host__ __device__ __forceinline__ void stage_rc(int b, int& R, int& C) { const int st = b / 1024, sb = b % 1024, swz = sb ^ (((sb >> 9) & 1) << 5); R = (st >> 1) * 16 + swz / 64; C = (st & 1) * 32 + (swz % 64) / 2; }
__host__ __device__ __forceinline__ int perm32(int rho) { const int n = rho >> 4, i = rho & 15; return 8 * (i >> 2) + 4 * n + (i & 3); }

struct Unit { int pm, pn; };
struct Gemm { const bf16_t* A; const bf16_t* Bt; int M, N, K; };

struct StaticOrder {
    int nM, nN, nwg, G, c;
    __host__ __device__ void init(int M, int N, int G_, int c_) { nM = M / BM; nN = N / BM; nwg = nM * nN; G = G_; c = c_; }
    __host__ __device__ bool next(int i, Unit& u) const {
        const long L = (long)i * G + c; if (L >= nwg) return false;
        int wgid = (int)L; { const int q = nwg / NXCD, r = nwg % NXCD, xcd = wgid % NXCD, off = wgid / NXCD; wgid = (xcd < r ? xcd * (q + 1) : r * (q + 1) + (xcd - r) * q) + off; }
        const int nig = WGM * nN, gid = wgid / nig, fm = gid * WGM, gsz = (nM - fm) < WGM ? (nM - fm) : WGM;
        u.pm = fm + ((wgid % nig) % gsz); u.pn = (wgid % nig) / gsz; return true;
    }
    __device__ __forceinline__ void a_ready(const Unit&) const {}
    __device__ __forceinline__ void done(const Unit&) const {}
};

__device__ __forceinline__ unsigned cvt_pk_bf16(float lo, float hi) { unsigned r; asm volatile("v_cvt_pk_bf16_f32 %0, %1, %2" : "=v"(r) : "v"(lo), "v"(hi)); return r; }
template <class Epi, class Sched, bool ALIGN_EPI = false, bool SP2 = false>
__device__ __forceinline__ void gemm_phase(PG8_LAS unsigned char* lds, const Gemm g, const Sched& S, const Epi& E) {
    const int tid = threadIdx.x, wid = __builtin_amdgcn_readfirstlane(tid >> 6), lane = tid & 63, wr = wid >> 2, wc = wid & 3, fr = lane & 15, fq = lane >> 4;
    const int K = g.K, nt = K / BK;
    unsigned voffA[2], voffB[2];
#pragma unroll
    for (int i = 0; i < 2; ++i) { int R, C; stage_rc(tid * 16 + i * 8192, R, C); const int Rb = Epi::PERM ? ((R & ~31) + perm32(R & 31)) : R;
        voffA[i] = (unsigned)(R * K + C) * 2u; voffB[i] = (unsigned)(Rb * K + C) * 2u; }
    const size_t kstep = (size_t)(BK * 2);
    const size_t hstep = (size_t)HALF * K * 2;
    const size_t tstep = 2 * hstep;
    const unsigned ldsw = (unsigned)wid * 1024u;
    const int aoff = lds_byte(wr * 64 + fr, fq * 8), boff = lds_byte(wc * 32 + fr, fq * 8);
#define PG8_SA(b, h) (((b) * 2 + (h)) * HTB)
#define PG8_SB(b, h) ((4 + (b) * 2 + (h)) * HTB)
#define PG8_STAGE(bufoff, gbase, voff) do { _Pragma("unroll") for (int _i = 0; _i < 2; ++_i) \
        __builtin_amdgcn_global_load_lds((const unsigned*)((const char*)(gbase) + (voff)[_i]), (PG8_LAS unsigned*)(lds + (bufoff) + ldsw + _i * 8192), 16, 0, 0); } while (0)
#define PG8_LDA(dst, b, h) do { _Pragma("unroll") for (int m = 0; m < 4; ++m) _Pragma("unroll") for (int k = 0; k < 2; ++k) dst[m][k] = *(const PG8_LAS bf16x8*)(lds + PG8_SA(b, h) + aoff + m * 2048 + k * 1024); } while (0)
#define PG8_LDB(dst, b, h) do { _Pragma("unroll") for (int n = 0; n < 2; ++n) _Pragma("unroll") for (int k = 0; k < 2; ++k) dst[n][k] = *(const PG8_LAS bf16x8*)(lds + PG8_SB(b, h) + boff + n * 2048 + k * 1024); } while (0)
#define PG8_MMA(ai, bj, At, Bt) do { __builtin_amdgcn_s_setprio(1); _Pragma("unroll") for (int m = 0; m < 4; ++m) _Pragma("unroll") for (int n = 0; n < 2; ++n) _Pragma("unroll") for (int k = 0; k < 2; ++k) \
        acc[ai][bj][m][n] = __builtin_amdgcn_mfma_f32_16x16x32_bf16(Bt[n][k], At[m][k], acc[ai][bj][m][n], 0, 0, 0); __builtin_amdgcn_s_setprio(0); } while (0)
#define PG8_WAIT_V(n) asm volatile("s_waitcnt vmcnt(" #n ")" ::: "memory")
#define PG8_WAIT_L(n) asm volatile("s_waitcnt lgkmcnt(" #n ")" ::: "memory")
#define PG8_BAR __builtin_amdgcn_s_barrier()
#define PG8_SCHED __builtin_amdgcn_sched_barrier(0)
    Unit cur, nxt; int ui = 0;
    if (!S.next(0, cur)) return;
    f32x4 acc[2][2][4][2];
#pragma unroll
    for (int a = 0; a < 2; ++a)
#pragma unroll
        for (int b = 0; b < 2; ++b)
#pragma unroll
            for (int m = 0; m < 4; ++m)
#pragma unroll
                for (int n = 0; n < 2; ++n) acc[a][b][m][n] = (f32x4){0.f, 0.f, 0.f, 0.f};
    bf16x8 At[4][2], B0[2][2], B1[2][2];
    const char* cA = (const char*)g.A + (size_t)cur.pm * tstep; const char* cB = (const char*)g.Bt + (size_t)cur.pn * tstep;
    S.a_ready(cur);
    if constexpr (SP2) {
        PG8_STAGE(PG8_SB(0, 0), cB, voffB); PG8_STAGE(PG8_SB(0, 1), cB + hstep, voffB); PG8_STAGE(PG8_SA(0, 0), cA, voffA); PG8_STAGE(PG8_SA(0, 1), cA + hstep, voffA);
        if (wr == 1) PG8_BAR;
        PG8_WAIT_V(2); PG8_BAR;
        PG8_STAGE(PG8_SB(1, 0), cB + kstep, voffB); PG8_STAGE(PG8_SA(1, 0), cA + kstep, voffA); PG8_STAGE(PG8_SB(1, 1), cB + hstep + kstep, voffB);
        PG8_WAIT_V(6); PG8_BAR;
    } else {
        PG8_STAGE(PG8_SB(0, 0), cB, voffB); PG8_STAGE(PG8_SA(0, 0), cA, voffA); PG8_STAGE(PG8_SB(0, 1), cB + hstep, voffB); PG8_STAGE(PG8_SA(0, 1), cA + hstep, voffA);
        if (wr == 1) PG8_BAR;
        PG8_WAIT_V(4); PG8_BAR;
        PG8_STAGE(PG8_SB(1, 0), cB + kstep, voffB); PG8_STAGE(PG8_SA(1, 0), cA + kstep, voffA); PG8_STAGE(PG8_SB(1, 1), cB + hstep + kstep, voffB);
        PG8_WAIT_V(6); PG8_BAR;
    }
    for (;;) {
        const bool has_next = S.next(ui + 1, nxt);
        const char* nA = has_next ? (const char*)g.A + (size_t)nxt.pm * tstep : cA; const char* nB = has_next ? (const char*)g.Bt + (size_t)nxt.pn * tstep : cB;
        for (int t = 0; t < nt; t += 2) {
            const bool last = (t == nt - 2);
            const char* a1 = cA + (size_t)(t + 1) * kstep;
            const char* a2 = last ? nA : cA + (size_t)(t + 2) * kstep; const char* b2 = last ? nB : cB + (size_t)(t + 2) * kstep;
            const char* a3 = a2 + kstep; const char* b3 = b2 + kstep;
            if (last && has_next) S.a_ready(nxt);
            if constexpr (SP2) {
            PG8_LDB(B0, 0, 0); PG8_LDB(B1, 0, 1); PG8_SCHED; PG8_LDA(At, 0, 0); PG8_STAGE(PG8_SA(1, 1), a1 + hstep, voffA);
            PG8_WAIT_V(8); PG8_WAIT_L(0); PG8_BAR; PG8_MMA(0, 0, At, B0); PG8_MMA(0, 1, At, B1); PG8_BAR; PG8_SCHED;
            PG8_LDA(At, 0, 1); PG8_STAGE(PG8_SB(0, 0), b2, voffB); PG8_STAGE(PG8_SB(0, 1), b2 + hstep, voffB); PG8_STAGE(PG8_SA(0, 0), a2, voffA);
            PG8_WAIT_V(8); PG8_WAIT_L(0); PG8_BAR; PG8_MMA(1, 0, At, B0); PG8_MMA(1, 1, At, B1); PG8_BAR; PG8_SCHED;
            PG8_LDB(B0, 1, 0); PG8_LDB(B1, 1, 1); PG8_SCHED; PG8_LDA(At, 1, 0); PG8_STAGE(PG8_SA(0, 1), a2 + hstep, voffA);
            PG8_WAIT_V(8); PG8_WAIT_L(0); PG8_BAR; PG8_MMA(0, 0, At, B0); PG8_MMA(0, 1, At, B1); PG8_BAR; PG8_SCHED;
            PG8_LDA(At, 1, 1); PG8_STAGE(PG8_SB(1, 0), b3, voffB); PG8_STAGE(PG8_SB(1, 1), b3 + hstep, voffB); PG8_STAGE(PG8_SA(1, 0), a3, voffA);
            PG8_WAIT_V(8); PG8_WAIT_L(0); PG8_BAR; PG8_MMA(1, 0, At, B0); PG8_MMA(1, 1, At, B1); PG8_BAR; PG8_SCHED;
            } else {
            PG8_LDB(B0, 0, 0); PG8_SCHED; PG8_LDA(At, 0, 0); PG8_STAGE(PG8_SA(1, 1), a1 + hstep, voffA);
            PG8_WAIT_L(8); PG8_BAR; PG8_WAIT_L(0); PG8_MMA(0, 0, At, B0); PG8_BAR; PG8_SCHED;
            PG8_LDB(B1, 0, 1); PG8_STAGE(PG8_SB(0, 0), b2, voffB);
            PG8_BAR; PG8_WAIT_L(0); PG8_MMA(0, 1, At, B1); PG8_BAR;
            PG8_LDA(At, 0, 1); PG8_STAGE(PG8_SA(0, 0), a2, voffA);
            PG8_BAR; PG8_WAIT_L(0); PG8_MMA(1, 0, At, B0); PG8_BAR; PG8_SCHED;
            PG8_STAGE(PG8_SB(0, 1), b2 + hstep, voffB);
            PG8_WAIT_V(6); PG8_BAR; PG8_MMA(1, 1, At, B1); PG8_BAR;
            PG8_LDB(B0, 1, 0); PG8_SCHED; PG8_LDA(At, 1, 0); PG8_STAGE(PG8_SA(0, 1), a2 + hstep, voffA);
            PG8_WAIT_L(8); PG8_BAR; PG8_WAIT_L(0); PG8_MMA(0, 0, At, B0); PG8_BAR; PG8_SCHED;
            PG8_LDB(B1, 1, 1); PG8_STAGE(PG8_SB(1, 0), b3, voffB);
            PG8_BAR; PG8_WAIT_L(0); PG8_MMA(0, 1, At, B1); PG8_BAR;
            PG8_LDA(At, 1, 1); PG8_STAGE(PG8_SA(1, 0), a3, voffA);
            PG8_BAR; PG8_WAIT_L(0); PG8_MMA(1, 0, At, B0); PG8_BAR; PG8_SCHED;
            PG8_STAGE(PG8_SB(1, 1), b3 + hstep, voffB);
            PG8_WAIT_V(6); PG8_BAR; PG8_MMA(1, 1, At, B1); PG8_BAR;
            }
        }
        if constexpr (ALIGN_EPI) { if (wr == 0) PG8_BAR; }
        if constexpr (!Epi::AFTER_DRAIN) { E(acc, cur, wr, wc, fr, fq); S.done(cur); }
        if (!has_next) break;
#pragma unroll
        for (int a = 0; a < 2; ++a)
#pragma unroll
            for (int b = 0; b < 2; ++b)
#pragma unroll
                for (int m = 0; m < 4; ++m)
#pragma unroll
                    for (int n = 0; n < 2; ++n) acc[a][b][m][n] = (f32x4){0.f, 0.f, 0.f, 0.f};
        cur = nxt; cA = nA; cB = nB; ++ui;
        if constexpr (ALIGN_EPI) { if (wr == 1) PG8_BAR; }
    }
    PG8_WAIT_V(0);
    if constexpr (!ALIGN_EPI) { if (wr == 0) PG8_BAR; }
    PG8_BAR;
    if constexpr (Epi::AFTER_DRAIN) { E.fused(acc, cur, wr, wc, fr, fq, lds, wid, lane); S.done(cur); }
#undef PG8_SA
#undef PG8_SB
#undef PG8_STAGE
#undef PG8_LDA
#undef PG8_LDB
#undef PG8_MMA
#undef PG8_WAIT_V
#undef PG8_WAIT_L
#undef PG8_BAR
#undef PG8_SCHED
}
}

#define LAS __attribute__((address_space(3)))
typedef unsigned short bf16_t;
typedef short bf16x8 __attribute__((ext_vector_type(8)));
typedef float f32x4 __attribute__((ext_vector_type(4)));
typedef float f32x2 __attribute__((ext_vector_type(2)));
typedef float f32x16 __attribute__((ext_vector_type(16)));
typedef unsigned u32x4 __attribute__((ext_vector_type(4)));
typedef unsigned u32x2 __attribute__((ext_vector_type(2)));
typedef short v4i16_t __attribute__((ext_vector_type(4)));
typedef __bf16 bf16x2_t __attribute__((ext_vector_type(2)));

constexpr int DM = 1024, NBATCH = 8, SEQ = 4096, DBATCH = 16, DSEQ = 32, PAST = 1024, NH = 8, HD = 64, DA = 512, DR = 512;
constexpr int MP = NBATCH * SEQ, MS = DBATCH * DSEQ, MT = MP + MS;
constexpr int DIN = 4616, NIN = 4608, NE = 16384, NQ = 2048;
constexpr float LN_EPS = 1e-5f, DN_ALPHA = 1.189207115002721f, LOG2E = 1.4426950408889634f;
constexpr int NSEGP = SEQ / 64;
constexpr size_t OFF_KP = 34078720, OFF_VP = 50855936, OFF_FP = 67633152, OFF_CP = 67895296, OFF_RP = 67907584,
                 OFF_KS = 67911680, OFF_VS = 68173824, OFF_FS = 68435968, OFF_CS = 68440064, OFF_RS = 68464640, OUT_TOTAL = 68472832;
constexpr size_t MiB = 1u << 20;
constexpr size_t WS_XB = 0;
constexpr size_t WS_WIN = 65 * MiB;
constexpr size_t WS_WA = 74 * MiB, WS_WR = 75 * MiB, WS_WO = 76 * MiB, WS_WQ = 78 * MiB;
constexpr size_t WS_KEYS = 82 * MiB, WS_RGA = 82 * MiB + 65536, WS_RGX = 82 * MiB + 131072;
constexpr size_t WS_UT = 83 * MiB, WS_VT = 115 * MiB;
constexpr size_t QKV_BYTES = (size_t)MT * 512 * 2;
constexpr size_t WS_Q = 147 * MiB, WS_K = WS_Q + QKV_BYTES, WS_V = WS_K + QKV_BYTES, WS_XR = WS_V + QKV_BYTES;
constexpr size_t WS_GG = 277 * MiB;
constexpr size_t WS_SA = WS_GG + QKV_BYTES, WS_SR = WS_SA + 2 * QKV_BYTES;
constexpr size_t WS_LC = 440 * MiB, WS_SCH = 442 * MiB, WS_RA = 442 * MiB + 65536, WS_RB = WS_RA + MiB;
constexpr size_t WS_IDX = 445 * MiB, WS_G = 462 * MiB, WS_CTL = 479 * MiB, WS_END = 480 * MiB;
static_assert(WS_XR + QKV_BYTES <= WS_GG && WS_SR + 2 * QKV_BYTES <= WS_LC && WS_IDX + (size_t)MT * 8 * 16 * 4 <= WS_G && WS_G + (size_t)MT * 8 * 16 * 4 <= WS_END, "ws map");

constexpr int LDS_BYTES = 147456;

struct Args { const float* in[28]; float* out; unsigned char* ws; int ph_lo, ph_hi; };
#define ARGS_T const __attribute__((address_space(4))) Args&
enum { I_XP = 0, I_XS, I_CK, I_CV, I_CLF, I_SCONV, I_SRNN, I_WIN, I_BF, I_CONVW, I_CONVB, I_RGA, I_BRGA, I_RGX, I_BRGX, I_LAM, I_WAUP, I_WRUP, I_WOUT, I_LN1G, I_LN1B,
       I_WQ, I_K1, I_K2, I_PU, I_PV, I_LN2G, I_LN2B };

__device__ __forceinline__ unsigned pk2(float lo, float hi) { f32x2 v = {lo, hi}; bf16x2_t b = __builtin_convertvector(v, bf16x2_t); return __builtin_bit_cast(unsigned, b); }
__device__ __forceinline__ float bflo(unsigned u) { return __uint_as_float(u << 16); }
__device__ __forceinline__ float bfhi(unsigned u) { return __uint_as_float(u & 0xffff0000u); }
__device__ __forceinline__ float bf1(bf16_t b) { return __uint_as_float((unsigned)b << 16); }
__device__ __forceinline__ float sigmoidf_(float x) { return __builtin_amdgcn_rcpf(1.f + __expf(-x)); }
__device__ __forceinline__ float gelu_tanh(float x) { const float u = 0.7978845608028654f * (x + 0.044715f * x * x * x); return x * sigmoidf_(2.f * u); }
__device__ __forceinline__ const float* xrow_ptr(ARGS_T a, int m) { return m < MP ? a.in[I_XP] + (size_t)m * DM : a.in[I_XS] + (size_t)(m - MP) * DM; }
__device__ __forceinline__ float wave_sum(float v) {
#pragma unroll
    for (int o = 1; o < 64; o <<= 1) v += __shfl_xor(v, o);
    return v;
}
__device__ __forceinline__ int crow(int r, int hi) { return (r & 3) + 8 * (r >> 2) + 4 * hi; }

__device__ __forceinline__ void transpose_item(const float* W, int ldw, bf16_t* WT, int ldk, LAS float* scr, int k0, int n0src, int n0dst, int lane) {
#pragma unroll 8
    for (int i = 0; i < 32; ++i) { const int kk = 2 * i + (lane >> 5); scr[kk * 33 + (lane & 31)] = W[(size_t)(k0 + kk) * ldw + n0src + (lane & 31)]; }
    asm volatile("s_waitcnt lgkmcnt(0)" ::: "memory");
    const int c = lane & 7;
#pragma unroll
    for (int j = 0; j < 4; ++j) { const int n = (lane >> 3) + 8 * j; const LAS float* s = scr + (8 * c) * 33 + n;
        u32x4 o; o.x = pk2(s[0 * 33], s[1 * 33]); o.y = pk2(s[2 * 33], s[3 * 33]); o.z = pk2(s[4 * 33], s[5 * 33]); o.w = pk2(s[6 * 33], s[7 * 33]);
        *(u32x4*)(WT + (size_t)(n0dst + n) * ldk + k0 + 8 * c) = o; }
    asm volatile("s_waitcnt lgkmcnt(0)" ::: "memory");
}
__device__ __forceinline__ void cvt8(const float* src, bf16_t* dst, size_t i) {
    const f32x4 v0 = *(const f32x4*)(src + i * 8), v1 = *(const f32x4*)(src + i * 8 + 4);
    u32x4 o; o.x = pk2(v0.x, v0.y); o.y = pk2(v0.z, v0.w); o.z = pk2(v1.x, v1.y); o.w = pk2(v1.z, v1.w);
    *(u32x4*)(dst + i * 8) = o;
}
constexpr float U4_SCALE = 64.f, V4_SCALE = 9.5f;
__device__ __forceinline__ void cvt16_fp4(const float* src, unsigned char* dst, size_t i, float sc) {
    const f32x4 v0 = *(const f32x4*)(src + i * 16) * sc, v1 = *(const f32x4*)(src + i * 16 + 4) * sc, v2 = *(const f32x4*)(src + i * 16 + 8) * sc, v3 = *(const f32x4*)(src + i * 16 + 12) * sc;
    unsigned lo = 0u, hi = 0u;
    lo = __builtin_amdgcn_cvt_scalef32_pk_fp4_f32(lo, v0.x, v0.y, 1.0f, 0); lo = __builtin_amdgcn_cvt_scalef32_pk_fp4_f32(lo, v0.z, v0.w, 1.0f, 1);
    lo = __builtin_amdgcn_cvt_scalef32_pk_fp4_f32(lo, v1.x, v1.y, 1.0f, 2); lo = __builtin_amdgcn_cvt_scalef32_pk_fp4_f32(lo, v1.z, v1.w, 1.0f, 3);
    hi = __builtin_amdgcn_cvt_scalef32_pk_fp4_f32(hi, v2.x, v2.y, 1.0f, 0); hi = __builtin_amdgcn_cvt_scalef32_pk_fp4_f32(hi, v2.z, v2.w, 1.0f, 1);
    hi = __builtin_amdgcn_cvt_scalef32_pk_fp4_f32(hi, v3.x, v3.y, 1.0f, 2); hi = __builtin_amdgcn_cvt_scalef32_pk_fp4_f32(hi, v3.z, v3.w, 1.0f, 3);
    *(u32x2*)(dst + i * 8) = (u32x2){lo, hi};
}
template <int PART> __device__ __forceinline__ void p0_prologue(ARGS_T a, LAS unsigned char* lds, int tid, int lane, int wave, int vblk, int nblk) {
    unsigned char* ws = a.ws;
    const int G = nblk, gw = vblk * 8 + wave, NGW = G * 8;
    {
        LAS float* scr = (LAS float*)(lds + wave * 8448);
        constexpr int I0 = 16 * 144, I1 = 8 * 32, I2 = 8 * 32, I3 = 16 * 32, I4 = 16 * 64, I5 = 16, I6 = 16, NIT = I0 + I1 + I2 + I3 + I4 + I5 + I6;
        const int TF = NIT / NGW, TL = NIT - TF * NGW, tl_idx = wave * G + vblk;
        const int tmine = TF + (tl_idx < TL ? 1 : 0);
        for (int k2 = 0; k2 < tmine; ++k2) {
            const int it = k2 < TF ? gw + k2 * NGW : TF * NGW + tl_idx;
            { const bool deferred = (it >= I0 && it < I0 + I1 + I2 + I3 + I4); if (deferred != (PART == 1)) continue; }
            int r = it;
            if (r < I0) { const int kb = r / 144, nb = r % 144, n0 = 32 * nb; transpose_item(a.in[I_WIN], DIN, (bf16_t*)(ws + WS_WIN), 1024, scr, 64 * kb, n0 + (n0 >= 1536 ? 8 : 0), n0, lane); continue; } r -= I0;
            if (r < I1) { transpose_item(a.in[I_WAUP], 1024, (bf16_t*)(ws + WS_WA), 512, scr, 64 * (r / 32), 32 * (r % 32), 32 * (r % 32), lane); continue; } r -= I1;
            if (r < I2) { transpose_item(a.in[I_WRUP], 1024, (bf16_t*)(ws + WS_WR), 512, scr, 64 * (r / 32), 32 * (r % 32), 32 * (r % 32), lane); continue; } r -= I2;
            if (r < I3) { transpose_item(a.in[I_WOUT], 1024, (bf16_t*)(ws + WS_WO), 1024, scr, 64 * (r / 32), 32 * (r % 32), 32 * (r % 32), lane); continue; } r -= I3;
            if (r < I4) { transpose_item(a.in[I_WQ], 2048, (bf16_t*)(ws + WS_WQ), 1024, scr, 64 * (r / 64), 32 * (r % 64), 32 * (r % 64), lane); continue; } r -= I4;
            if (r < I5) { const int n = r >> 1, nb = r & 1; transpose_item(a.in[I_RGA] + n * 4096, 64, (bf16_t*)(ws + WS_RGA) + n * 4096, 64, scr, 0, 32 * nb, 32 * nb, lane); continue; } r -= I5;
            { const int n = r >> 1, nb = r & 1; transpose_item(a.in[I_RGX] + n * 4096, 64, (bf16_t*)(ws + WS_RGX) + n * 4096, 64, scr, 0, 32 * nb, 32 * nb, lane); }
        }
    }
    {
        const unsigned stride = (unsigned)G * 512u, t0 = (unsigned)vblk * 512u + (unsigned)tid;
#define CVT_LOOP(NITEMS, LOADN, BODY) { unsigned i = t0; \
            for (; i + 3u * stride < (unsigned)(NITEMS); i += 4u * stride) { f32x4 r_[4][LOADN]; \
                _Pragma("unroll") for (int q = 0; q < 4; ++q) { const unsigned ii = i + q * stride; _Pragma("unroll") for (int e = 0; e < LOADN; ++e) r_[q][e] = *(const f32x4*)(SRC + (size_t)ii * (4 * LOADN) + 4 * e); } \
                _Pragma("unroll") for (int q = 0; q < 4; ++q) { const unsigned ii = i + q * stride; BODY } } \
            for (; i < (unsigned)(NITEMS); i += stride) { f32x4 r_[1][LOADN]; constexpr int q = 0; const unsigned ii = i; \
                _Pragma("unroll") for (int e = 0; e < LOADN; ++e) r_[0][e] = *(const f32x4*)(SRC + (size_t)ii * (4 * LOADN) + 4 * e); BODY } }
#define BF8_BODY(DST) { u32x4 o_; o_.x = pk2(r_[q][0].x, r_[q][0].y); o_.y = pk2(r_[q][0].z, r_[q][0].w); o_.z = pk2(r_[q][1].x, r_[q][1].y); o_.w = pk2(r_[q][1].z, r_[q][1].w); *(u32x4*)((DST) + (size_t)ii * 8) = o_; }
#define FP4_BODY(DST, SCL) { const f32x4 v0 = r_[q][0] * (SCL), v1 = r_[q][1] * (SCL), v2 = r_[q][2] * (SCL), v3 = r_[q][3] * (SCL); unsigned lo = 0u, hi = 0u; \
            lo = __builtin_amdgcn_cvt_scalef32_pk_fp4_f32(lo, v0.x, v0.y, 1.0f, 0); lo = __builtin_amdgcn_cvt_scalef32_pk_fp4_f32(lo, v0.z, v0.w, 1.0f, 1); \
            lo = __builtin_amdgcn_cvt_scalef32_pk_fp4_f32(lo, v1.x, v1.y, 1.0f, 2); lo = __builtin_amdgcn_cvt_scalef32_pk_fp4_f32(lo, v1.z, v1.w, 1.0f, 3); \
            hi = __builtin_amdgcn_cvt_scalef32_pk_fp4_f32(hi, v2.x, v2.y, 1.0f, 0); hi = __builtin_amdgcn_cvt_scalef32_pk_fp4_f32(hi, v2.z, v2.w, 1.0f, 1); \
            hi = __builtin_amdgcn_cvt_scalef32_pk_fp4_f32(hi, v3.x, v3.y, 1.0f, 2); hi = __builtin_amdgcn_cvt_scalef32_pk_fp4_f32(hi, v3.z, v3.w, 1.0f, 3); \
            *(u32x2*)((DST) + (size_t)ii * 8) = (u32x2){lo, hi}; }
        if (PART == 0) {
        { const float* SRC = a.in[I_K1]; bf16_t* D = (bf16_t*)(ws + WS_KEYS); CVT_LOOP((size_t)2048, 2, BF8_BODY(D)) }
        { const float* SRC = a.in[I_K2]; bf16_t* D = (bf16_t*)(ws + WS_KEYS) + 16384; CVT_LOOP((size_t)2048, 2, BF8_BODY(D)) }
        } else {
        { const float* SRC = a.in[I_PU]; unsigned char* D = ws + WS_UT; CVT_LOOP((size_t)NE * DM / 16, 4, FP4_BODY(D, U4_SCALE)) }
        { const float* SRC = a.in[I_PV]; unsigned char* D = ws + WS_VT; CVT_LOOP((size_t)NE * DM / 16, 4, FP4_BODY(D, V4_SCALE)) }
        }
#undef CVT_LOOP
#undef BF8_BODY
#undef FP4_BODY
    }
    __syncthreads();
    if (PART == 0) {
        LAS float* wf = (LAS float*)lds;
        LAS float* lfs = (LAS float*)(lds + 32768);
        const float* win = a.in[I_WIN];
        bool staged = false;
        const bool spread = (MS % (2 * G) == 0) && (MS / (2 * G) <= 8);
        const int NU = spread ? MP / 64 : MT / 64;
        const int nloops = (vblk < NU ? (NU - vblk + G - 1) / G : 0) + (spread ? 1 : 0);
        for (int lp = 0; lp < nloops; ++lp) {
            const int u = vblk + lp * G; const bool spass = spread && u >= NU;
            if (!staged) { for (int i = tid; i < 8192; i += 512) wf[i] = win[(size_t)(i >> 3) * DIN + 1536 + (i & 7)]; staged = true; __syncthreads(); }
            const int m0 = spass ? 0 : 64 * u; const int ni = spass ? (wave < MS / (2 * G) ? 2 : 0) : 8;
            for (int i = 0; i < ni; i += 2) {
                const int m = spass ? MP + 2 * (wave * G + vblk) : m0 + 8 * wave + i; const float* xr0 = xrow_ptr(a, m); const float* xr1 = xrow_ptr(a, m + 1);
                float xv0[16], xv1[16];
#pragma unroll
                for (int kk = 0; kk < 16; ++kk) { xv0[kk] = xr0[lane + 64 * kk]; xv1[kk] = xr1[lane + 64 * kk]; }
                { bf16_t* xb0 = (bf16_t*)(ws + WS_XB) + (size_t)m * DM; bf16_t* xb1 = xb0 + DM;
#pragma unroll
                  for (int kk = 0; kk < 16; ++kk) { xb0[lane + 64 * kk] = (bf16_t)(pk2(xv0[kk], 0.f) & 0xffffu); xb1[lane + 64 * kk] = (bf16_t)(pk2(xv1[kk], 0.f) & 0xffffu); } }
                float acc[16];
#pragma unroll
                for (int h = 0; h < 16; ++h) acc[h] = 0.f;
#pragma unroll
                for (int kk = 0; kk < 16; ++kk) { const int k = lane + 64 * kk; const f32x4 w0 = *(const LAS f32x4*)(wf + k * 8), w1 = *(const LAS f32x4*)(wf + k * 8 + 4);
                    acc[0] += xv0[kk] * w0.x; acc[1] += xv0[kk] * w0.y; acc[2] += xv0[kk] * w0.z; acc[3] += xv0[kk] * w0.w; acc[4] += xv0[kk] * w1.x; acc[5] += xv0[kk] * w1.y; acc[6] += xv0[kk] * w1.z; acc[7] += xv0[kk] * w1.w;
                    acc[8] += xv1[kk] * w0.x; acc[9] += xv1[kk] * w0.y; acc[10] += xv1[kk] * w0.z; acc[11] += xv1[kk] * w0.w; acc[12] += xv1[kk] * w1.x; acc[13] += xv1[kk] * w1.y; acc[14] += xv1[kk] * w1.z; acc[15] += xv1[kk] * w1.w; }
                float q8[8], q4[4], q2[2], q1;
#pragma unroll
                for (int j = 0; j < 8; ++j) { const bool up = lane & 1; const float send = up ? acc[j] : acc[j + 8], keep = up ? acc[j + 8] : acc[j]; q8[j] = keep + __shfl_xor(send, 1); }
#pragma unroll
                for (int j = 0; j < 4; ++j) { const bool up = lane & 2; const float send = up ? q8[j] : q8[j + 4], keep = up ? q8[j + 4] : q8[j]; q4[j] = keep + __shfl_xor(send, 2); }
#pragma unroll
                for (int j = 0; j < 2; ++j) { const bool up = lane & 4; const float send = up ? q4[j] : q4[j + 2], keep = up ? q4[j + 2] : q4[j]; q2[j] = keep + __shfl_xor(send, 4); }
                { const bool up = lane & 8; const float send = up ? q2[0] : q2[1], keep = up ? q2[1] : q2[0]; q1 = keep + __shfl_xor(send, 8); }
                q1 += __shfl_xor(q1, 16); q1 += __shfl_xor(q1, 32);
                if (lane < 16) { const int km = ((lane & 1) << 3) | ((lane & 2) << 1) | ((lane & 4) >> 1) | ((lane & 8) >> 3); const int rr = km >> 3, hh = km & 7; const int mm = m + rr;
                    const float z = q1 + a.in[I_BF][hh]; const float lf = fminf(z, 0.f) - log1pf(__expf(-fabsf(z)));
                    if (mm < MP) a.out[OFF_FP + (size_t)mm * 8 + hh] = lf; else a.out[OFF_FS + (size_t)(mm - MP) * 8 + hh] = lf;
                    lfs[(8 * wave + i + rr) * 8 + hh] = lf; }
            }
            __syncthreads();
            if (!spass && u < MP / 64) { float v = lfs[lane * 8 + wave];
#pragma unroll
                for (int o = 1; o < 64; o <<= 1) { const float t = __shfl_up(v, o); if (lane >= o) v += t; }
                ((float*)(ws + WS_LC))[(size_t)(m0 + lane) * 8 + wave] = v;
                if (lane == 63) ((float*)(ws + WS_SCH))[u * 8 + wave] = v; }
            __syncthreads();
        }
    }
}

struct Epi1 {
    static constexpr bool PERM = true, AFTER_DRAIN = false;
    float* out; unsigned char* ws;
    template <int ACT> static __device__ __forceinline__ u32x4 pack8(const f32x4 a, const f32x4 b) {
        u32x4 w;
        if (ACT == 0) { w.x = pk2(a.x, a.y); w.y = pk2(a.z, a.w); w.z = pk2(b.x, b.y); w.w = pk2(b.z, b.w); }
        else if (ACT == 1) { w.x = pk2(gelu_tanh(a.x), gelu_tanh(a.y)); w.y = pk2(gelu_tanh(a.z), gelu_tanh(a.w)); w.z = pk2(gelu_tanh(b.x), gelu_tanh(b.y)); w.w = pk2(gelu_tanh(b.z), gelu_tanh(b.w)); }
        else { w.x = pk2(sigmoidf_(a.x), sigmoidf_(a.y)); w.y = pk2(sigmoidf_(a.z), sigmoidf_(a.w)); w.z = pk2(sigmoidf_(b.x), sigmoidf_(b.y)); w.w = pk2(sigmoidf_(b.z), sigmoidf_(b.w)); }
        return w;
    }
    __device__ __forceinline__ void elem8(int row, int col, const f32x4 v0, const f32x4 v1, int pn) const {
        const bool samp = row >= MP;
        if (pn < 2) { *(u32x4*)((bf16_t*)(ws + WS_Q) + (size_t)row * 512 + col) = pack8<0>(v0, v1); }
        else if (pn < 6) { const int isv = pn >= 4; const int c = col - (isv ? 1024 : 512);
            *(u32x4*)((bf16_t*)(ws + (isv ? WS_V : WS_K)) + (size_t)row * 512 + c) = pack8<0>(v0, v1);
            float* o = samp ? out + (isv ? OFF_VS : OFF_KS) + (size_t)(row - MP) * 512 + c : out + (isv ? OFF_VP : OFF_KP) + (size_t)row * 512 + c;
            *(f32x4*)o = v0; *(f32x4*)(o + 4) = v1; }
        else if (pn < 8) { const int c = col - 1536;
            *(u32x4*)((bf16_t*)(ws + WS_XR) + (size_t)row * 512 + c) = pack8<0>(v0, v1);
            if (!samp) { const int t = row & (SEQ - 1); if (t >= SEQ - 3) { float* o = out + OFF_CP + (size_t)((row >> 12) * 3 + (t - (SEQ - 3))) * 512 + c; *(f32x4*)o = v0; *(f32x4*)(o + 4) = v1; } }
            else { const int rs = row - MP, t = rs & 31; if (t >= DSEQ - 3) { float* o = out + OFF_CS + (size_t)((rs >> 5) * 3 + (t - (DSEQ - 3))) * 512 + c; *(f32x4*)o = v0; *(f32x4*)(o + 4) = v1; } } }
        else if (pn < 10) { *(u32x4*)((bf16_t*)(ws + WS_GG) + (size_t)row * 512 + (col - 2048)) = pack8<1>(v0, v1); }
        else { const int isr = pn >= 14; *(u32x4*)((bf16_t*)(ws + (isr ? WS_SR : WS_SA)) + (size_t)row * 1024 + (col - (isr ? 3584 : 2560))) = pack8<2>(v0, v1); }
    }
    __device__ __forceinline__ void operator()(const f32x4 (&acc)[2][2][4][2], const pg8::Unit& u, int wr, int wc, int fr, int fq) const {
        const int rbase = u.pm * 256 + wr * 64 + fr; const int cbase = u.pn * 256 + wc * 32 + 8 * fq;
#pragma unroll
        for (int ai = 0; ai < 2; ++ai)
#pragma unroll
            for (int m = 0; m < 4; ++m)
#pragma unroll
                for (int bj = 0; bj < 2; ++bj) elem8(rbase + ai * 128 + m * 16, cbase + bj * 128, acc[ai][bj][m][0], acc[ai][bj][m][1], u.pn);
    }
};
template <int SECOND> struct EpiUp {
    static constexpr bool PERM = true, AFTER_DRAIN = false;
    const bf16_t* gate; bf16_t* mg;
    __device__ __forceinline__ void elem(size_t o, const f32x4 v) const {
        const u32x2 g = *(const u32x2*)(gate + o);
        float r0 = bflo(g.x) * v.x, r1 = bfhi(g.x) * v.y, r2 = bflo(g.y) * v.z, r3 = bfhi(g.y) * v.w;
        if (SECOND) { const u32x2 p = *(const u32x2*)(mg + o); r0 += bflo(p.x); r1 += bfhi(p.x); r2 += bflo(p.y); r3 += bfhi(p.y); }
        u32x2 w; w.x = pk2(r0, r1); w.y = pk2(r2, r3); *(u32x2*)(mg + o) = w;
    }
    __device__ __forceinline__ void elem8(size_t o, const f32x4 v0, const f32x4 v1) const {
        const u32x4 g = *(const u32x4*)(gate + o);
        float r[8] = {bflo(g.x) * v0.x, bfhi(g.x) * v0.y, bflo(g.y) * v0.z, bfhi(g.y) * v0.w, bflo(g.z) * v1.x, bfhi(g.z) * v1.y, bflo(g.w) * v1.z, bfhi(g.w) * v1.w};
        if (SECOND) { const u32x4 p = *(const u32x4*)(mg + o); r[0] += bflo(p.x); r[1] += bfhi(p.x); r[2] += bflo(p.y); r[3] += bfhi(p.y); r[4] += bflo(p.z); r[5] += bfhi(p.z); r[6] += bflo(p.w); r[7] += bfhi(p.w); }
        u32x4 w; w.x = pk2(r[0], r[1]); w.y = pk2(r[2], r[3]); w.z = pk2(r[4], r[5]); w.w = pk2(r[6], r[7]); *(u32x4*)(mg + o) = w;
    }
    __device__ __forceinline__ void operator()(const f32x4 (&acc)[2][2][4][2], const pg8::Unit& u, int wr, int wc, int fr, int fq) const {
        const int rbase = u.pm * 256 + wr * 64 + fr; const int cbase = u.pn * 256 + wc * 32 + 8 * fq;
#pragma unroll
        for (int ai = 0; ai < 2; ++ai)
#pragma unroll
            for (int m = 0; m < 4; ++m)
#pragma unroll
                for (int bj = 0; bj < 2; ++bj) elem8((size_t)(rbase + ai * 128 + m * 16) * 1024 + cbase + bj * 128, acc[ai][bj][m][0], acc[ai][bj][m][1]);
    }
};
struct EpiOut {
    static constexpr bool PERM = true, AFTER_DRAIN = false;
    const bf16_t* xb; bf16_t* u1;
    __device__ __forceinline__ void elem(size_t o, const f32x4 v) const {
        const u32x2 xv = *(const u32x2*)(xb + o);
        u32x2 w; w.x = pk2(bflo(xv.x) * DN_ALPHA + v.x, bfhi(xv.x) * DN_ALPHA + v.y); w.y = pk2(bflo(xv.y) * DN_ALPHA + v.z, bfhi(xv.y) * DN_ALPHA + v.w); *(u32x2*)(u1 + o) = w;
    }
    __device__ __forceinline__ void elem8(size_t o, const f32x4 v0, const f32x4 v1) const {
        const u32x4 xv = *(const u32x4*)(xb + o);
        u32x4 w; w.x = pk2(bflo(xv.x) * DN_ALPHA + v0.x, bfhi(xv.x) * DN_ALPHA + v0.y); w.y = pk2(bflo(xv.y) * DN_ALPHA + v0.z, bfhi(xv.y) * DN_ALPHA + v0.w);
        w.z = pk2(bflo(xv.z) * DN_ALPHA + v1.x, bfhi(xv.z) * DN_ALPHA + v1.y); w.w = pk2(bflo(xv.w) * DN_ALPHA + v1.z, bfhi(xv.w) * DN_ALPHA + v1.w); *(u32x4*)(u1 + o) = w;
    }
    __device__ __forceinline__ void operator()(const f32x4 (&acc)[2][2][4][2], const pg8::Unit& u, int wr, int wc, int fr, int fq) const {
        const int rbase = u.pm * 256 + wr * 64 + fr; const int cbase = u.pn * 256 + wc * 32 + 8 * fq;
#pragma unroll
        for (int ai = 0; ai < 2; ++ai)
#pragma unroll
            for (int m = 0; m < 4; ++m)
#pragma unroll
                for (int bj = 0; bj < 2; ++bj) elem8((size_t)(rbase + ai * 128 + m * 16) * DM + cbase + bj * 128, acc[ai][bj][m][0], acc[ai][bj][m][1]);
    }
};
struct EpiQy {
    static constexpr bool PERM = true, AFTER_DRAIN = false;
    bf16_t* O;
    __device__ __forceinline__ void elem(size_t o, const f32x4 v) const { u32x2 w; w.x = pk2(v.x, v.y); w.y = pk2(v.z, v.w); *(u32x2*)(O + o) = w; }
    __device__ __forceinline__ void operator()(const f32x4 (&acc)[2][2][4][2], const pg8::Unit& u, int wr, int wc, int fr, int fq) const {
        const int row0 = u.pm * 256 + wr * 64 + fr; const int col0 = u.pn * 256 + wc * 32 + 8 * fq;
#pragma unroll
        for (int ai = 0; ai < 2; ++ai)
#pragma unroll
            for (int m = 0; m < 4; ++m) { bf16_t* rowp = O + (size_t)(row0 + ai * 128 + m * 16) * NQ + col0;
#pragma unroll
                for (int bj = 0; bj < 2; ++bj) { const f32x4 v0 = acc[ai][bj][m][0], v1 = acc[ai][bj][m][1];
                    u32x4 w; w.x = pk2(v0[0], v0[1]); w.y = pk2(v0[2], v0[3]); w.z = pk2(v1[0], v1[1]); w.w = pk2(v1[2], v1[3]);
                    *(u32x4*)(rowp + bj * 128) = w; } }
    }
};

template <class Epi>
__device__ __forceinline__ void small_gemm(const bf16_t* A, const bf16_t* Bt, int N, int K, const Epi& E, int lane, int wave) {
    const int gw = blockIdx.x * 8 + wave, NGW = gridDim.x * 8;
    const int r32 = lane & 31, hi = lane >> 5;
    for (int t = wave * (int)gridDim.x + (int)blockIdx.x; t < (MS / 32) * (N / 32); t += NGW) {
        const int tm = t & 15, tn = t >> 4;
        const bf16_t* ap = A + (size_t)(MP + tm * 32 + r32) * K + 8 * hi;
        const bf16_t* bp = Bt + (size_t)(tn * 32 + r32) * K + 8 * hi;
        f32x16 acc = {};
        bf16x8 a0[8], b0[8], a1[8], b1[8];
#pragma unroll
        for (int c = 0; c < 8; ++c) { a0[c] = *(const bf16x8*)(ap + 16 * c); b0[c] = *(const bf16x8*)(bp + 16 * c); }
#pragma unroll 1
        for (int k0 = 0; k0 < K; k0 += 256) {
#pragma unroll
            for (int c = 0; c < 8; ++c) { a1[c] = *(const bf16x8*)(ap + k0 + 128 + 16 * c); b1[c] = *(const bf16x8*)(bp + k0 + 128 + 16 * c); }
#pragma unroll
            for (int c = 0; c < 8; ++c) acc = __builtin_amdgcn_mfma_f32_32x32x16_bf16(b0[c], a0[c], acc, 0, 0, 0);
            if (k0 + 256 < K) {
#pragma unroll
                for (int c = 0; c < 8; ++c) { a0[c] = *(const bf16x8*)(ap + k0 + 256 + 16 * c); b0[c] = *(const bf16x8*)(bp + k0 + 256 + 16 * c); }
            }
#pragma unroll
            for (int c = 0; c < 8; ++c) acc = __builtin_amdgcn_mfma_f32_32x32x16_bf16(b1[c], a1[c], acc, 0, 0, 0);
        }
        const size_t ro = (size_t)(MP + tm * 32 + r32) * N + tn * 32 + 4 * hi;
#pragma unroll
        for (int g = 0; g < 4; ++g) E.elem(ro + 8 * g, (f32x4){acc[4 * g], acc[4 * g + 1], acc[4 * g + 2], acc[4 * g + 3]});
    }
}
#define GAS __attribute__((address_space(1)))
#define XB_TMO      128
#define XB_XCNT(j)  (256  + 64 * (j))
#define XB_XSUB(j)  (1280 + 64 * (j))
#define XB_XGEN(j)  (2304 + 64 * (j))
#define XB_TOP      3328
#define XB_TOPGEN   3392
#define XCD_BAR_WORDS 3456
#define XB_SPIN_CAP (1u << 18)

__device__ __forceinline__ unsigned xb_ld(unsigned* p)              { return __hip_atomic_load(p, __ATOMIC_RELAXED, __HIP_MEMORY_SCOPE_AGENT); }
__device__ __forceinline__ unsigned xb_add(unsigned* p, unsigned v) { return __hip_atomic_fetch_add(p, v, __ATOMIC_RELAXED, __HIP_MEMORY_SCOPE_AGENT); }
__device__ __forceinline__ unsigned xb_xcc_id() { return (unsigned)__builtin_amdgcn_s_getreg((3 << 11) | 20) & 0xFu; }
#define XB_SPIN(cond, bar) do { unsigned _sp = 0; while (cond) { __builtin_amdgcn_s_sleep(1); \
    if ((++_sp & 255u) == 0u) { if (xb_ld(&(bar)[XB_TMO])) break; if (_sp > XB_SPIN_CAP) { atomicAdd(&(bar)[XB_TMO], 1u); break; } } } } while (0)

struct XcdBarrier {
    unsigned* bar; unsigned x;
    volatile LAS unsigned* st;
};

__device__ __forceinline__ XcdBarrier xcd_barrier_post(unsigned* bar, volatile LAS unsigned* st) {
    XcdBarrier b; b.bar = bar; b.x = xb_xcc_id(); b.st = st;
    if (threadIdx.x == 0) (void)xb_add(&bar[XB_XCNT(b.x)], 1u);
    return b;
}
__device__ __forceinline__ void xcd_barrier_complete(unsigned* bar, unsigned x, unsigned& nloc, unsigned& nx) {
    const unsigned G = gridDim.x * gridDim.y * gridDim.z;
    unsigned sum, cnt, mine, sp = 0u;
    for (;;) {
        sum = 0u; cnt = 0u; mine = 0u;
#pragma unroll
        for (unsigned j = 0; j < 16; ++j) { const unsigned c = xb_ld(&bar[XB_XCNT(j)]); sum += c; cnt += (c > 0u) ? 1u : 0u; mine = (j == x) ? c : mine; }
        if (sum == G) break;
        __builtin_amdgcn_s_sleep(1);
        if ((++sp & 255u) == 0u) { if (xb_ld(&bar[XB_TMO])) break; if (sp > XB_SPIN_CAP) { atomicAdd(&bar[XB_TMO], 1u); break; } }
    }
    nloc = mine > 0u ? mine : 1u; nx = cnt > 0u ? cnt : 1u;
}

__device__ __forceinline__ void xcd_barrier(const XcdBarrier& b) {
    asm volatile("s_waitcnt vmcnt(0)" ::: "memory");
    __syncthreads();
    if (threadIdx.x == 0) {
        unsigned* bar = b.bar;
        __builtin_amdgcn_s_waitcnt(0);
        unsigned nloc = b.st[0], nx = b.st[1];
        if (nloc == 0u) { xcd_barrier_complete(bar, b.x, nloc, nx); b.st[0] = nloc; b.st[1] = nx; }
        const unsigned old = xb_add(&bar[XB_XSUB(b.x)], 1u);
        const unsigned gen = old / nloc;
        if (old + 1u == (gen + 1u) * nloc) {
            __builtin_amdgcn_fence(__ATOMIC_RELEASE, "agent");
            asm volatile("s_waitcnt vmcnt(0)" ::: "memory");
            const unsigned og = xb_add(&bar[XB_TOP], 1u);
            const unsigned tg = og / nx;
            if (og + 1u == (tg + 1u) * nx) xb_add(&bar[XB_TOPGEN], 1u);
            else XB_SPIN(xb_ld(&bar[XB_TOPGEN]) == tg, bar);
            __builtin_amdgcn_fence(__ATOMIC_ACQUIRE, "agent");
            xb_add(&bar[XB_XGEN(b.x)], 1u);
            asm volatile("s_waitcnt vmcnt(0)" ::: "memory");
        } else {
            XB_SPIN(xb_ld(&bar[XB_XGEN(b.x)]) == gen, bar);
            __builtin_amdgcn_fence(__ATOMIC_ACQUIRE, "agent");
            asm volatile("s_waitcnt vmcnt(0)" ::: "memory");
        }
    }
    __syncthreads();
}

template <int NK, bool MASKED>
__device__ __forceinline__ void attn_tile(float& lrun, f32x16 (&o)[2], const bf16x8 (&qf)[4], const LAS unsigned char* Kt, const LAS unsigned char* Vt, int vimg_stride,
                                          const LAS float* cb, float fq, int qrel, int lane) {
    const int r32 = lane & 31, hi = lane >> 5;
    f32x16 p[NK];
#pragma unroll
    for (int ks = 0; ks < NK; ++ks) {
        f32x16 acc;
#pragma unroll
        for (int g = 0; g < 4; ++g) { const f32x4 cbv = *(const LAS f32x4*)(cb + 32 * ks + 8 * g + 4 * hi); acc[4 * g] = cbv.x + fq; acc[4 * g + 1] = cbv.y + fq; acc[4 * g + 2] = cbv.z + fq; acc[4 * g + 3] = cbv.w + fq; }
#pragma unroll
        for (int c = 0; c < 4; ++c) { const bf16x8 kf = *(const LAS bf16x8*)(Kt + (32 * ks + r32) * 144 + (16 * c + 8 * hi) * 2); acc = __builtin_amdgcn_mfma_f32_32x32x16_bf16(kf, qf[c], acc, 0, 0, 0); }
        p[ks] = acc;
    }
    float rs = 0.f;
#pragma unroll
    for (int ks = 0; ks < NK; ++ks)
#pragma unroll
        for (int r = 0; r < 16; ++r) { float e = __builtin_amdgcn_exp2f(p[ks][r]); if (MASKED && (32 * ks + crow(r, 0) + 4 * hi > qrel)) e = 0.f; p[ks][r] = e; rs += e; }
    lrun += rs;
    const int li = lane & 15, cg2 = (lane >> 4) & 1;
    const int voff = (4 * hi + (li >> 2)) * 64 + (16 * cg2 + 4 * (li & 3)) * 2;
#pragma unroll
    for (int kc = 0; kc < 2 * NK; ++kc) {
        const int ks = kc >> 1, rb = 8 * (kc & 1);
        u32x4 pw; pw.x = pk2(p[ks][rb + 0], p[ks][rb + 1]); pw.y = pk2(p[ks][rb + 2], p[ks][rb + 3]); pw.z = pk2(p[ks][rb + 4], p[ks][rb + 5]); pw.w = pk2(p[ks][rb + 6], p[ks][rb + 7]);
        const bf16x8 pb = __builtin_bit_cast(bf16x8, pw);
#pragma unroll
        for (int dh = 0; dh < 2; ++dh) {
            const LAS unsigned char* vp = Vt + dh * vimg_stride + (16 * kc) * 64 + voff;
            const v4i16_t lo = __builtin_amdgcn_ds_read_tr16_b64_v4i16((LAS v4i16_t*)vp);
            const v4i16_t hh = __builtin_amdgcn_ds_read_tr16_b64_v4i16((LAS v4i16_t*)(vp + 8 * 64));
            const bf16x8 vf = {lo[0], lo[1], lo[2], lo[3], hh[0], hh[1], hh[2], hh[3]};
            o[dh] = __builtin_amdgcn_mfma_f32_32x32x16_bf16(vf, pb, o[dh], 0, 0, 0);
        }
    }
}

constexpr int AT_KB = 64 * 144, AT_VB = 8192, AT_K0 = 0, AT_V0 = 2 * AT_KB, AT_CB = AT_V0 + 2 * AT_VB, AT_OFF = AT_CB + 512;
__device__ __forceinline__ void attn_prompt_unit(ARGS_T a, LAS unsigned char* lds, int b, int h, int qb, int tid, int lane, int wave) {
    unsigned char* ws = a.ws;
    const bf16_t* Q = (const bf16_t*)(ws + WS_Q); const bf16_t* K = (const bf16_t*)(ws + WS_K); const bf16_t* V = (const bf16_t*)(ws + WS_V); bf16_t* O = (bf16_t*)(ws + WS_Q);
    const float* LC = (const float*)(ws + WS_LC); const float* SCH = (const float*)(ws + WS_SCH);
    const int r32 = lane & 31, hi = lane >> 5;
    const size_t rowb = (size_t)b * SEQ;
    const int q0 = qb * 256 + wave * 32;
    bf16x8 qf[4];
#pragma unroll
    for (int c = 0; c < 4; ++c) { const u32x4 t = *(const u32x4*)(Q + (rowb + q0 + r32) * 512 + h * 64 + 16 * c + 8 * hi); constexpr float SC = 0.125f * LOG2E; u32x4 s;
        s.x = pk2(bflo(t.x) * SC, bfhi(t.x) * SC); s.y = pk2(bflo(t.y) * SC, bfhi(t.y) * SC); s.z = pk2(bflo(t.z) * SC, bfhi(t.z) * SC); s.w = pk2(bflo(t.w) * SC, bfhi(t.w) * SC); qf[c] = __builtin_bit_cast(bf16x8, s); }
    LAS float* offs = (LAS float*)(lds + AT_OFF);
    if (wave == 0) { const float v = SCH[(b * NSEGP + lane) * 8 + h]; float inc = v;
#pragma unroll
        for (int o = 1; o < 64; o <<= 1) { const float t = __shfl_up(inc, o); if (lane >= o) inc += t; }
        offs[lane] = inc - v; }
    __syncthreads();
    const float fq = (offs[(q0 + r32) >> 6] + LC[(rowb + q0 + r32) * 8 + h]) * LOG2E;
    const int NT = (qb + 1) * 4;
    const int skey = tid >> 3, sch = tid & 7;
    const bf16_t* ksrc = K + (rowb + skey) * 512 + h * 64 + sch * 8; const bf16_t* vsrc = V + (rowb + skey) * 512 + h * 64 + sch * 8;
    const int kdst = skey * 144 + sch * 16, vdst = (sch >> 2) * 4096 + skey * 64 + (sch & 3) * 16;
#define AT_LOAD(KR, VR, CR, t) do { KR = *(const u32x4*)(ksrc + (size_t)(t) * 64 * 512); VR = *(const u32x4*)(vsrc + (size_t)(t) * 64 * 512); \
        if (tid < 64) CR = -(offs[(t)] + LC[(rowb + 64 * (t) + tid) * 8 + h]) * LOG2E; } while (0)
#define AT_STORE(KR, VR, CR, bf) do { *(LAS u32x4*)(lds + AT_K0 + (bf) * AT_KB + kdst) = KR; *(LAS u32x4*)(lds + AT_V0 + (bf) * AT_VB + vdst) = VR; if (tid < 64) ((LAS float*)(lds + AT_CB))[(bf) * 64 + tid] = CR; } while (0)
#define AT_BAR() asm volatile("s_waitcnt lgkmcnt(0)\n\ts_barrier" ::: "memory")
#define AT_COMPUTE(t, bf) do { if (64 * (t) + 63 <= q0) attn_tile<2, false>(lrun, o, qf, lds + AT_K0 + (bf) * AT_KB, lds + AT_V0 + (bf) * AT_VB, 4096, (const LAS float*)(lds + AT_CB) + (bf) * 64, fq, 0, lane); \
        else if (64 * (t) <= q0 + 31) attn_tile<2, true>(lrun, o, qf, lds + AT_K0 + (bf) * AT_KB, lds + AT_V0 + (bf) * AT_VB, 4096, (const LAS float*)(lds + AT_CB) + (bf) * 64, fq, q0 + r32 - 64 * (t), lane); } while (0)
    u32x4 kA, vA, kB, vB; float cA = 0.f, cB = 0.f;
    AT_LOAD(kA, vA, cA, 0); AT_LOAD(kB, vB, cB, 1);
    AT_STORE(kA, vA, cA, 0);
    AT_BAR();
    float lrun = 0.f; f32x16 o[2]; o[0] = f32x16{}; o[1] = f32x16{};
    for (int j = 0; j < NT; j += 2) {
        if (j + 2 < NT) AT_LOAD(kA, vA, cA, j + 2);
        AT_COMPUTE(j, 0);
        AT_STORE(kB, vB, cB, 1);
        AT_BAR();
        if (j + 3 < NT) AT_LOAD(kB, vB, cB, j + 3);
        AT_COMPUTE(j + 1, 1);
        if (j + 2 < NT) AT_STORE(kA, vA, cA, 0);
        AT_BAR();
    }
#undef AT_LOAD
#undef AT_STORE
#undef AT_BAR
#undef AT_COMPUTE
    const float lt = lrun + __shfl_xor(lrun, 32); const float inv = 1.f / lt;
    bf16_t* orow = O + (rowb + q0 + r32) * 512 + h * 64;
#pragma unroll
    for (int dh = 0; dh < 2; ++dh)
#pragma unroll
        for (int g = 0; g < 4; ++g) { u32x2 w; w.x = pk2(o[dh][4 * g] * inv, o[dh][4 * g + 1] * inv); w.y = pk2(o[dh][4 * g + 2] * inv, o[dh][4 * g + 3] * inv);
            *(u32x2*)(orow + 32 * dh + 8 * g + 4 * hi) = w; }
}

constexpr int SA_WV = 4608 + 4096, SA_CB = 8 * SA_WV, SA_CMB = 0;
__device__ __forceinline__ void attn_sample_unit(ARGS_T a, LAS unsigned char* lds, int bs, int h, int tid, int lane, int wave) {
    unsigned char* ws = a.ws;
    const bf16_t* Q = (const bf16_t*)(ws + WS_Q); const bf16_t* Kn = (const bf16_t*)(ws + WS_K); const bf16_t* Vn = (const bf16_t*)(ws + WS_V); bf16_t* O = (bf16_t*)(ws + WS_Q);
    const int r32 = lane & 31, hi = lane >> 5;
    const size_t row0 = (size_t)MP + (size_t)bs * DSEQ;
    LAS float* cbs = (LAS float*)(lds + SA_CB);
    if (wave == 0) {
        float v[17]; float s = 0.f;
#pragma unroll
        for (int i = 0; i < 17; ++i) { const int k = lane * 17 + i; float x = 0.f;
            if (k < PAST) x = a.in[I_CLF][((size_t)bs * PAST + k) * 8 + h]; else if (k < PAST + DSEQ) x = a.out[OFF_FS + ((size_t)bs * DSEQ + (k - PAST)) * 8 + h];
            s += x; v[i] = s; }
        float inc = s;
#pragma unroll
        for (int o = 1; o < 64; o <<= 1) { const float t = __shfl_up(inc, o); if (lane >= o) inc += t; }
        const float excl = inc - s;
#pragma unroll
        for (int i = 0; i < 17; ++i) cbs[lane * 17 + i] = -(excl + v[i]) * LOG2E;
    }
    bf16x8 qf[4];
#pragma unroll
    for (int c = 0; c < 4; ++c) { const u32x4 t = *(const u32x4*)(Q + (row0 + r32) * 512 + h * 64 + 16 * c + 8 * hi); constexpr float SC = 0.125f * LOG2E; u32x4 s;
        s.x = pk2(bflo(t.x) * SC, bfhi(t.x) * SC); s.y = pk2(bflo(t.y) * SC, bfhi(t.y) * SC); s.z = pk2(bflo(t.z) * SC, bfhi(t.z) * SC); s.w = pk2(bflo(t.w) * SC, bfhi(t.w) * SC); qf[c] = __builtin_bit_cast(bf16x8, s); }
    __syncthreads();
    const float fq = -cbs[PAST + r32];
    LAS unsigned char* Kw = lds + wave * SA_WV; LAS unsigned char* Vw = Kw + 4608;
    float lrun = 0.f; f32x16 o[2]; o[0] = f32x16{}; o[1] = f32x16{};
    for (int g = wave; g < 33; g += 8) {
        if (g < 32) {
            const float* kc = a.in[I_CK] + (((size_t)bs * PAST + 32 * g) * NH + h) * HD; const float* vc = a.in[I_CV] + (((size_t)bs * PAST + 32 * g) * NH + h) * HD;
#pragma unroll
            for (int i = 0; i < 8; ++i) { const int id = i * 64 + lane, key = id >> 4, part = id & 15;
                const f32x4 kv = *(const f32x4*)(kc + (size_t)key * NH * HD + part * 4), vv = *(const f32x4*)(vc + (size_t)key * NH * HD + part * 4);
                u32x2 kw; kw.x = pk2(kv.x, kv.y); kw.y = pk2(kv.z, kv.w); u32x2 vw; vw.x = pk2(vv.x, vv.y); vw.y = pk2(vv.z, vv.w);
                *(LAS u32x2*)(Kw + key * 144 + part * 8) = kw; *(LAS u32x2*)(Vw + (part >> 3) * 2048 + key * 64 + (part & 7) * 8) = vw; }
        } else {
#pragma unroll
            for (int i = 0; i < 4; ++i) { const int id = i * 64 + lane, key = id >> 3, ch = id & 7;
                const u32x4 kv = *(const u32x4*)(Kn + (row0 + key) * 512 + h * 64 + ch * 8), vv = *(const u32x4*)(Vn + (row0 + key) * 512 + h * 64 + ch * 8);
                *(LAS u32x4*)(Kw + key * 144 + ch * 16) = kv; *(LAS u32x4*)(Vw + (ch >> 2) * 2048 + key * 64 + (ch & 3) * 16) = vv; }
        }
        asm volatile("s_waitcnt lgkmcnt(0)" ::: "memory");
        if (g == 32) attn_tile<1, true>(lrun, o, qf, Kw, Vw, 2048, cbs + 32 * g, fq, r32, lane); else attn_tile<1, false>(lrun, o, qf, Kw, Vw, 2048, cbs + 32 * g, fq, 0, lane);
        asm volatile("s_waitcnt lgkmcnt(0)" ::: "memory");
    }
    __syncthreads();
    LAS float* cm = (LAS float*)(lds + SA_CMB) + wave * 2112;
    const float lt = lrun + __shfl_xor(lrun, 32);
    if (hi == 0) cm[32 + r32] = lt;
#pragma unroll
    for (int dh = 0; dh < 2; ++dh)
#pragma unroll
        for (int r = 0; r < 16; ++r) cm[64 + (32 * dh + crow(r, hi)) * 32 + r32] = o[dh][r];
    __syncthreads();
    {
        const int q = tid & 31, d0 = (tid >> 5) * 4;
        const LAS float* base = (const LAS float*)(lds + SA_CMB);
        float L = 0.f, acc[4] = {0.f, 0.f, 0.f, 0.f};
#pragma unroll
        for (int w = 0; w < 8; ++w) { L += base[w * 2112 + 32 + q];
#pragma unroll
            for (int i = 0; i < 4; ++i) acc[i] += base[w * 2112 + 64 + (d0 + i) * 32 + q]; }
        const float inv = 1.f / L;
        u32x2 w; w.x = pk2(acc[0] * inv, acc[1] * inv); w.y = pk2(acc[2] * inv, acc[3] * inv);
        *(u32x2*)(O + (row0 + q) * 512 + h * 64 + d0) = w;
    }
    __syncthreads();
}

constexpr int RN_XC = 0, RN_XCS = 1040, RN_HIN = 64 * RN_XCS, RN_GG = RN_HIN + 2048;
template <bool FINAL>
__device__ __forceinline__ void rnn_tile(ARGS_T a, LAS unsigned char* lds, int tile, int tid, int lane, int wave) {
    unsigned char* ws = a.ws;
    const bf16_t* XR = (const bf16_t*)(ws + WS_XR); bf16_t* GGRO = (bf16_t*)(ws + WS_GG);
    float* RA = (float*)(ws + WS_RA); float* RB = (float*)(ws + WS_RB);
    const bool samp = tile >= NBATCH * NSEGP;
    const int b = samp ? tile - NBATCH * NSEGP : tile / NSEGP, seg = samp ? 0 : tile % NSEGP;
    const size_t m0 = samp ? (size_t)MP + (size_t)b * DSEQ : (size_t)b * SEQ + (size_t)seg * 64;
    const int nrow = samp ? 32 : 64;
    {
        const int c0 = (tid & 63) * 8, t0 = (tid >> 6) * 8;
        if (t0 < nrow) {
            const int tbase = samp ? 0 : seg * 64;
            u32x4 xr[11];
#pragma unroll
            for (int r = 0; r < 11; ++r) { const int tt = tbase + t0 - 3 + r;
                if (tt >= 0) xr[r] = *(const u32x4*)(XR + (m0 + t0 - 3 + r) * 512 + c0);
                else if (samp) { const float* sc = a.in[I_SCONV] + ((size_t)b * 3 + (3 + tt)) * 512 + c0; const f32x4 s0 = *(const f32x4*)sc, s1 = *(const f32x4*)(sc + 4);
                    xr[r] = (u32x4){pk2(s0.x, s0.y), pk2(s0.z, s0.w), pk2(s1.x, s1.y), pk2(s1.z, s1.w)}; }
                else xr[r] = (u32x4){0u, 0u, 0u, 0u}; }
            u32x4 gg[8];
            if (FINAL) {
#pragma unroll
                for (int r = 0; r < 8; ++r) gg[r] = *(const u32x4*)(GGRO + (m0 + t0 + r) * 512 + c0); }
            float cw[4][8], cbias[8];
#pragma unroll
            for (int w = 0; w < 4; ++w) { const f32x4 w0 = *(const f32x4*)(a.in[I_CONVW] + w * 512 + c0), w1 = *(const f32x4*)(a.in[I_CONVW] + w * 512 + c0 + 4);
                cw[w][0] = w0.x; cw[w][1] = w0.y; cw[w][2] = w0.z; cw[w][3] = w0.w; cw[w][4] = w1.x; cw[w][5] = w1.y; cw[w][6] = w1.z; cw[w][7] = w1.w; }
            { const f32x4 b0 = *(const f32x4*)(a.in[I_CONVB] + c0), b1 = *(const f32x4*)(a.in[I_CONVB] + c0 + 4);
              cbias[0] = b0.x; cbias[1] = b0.y; cbias[2] = b0.z; cbias[3] = b0.w; cbias[4] = b1.x; cbias[5] = b1.y; cbias[6] = b1.z; cbias[7] = b1.w; }
#pragma unroll
            for (int r = 0; r < 8; ++r) {
                float acc[8];
#pragma unroll
                for (int i = 0; i < 8; ++i) acc[i] = cbias[i];
#pragma unroll
                for (int w = 0; w < 4; ++w) { const u32x4 x = xr[r + w];
                    acc[0] += bflo(x.x) * cw[w][0]; acc[1] += bfhi(x.x) * cw[w][1]; acc[2] += bflo(x.y) * cw[w][2]; acc[3] += bfhi(x.y) * cw[w][3];
                    acc[4] += bflo(x.z) * cw[w][4]; acc[5] += bfhi(x.z) * cw[w][5]; acc[6] += bflo(x.w) * cw[w][6]; acc[7] += bfhi(x.w) * cw[w][7]; }
                u32x4 o; o.x = pk2(acc[0], acc[1]); o.y = pk2(acc[2], acc[3]); o.z = pk2(acc[4], acc[5]); o.w = pk2(acc[6], acc[7]);
                *(LAS u32x4*)(lds + RN_XC + (t0 + r) * RN_XCS + c0 * 2) = o;
                if (FINAL) *(LAS u32x4*)(lds + RN_GG + (t0 + r) * RN_XCS + c0 * 2) = gg[r];
            }
        }
    }
    if (FINAL) {
        LAS float* hin = (LAS float*)(lds + RN_HIN);
        float hc;
        if (samp) hc = a.in[I_SRNN][(size_t)b * 512 + tid];
        else { hc = 0.f; const float* pa = RA + (size_t)(b * NSEGP) * 512 + tid; const float* pb = RB + (size_t)(b * NSEGP) * 512 + tid;
#pragma unroll 8
            for (int s = 0; s < seg; ++s) hc = pa[(size_t)s * 512] * hc + pb[(size_t)s * 512]; }
        hin[tid] = hc;
    }
    __syncthreads();
    const int r32 = lane & 31, hi = lane >> 5, n = wave;
    const bf16_t* WAt = (const bf16_t*)(ws + WS_RGA) + n * 4096; const bf16_t* WXt = (const bf16_t*)(ws + WS_RGX) + n * 4096;
    float carry[2], aprod[2];
#pragma unroll 1
    for (int jh = 0; jh < 2; ++jh) {
        const int ch = 64 * n + 32 * jh + r32;
        bf16x8 wa[4], wx[4];
#pragma unroll
        for (int c = 0; c < 4; ++c) { wa[c] = *(const bf16x8*)(WAt + (32 * jh + r32) * 64 + 16 * c + 8 * hi); wx[c] = *(const bf16x8*)(WXt + (32 * jh + r32) * 64 + 16 * c + 8 * hi); }
        const float ba = a.in[I_BRGA][ch], bx = a.in[I_BRGX][ch];
        const float lam = a.in[I_LAM][ch]; const float sp = fmaxf(-lam, 0.f) + log1pf(__expf(-fabsf(lam)));
        float cr = FINAL ? ((const LAS float*)(lds + RN_HIN))[ch] : 0.f; float ap = 1.f;
#pragma unroll 1
        for (int th = 0; th < (samp ? 1 : 2); ++th) {
            f32x16 ya = {}, yx = {};
#pragma unroll
            for (int c = 0; c < 4; ++c) { const bf16x8 af = *(const LAS bf16x8*)(lds + RN_XC + (32 * th + r32) * RN_XCS + (64 * n + 16 * c + 8 * hi) * 2);
                ya = __builtin_amdgcn_mfma_f32_32x32x16_bf16(af, wa[c], ya, 0, 0, 0); yx = __builtin_amdgcn_mfma_f32_32x32x16_bf16(af, wx[c], yx, 0, 0, 0); }
#pragma unroll
            for (int r = 0; r < 16; ++r) {
                const int t = 32 * th + crow(r, hi);
                const float xc = bf1(*(const LAS bf16_t*)(lds + RN_XC + t * RN_XCS + ch * 2));
                const float rg = sigmoidf_(ya[r] + ba), ig = sigmoidf_(yx[r] + bx);
                const float la = -8.f * rg * sp; const float av = __expf(la);
                const float mult = sqrtf(fmaxf(1.f - av * av, 0.f));
                ya[r] = av; yx[r] = mult * ig * xc;
            }
#pragma unroll
            for (int g = 0; g < 4; ++g) {
                float h0 = ya[4 * g] * cr + yx[4 * g], h1 = ya[4 * g + 1] * h0 + yx[4 * g + 1], h2 = ya[4 * g + 2] * h1 + yx[4 * g + 2], h3 = ya[4 * g + 3] * h2 + yx[4 * g + 3];
                const float rv = __shfl_xor(h3, 32);
                const float k0 = ya[4 * g] * rv + yx[4 * g], k1 = ya[4 * g + 1] * k0 + yx[4 * g + 1], k2 = ya[4 * g + 2] * k1 + yx[4 * g + 2], k3 = ya[4 * g + 3] * k2 + yx[4 * g + 3];
                ap *= (ya[4 * g] * ya[4 * g + 1]) * (ya[4 * g + 2] * ya[4 * g + 3]);
                if (hi) { h0 = k0; h1 = k1; h2 = k2; h3 = k3; }
                const float back = __shfl_xor(k3, 32);
                cr = hi ? k3 : back;
                if (FINAL) { yx[4 * g] = h0; yx[4 * g + 1] = h1; yx[4 * g + 2] = h2; yx[4 * g + 3] = h3; }
            }
            if (FINAL) {
#pragma unroll
                for (int r = 0; r < 16; ++r) { const int t = 32 * th + crow(r, hi); LAS bf16_t* p = (LAS bf16_t*)(lds + RN_GG + t * RN_XCS + ch * 2); *p = (bf16_t)(pk2(yx[r] * bf1(*p), 0.f) & 0xffffu); }
            }
        }
        carry[jh] = cr; aprod[jh] = ap;
    }
#pragma unroll
    for (int jh = 0; jh < 2; ++jh) {
        const int ch = 64 * n + 32 * jh + r32;
        if (!FINAL) { const float ap = aprod[jh] * __shfl_xor(aprod[jh], 32); if (hi == 0) { RA[(size_t)tile * 512 + ch] = ap; RB[(size_t)tile * 512 + ch] = carry[jh]; } }
        else if (hi == 0) { if (samp) a.out[OFF_RS + (size_t)b * 512 + ch] = carry[jh]; else if (seg == NSEGP - 1) a.out[OFF_RP + (size_t)b * 512 + ch] = carry[jh]; }
    }
    if (FINAL) {
        __syncthreads();
        const int c0 = (tid & 63) * 8, t0 = (tid >> 6) * 8;
        if (t0 < nrow) {
#pragma unroll
            for (int r = 0; r < 8; ++r) *(u32x4*)(GGRO + (m0 + t0 + r) * 512 + c0) = *(const LAS u32x4*)(lds + RN_GG + (t0 + r) * RN_XCS + c0 * 2);
        }
    }
    __syncthreads();
}

__device__ __forceinline__ void ln1_phase(ARGS_T a, int lane, int wave) {
    const int gw = blockIdx.x * 8 + wave, NGW = gridDim.x * 8;
    const bf16_t* U1 = (const bf16_t*)(a.ws + WS_SA); bf16_t* HB = (bf16_t*)(a.ws + WS_XB);
    f32x4 gv[4], bv[4];
#pragma unroll
    for (int j = 0; j < 4; ++j) { gv[j] = *((const f32x4*)a.in[I_LN1G] + lane + 64 * j); bv[j] = *((const f32x4*)a.in[I_LN1B] + lane + 64 * j); }
    for (int m = gw; m < MT; m += NGW) {
        const u32x2* row = (const u32x2*)(U1 + (size_t)m * DM) + lane;
        f32x4 v[4]; float s = 0.f;
#pragma unroll
        for (int j = 0; j < 4; ++j) { const u32x2 t = row[64 * j]; v[j] = (f32x4){bflo(t.x), bfhi(t.x), bflo(t.y), bfhi(t.y)}; s += (v[j].x + v[j].y) + (v[j].z + v[j].w); }
        const float mean = wave_sum(s) * (1.f / DM); float s2 = 0.f;
#pragma unroll
        for (int j = 0; j < 4; ++j) { v[j] = v[j] - mean; s2 += (v[j].x * v[j].x + v[j].y * v[j].y) + (v[j].z * v[j].z + v[j].w * v[j].w); }
        const float rstd = 1.f / sqrtf(wave_sum(s2) * (1.f / DM) + LN_EPS);
        u32x2* o8 = (u32x2*)(HB + (size_t)m * DM) + lane;
        f32x4* hrow = (f32x4*)(a.out + (size_t)m * DM) + lane;
#pragma unroll
        for (int j = 0; j < 4; ++j) { const f32x4 y = v[j] * rstd * gv[j] + bv[j]; hrow[64 * j] = y; u32x2 w; w.x = pk2(y.x, y.y); w.y = pk2(y.z, y.w); o8[64 * j] = w; }
    }
}

__device__ __forceinline__ unsigned fkey(float f) { const unsigned u = __float_as_uint(f); return (u & 0x80000000u) ? ~u : (u | 0x80000000u); }
__device__ __forceinline__ float funkey(unsigned k) { const unsigned u = (k & 0x80000000u) ? (k & 0x7fffffffu) : ~k; return __uint_as_float(u); }
__device__ __forceinline__ void cex(unsigned& hi_, unsigned& lo_) { const unsigned x = hi_, y = lo_; hi_ = x > y ? x : y; lo_ = x > y ? y : x; }
__device__ __forceinline__ void sort16_desc(unsigned (&v)[16]) {
#pragma unroll
    for (int k = 2; k <= 16; k <<= 1)
#pragma unroll
        for (int j = k >> 1; j > 0; j >>= 1)
#pragma unroll
            for (int i = 0; i < 16; ++i) { const int l = i ^ j; if (l > i) { if ((i & k) == 0) cex(v[i], v[l]); else cex(v[l], v[i]); } }
}
__device__ __forceinline__ void merge16_desc(unsigned (&v)[16]) {
#pragma unroll
    for (int j = 8; j > 0; j >>= 1)
#pragma unroll
        for (int i = 0; i < 16; ++i) { const int l = i ^ j; if (l > i) cex(v[i], v[l]); }
}
__device__ __forceinline__ void top16_of_two(unsigned (&a_)[16], const unsigned (&b_)[16]) {
#pragma unroll
    for (int i = 0; i < 16; ++i) a_[i] = a_[i] > b_[15 - i] ? a_[i] : b_[15 - i];
    merge16_desc(a_);
}
__device__ __forceinline__ void lane_top16(const f32x16 (&acc)[4], int hi, unsigned (&res)[16]) {
    unsigned g[16];
#pragma unroll
    for (int kt = 0; kt < 4; ++kt) {
#pragma unroll
        for (int r = 0; r < 16; ++r) g[r] = (fkey(acc[kt][r]) & ~127u) | (unsigned)(32 * kt + crow(r, 0));
        sort16_desc(g);
        if (kt == 0) {
#pragma unroll
            for (int r = 0; r < 16; ++r) res[r] = g[r];
        } else top16_of_two(res, g);
    }
#pragma unroll
    for (int r = 0; r < 16; ++r) res[r] |= (unsigned)(4 * hi);
}
constexpr int TK_KEYS = 0, TK_KS = 272, TK_LUT = 2 * 128 * TK_KS;
__device__ __forceinline__ void topk_phase(ARGS_T a, LAS unsigned char* lds, int tid, int lane, int wave) {
    unsigned char* ws = a.ws;
    const bf16_t* KEYS = (const bf16_t*)(ws + WS_KEYS); const bf16_t* QY = (const bf16_t*)(ws + WS_Q);
    int* IDX = (int*)(ws + WS_IDX); float* GW = (float*)(ws + WS_G);
    for (int i = tid; i < 2 * 128 * 16; i += 512) { const int row = i >> 4, ch = i & 15; *(LAS u32x4*)(lds + TK_KEYS + row * TK_KS + ch * 16) = *(const u32x4*)(KEYS + (size_t)row * 128 + ch * 8); }
    __syncthreads();
    const int r32 = lane & 31, hi = lane >> 5;
    LAS unsigned* lut = (LAS unsigned*)(lds + TK_LUT) + (wave * 64 + lane) * 33;
    const int gw = blockIdx.x * 8 + wave, NGW = gridDim.x * 8;
    const int NTASK = MT * 8 / 32, NFULL = NTASK / NGW, NLEFT = NTASK - NFULL * NGW, SPREAD = NLEFT > 0 ? NGW / NLEFT : 1;
    const int nmine = NFULL + ((NLEFT > 0 && gw % SPREAD == 0 && gw / SPREAD < NLEFT) ? 1 : 0);
    for (int kk = 0; kk < nmine; ++kk) {
        const int task = kk < NFULL ? gw + kk * NGW : NFULL * NGW + gw / SPREAD;
        const size_t R = (size_t)task * 32 + r32;
        unsigned L[2][16];
#pragma unroll
        for (int p = 0; p < 2; ++p) {
            bf16x8 qf[8];
#pragma unroll
            for (int c = 0; c < 8; ++c) qf[c] = *(const bf16x8*)(QY + R * 256 + p * 128 + 16 * c + 8 * hi);
            f32x16 acc[4];
#pragma unroll
            for (int kt = 0; kt < 4; ++kt) { f32x16 s = {};
#pragma unroll
                for (int c = 0; c < 8; ++c) { const bf16x8 kf = *(const LAS bf16x8*)(lds + TK_KEYS + (p * 128 + 32 * kt + r32) * TK_KS + (16 * c + 8 * hi) * 2); s = __builtin_amdgcn_mfma_f32_32x32x16_bf16(kf, qf[c], s, 0, 0, 0); }
                acc[kt] = s; }
            lane_top16(acc, hi, L[p]);
        }
        unsigned mine[16], recv[16];
#pragma unroll
        for (int i = 0; i < 16; ++i) { const unsigned send = hi ? L[0][i] : L[1][i]; recv[i] = __shfl_xor(send, 32); mine[i] = hi ? L[1][i] : L[0][i]; }
        top16_of_two(mine, recv);
        unsigned P[16], Qk[16];
#pragma unroll
        for (int i = 0; i < 16; ++i) { P[i] = mine[i]; Qk[i] = __shfl_xor(mine[i], 32); }
#pragma unroll
        for (int i = 0; i < 16; ++i) { lut[i] = hi ? Qk[i] : P[i]; lut[16 + i] = hi ? P[i] : Qk[i]; }
        float pv[16], qv[16];
#pragma unroll
        for (int i = 0; i < 16; ++i) { pv[i] = funkey(P[i] & ~127u); qv[i] = funkey(Qk[i] & ~127u); }
        unsigned c0[16], c1[16];
        {
            int cnt = 0;
#pragma unroll
            for (int x = 0; x < 4; ++x)
#pragma unroll
                for (int y = x; y < 16; ++y) {
                    if ((x + 1) * (y + 1) <= 16) {
                        const float s = pv[x] + qv[y];
                        unsigned key = (fkey(s) & ~255u) | (hi ? (unsigned)(y * 16 + x) : (unsigned)(x * 16 + y));
                        if (x == y && hi) key = 0u;
                        if (cnt < 16) c0[cnt] = key; else c1[cnt - 16] = key;
                        ++cnt;
                    }
                }
#pragma unroll
            for (int i = 11; i < 16; ++i) c1[i] = 0u;
        }
        sort16_desc(c0); sort16_desc(c1); top16_of_two(c0, c1);
#pragma unroll
        for (int i = 0; i < 16; ++i) c1[i] = __shfl_xor(c0[i], 32);
        top16_of_two(c0, c1);
        asm volatile("s_waitcnt lgkmcnt(0)" ::: "memory");
        float top[16]; int eidx[16]; float mxv = -INFINITY;
#pragma unroll
        for (int w = 0; w < 16; ++w) { const unsigned pay = c0[w] & 255u; const unsigned k1 = lut[pay >> 4], k2 = lut[16 + (pay & 15u)];
            top[w] = funkey(k1 & ~127u) + funkey(k2 & ~127u); eidx[w] = (int)((k1 & 127u) * 128u + (k2 & 127u)); mxv = fmaxf(mxv, top[w]); }
        float se = 0.f;
#pragma unroll
        for (int w = 0; w < 16; ++w) { top[w] = __expf(top[w] - mxv); se += top[w]; }
        const float inv = 1.f / se;
        if (hi == 0) {
#pragma unroll
            for (int w = 0; w < 16; w += 4) { *(int4*)(IDX + R * 16 + w) = make_int4(eidx[w], eidx[w + 1], eidx[w + 2], eidx[w + 3]);
                *(f32x4*)(GW + R * 16 + w) = (f32x4){top[w] * inv, top[w + 1] * inv, top[w + 2] * inv, top[w + 3] * inv}; }
        }
        asm volatile("s_waitcnt lgkmcnt(0)" ::: "memory");
    }
}

constexpr int GA_PART = 0, GA_RED = 8 * 1024 * 4;
#define FP4PAIR(w, b) __builtin_amdgcn_cvt_scalef32_pk_f32_fp4((w), 1.0f, (b))
__device__ __forceinline__ float dot16_fp4(const u32x2 u, const f32x2 (&x)[8]) {
    f32x2 s = FP4PAIR(u.x, 0) * x[0];
    s += FP4PAIR(u.x, 1) * x[1]; s += FP4PAIR(u.x, 2) * x[2]; s += FP4PAIR(u.x, 3) * x[3];
    s += FP4PAIR(u.y, 0) * x[4]; s += FP4PAIR(u.y, 1) * x[5]; s += FP4PAIR(u.y, 2) * x[6]; s += FP4PAIR(u.y, 3) * x[7];
    return s.x + s.y;
}
__device__ __forceinline__ void fma16_fp4(f32x2 (&acc)[8], const u32x2 v, float w) {
    const f32x2 w2 = {w, w};
    acc[0] += FP4PAIR(v.x, 0) * w2; acc[1] += FP4PAIR(v.x, 1) * w2; acc[2] += FP4PAIR(v.x, 2) * w2; acc[3] += FP4PAIR(v.x, 3) * w2;
    acc[4] += FP4PAIR(v.y, 0) * w2; acc[5] += FP4PAIR(v.y, 1) * w2; acc[6] += FP4PAIR(v.y, 2) * w2; acc[7] += FP4PAIR(v.y, 3) * w2;
}
__device__ __forceinline__ void gather_phase(ARGS_T a, LAS unsigned char* lds, int tid, int lane, int wave) {
    unsigned char* ws = a.ws;
    const unsigned char* UT = ws + WS_UT; const unsigned char* VT = ws + WS_VT;
    const int* IDX = (const int*)(ws + WS_IDX); const float* GW = (const float*)(ws + WS_G);
    const int gw = blockIdx.x * 8 + wave, NGW = gridDim.x * 8;
    const int kmap = ((lane & 1) << 3) | ((lane & 2) << 1) | ((lane & 4) >> 1) | ((lane & 8) >> 3);
    const int NFULL = MT / NGW, NLEFT = MT - NFULL * NGW, G_ = gridDim.x;
    const bool spread = NLEFT > 0 && NLEFT % G_ == 0 && NLEFT / G_ <= 8;
    const int nmine = spread ? NFULL + (wave < NLEFT / G_ ? 1 : 0) : (MT - gw + NGW - 1) / NGW;
    for (int kk = 0; kk < nmine; ++kk) {
        const int tok = (spread && kk == NFULL) ? NFULL * NGW + wave * G_ + (int)blockIdx.x : gw + kk * NGW;
        float* hrow = a.out + (size_t)tok * DM;
        const int idxA = IDX[(size_t)tok * 128 + lane], idxB = IDX[(size_t)tok * 128 + 64 + lane];
        const float gA = GW[(size_t)tok * 128 + lane], gB = GW[(size_t)tok * 128 + 64 + lane];
        f32x2 x[8];
#pragma unroll
        for (int j = 0; j < 4; ++j) { const f32x4 t = *(const f32x4*)(hrow + lane * 16 + 4 * j); x[2 * j] = (f32x2){t.x, t.y}; x[2 * j + 1] = (f32x2){t.z, t.w}; }
        f32x2 oa[8];
#pragma unroll
        for (int i = 0; i < 8; ++i) oa[i] = (f32x2){0.f, 0.f};
        u32x2 ur[16];
#pragma unroll
        for (int k = 0; k < 16; ++k) { const int e = __builtin_amdgcn_readlane(idxA, k); ur[k] = *(const u32x2*)(UT + (size_t)e * 512 + lane * 8); }
#pragma unroll
        for (int hd = 0; hd < 8; ++hd) {
            float pd[16];
#pragma unroll
            for (int k = 0; k < 16; ++k) pd[k] = dot16_fp4(ur[k], x);
            u32x2 vr[16];
#pragma unroll
            for (int k = 0; k < 16; ++k) { const int e = __builtin_amdgcn_readlane(hd < 4 ? idxA : idxB, (hd & 3) * 16 + k); vr[k] = *(const u32x2*)(VT + (size_t)e * 512 + lane * 8); }
            if (hd < 7) {
#pragma unroll
                for (int k = 0; k < 16; ++k) { const int e = __builtin_amdgcn_readlane(hd + 1 < 4 ? idxA : idxB, ((hd + 1) & 3) * 16 + k); ur[k] = *(const u32x2*)(UT + (size_t)e * 512 + lane * 8); }
            }
            float q8[8], q4[4], q2[2], q1;
#pragma unroll
            for (int i = 0; i < 8; ++i) { const bool up = lane & 1; const float send = up ? pd[i] : pd[i + 8], keep = up ? pd[i + 8] : pd[i]; q8[i] = keep + __shfl_xor(send, 1); }
#pragma unroll
            for (int i = 0; i < 4; ++i) { const bool up = lane & 2; const float send = up ? q8[i] : q8[i + 4], keep = up ? q8[i + 4] : q8[i]; q4[i] = keep + __shfl_xor(send, 2); }
#pragma unroll
            for (int i = 0; i < 2; ++i) { const bool up = lane & 4; const float send = up ? q4[i] : q4[i + 2], keep = up ? q4[i + 2] : q4[i]; q2[i] = keep + __shfl_xor(send, 4); }
            { const bool up = lane & 8; const float send = up ? q2[0] : q2[1], keep = up ? q2[1] : q2[0]; q1 = keep + __shfl_xor(send, 8); }
            q1 += __shfl_xor(q1, 16); q1 += __shfl_xor(q1, 32);
            const float gk = __shfl(hd < 4 ? gA : gB, (hd & 3) * 16 + kmap);
            const float wgt = gk * gelu_tanh(q1 * (1.f / U4_SCALE)) * (1.f / V4_SCALE);
#pragma unroll
            for (int k = 0; k < 16; ++k) {
                const int src = ((k & 1) << 3) | ((k & 2) << 1) | ((k & 4) >> 1) | ((k & 8) >> 3);
                const float wk = __uint_as_float(__builtin_amdgcn_readlane(__float_as_uint(wgt), src));
                fma16_fp4(oa, vr[k], wk); }
        }
        float v[16]; float s = 0.f;
#pragma unroll
        for (int j = 0; j < 8; ++j) { v[2 * j] = DN_ALPHA * x[j].x + oa[j].x; v[2 * j + 1] = DN_ALPHA * x[j].y + oa[j].y; s += v[2 * j] + v[2 * j + 1]; }
        const float mean = wave_sum(s) * (1.f / DM); float s2 = 0.f;
#pragma unroll
        for (int j = 0; j < 16; ++j) { v[j] -= mean; s2 += v[j] * v[j]; }
        const float rstd = 1.f / sqrtf(wave_sum(s2) * (1.f / DM) + LN_EPS);
#pragma unroll
        for (int j = 0; j < 4; ++j) { const f32x4 g = *(const f32x4*)(a.in[I_LN2G] + lane * 16 + 4 * j), b = *(const f32x4*)(a.in[I_LN2B] + lane * 16 + 4 * j);
            *(f32x4*)(hrow + lane * 16 + 4 * j) = (f32x4){v[4 * j] * rstd * g.x + b.x, v[4 * j + 1] * rstd * g.y + b.y, v[4 * j + 2] * rstd * g.z + b.z, v[4 * j + 3] * rstd * g.w + b.w}; }
    }
}

constexpr int NPH = 10;
__global__ void __launch_bounds__(512, 2) fox_peer_fwd(Args a_unused) {
    extern __shared__ __attribute__((aligned(16))) unsigned char lds_raw[];
    LAS unsigned char* lds = (LAS unsigned char*)lds_raw;
    cg::grid_group grid = cg::this_grid();
    const int tid = threadIdx.x, lane = tid & 63, wave = __builtin_amdgcn_readfirstlane(tid >> 6);
    const int G = gridDim.x;
    typedef const __attribute__((address_space(4))) Args CArgs;
    CArgs* ap0 = (CArgs*)__builtin_amdgcn_kernarg_segment_ptr();
    unsigned char* ws = ap0->ws;
    const int lo = ap0->ph_lo, hi_ = ap0->ph_hi;
#define a (*apx)
#define PHASE_ARGS() CArgs* apx = ap0; asm volatile("" : "+s"(apx))
    volatile LAS unsigned* xst = (volatile LAS unsigned*)(lds + LDS_BYTES - 16);
    if (tid < 2) xst[tid] = 0u;
    __syncthreads();
    XcdBarrier xbar = xcd_barrier_post((unsigned*)(ws + WS_CTL), xst);
#ifndef PHMASK
#define PHMASK 0x3ff
#endif
#define IN(k) (((PHMASK >> (k)) & 1) && lo <= (k) && (k) < hi_)
#define FRESH() int tid_ = tid, lane_ = lane; asm volatile("" : "+v"(tid_), "+v"(lane_))
#define SEAM(k) do { if (IN(k) && IN((k) + 1)) { if ((k) == 0) grid.sync(); else xcd_barrier(xbar); } } while (0)

#ifdef PROBE_PH
    unsigned long long pt0 = 0, pt1 = 0;
#define PSTAMP(k) do { if ((k) == PROBE_PH) pt0 = __builtin_amdgcn_s_memrealtime(); if ((k) == PROBE_PH + 1) pt1 = __builtin_amdgcn_s_memrealtime(); } while (0)
#else
#define PSTAMP(k) do { } while (0)
#endif
    PSTAMP(0);
    if (IN(0)) { PHASE_ARGS(); FRESH(); p0_prologue<0>(a, lds, tid_, lane_, wave, (int)blockIdx.x, G); }
    SEAM(0); PSTAMP(1);
    if (IN(1)) { PHASE_ARGS();
        pg8::Gemm g{(const bf16_t*)(ws + WS_XB), (const bf16_t*)(ws + WS_WIN), MT, NIN, DM}; pg8::StaticOrder S; S.init(MT, NIN, G, (int)blockIdx.x);
        Epi1 E{a.out, ws};
        pg8::gemm_phase<Epi1, pg8::StaticOrder, true, true>(lds, g, S, E);
        { const int extra = ((MT / 256) * (NIN / 256)) % G; FRESH();
          if (extra > 0) { if ((int)blockIdx.x >= extra) p0_prologue<1>(a, lds, tid_, lane_, wave, (int)blockIdx.x - extra, G - extra); }
          else p0_prologue<1>(a, lds, tid_, lane_, wave, (int)blockIdx.x, G); }
    }
    SEAM(1); PSTAMP(2);
    if (IN(2)) { PHASE_ARGS();
#ifdef PROBE_PH
        if (PROBE_PH == 20) pt0 = __builtin_amdgcn_s_memrealtime();
#endif
        if (G == 2 * DBATCH * NH && NBATCH * NSEGP == 4 * DBATCH * NH) {
            if ((int)blockIdx.x < DBATCH * NH) rnn_tile<false>(a, lds, (int)blockIdx.x, tid, lane, wave);
            else for (int i = 0; i < 3; ++i) rnn_tile<false>(a, lds, DBATCH * NH + 3 * ((int)blockIdx.x - DBATCH * NH) + i, tid, lane, wave);
        } else
        for (int t = blockIdx.x; t < NBATCH * NSEGP; t += G) rnn_tile<false>(a, lds, t, tid, lane, wave);
#ifdef PROBE_PH
        if (PROBE_PH == 20) pt1 = __builtin_amdgcn_s_memrealtime();
        if (PROBE_PH == 21) pt0 = __builtin_amdgcn_s_memrealtime();
#endif
        for (int u = blockIdx.x; u < DBATCH * NH; u += G) attn_sample_unit(a, lds, u >> 3, u & 7, tid, lane, wave);
#ifdef PROBE_PH
        if (PROBE_PH == 21) pt1 = __builtin_amdgcn_s_memrealtime();
        if (PROBE_PH == 22) pt0 = __builtin_amdgcn_s_memrealtime();
#endif
        for (int v = blockIdx.x; v < 256; v += G) {
            const int bh = v >> 2, s = v & 3;
#pragma unroll 1
            for (int i = 0; i < 4; ++i) { const int qb = (i == 0) ? s : (i == 1) ? 7 - s : (i == 2) ? 8 + s : 15 - s; attn_prompt_unit(a, lds, bh >> 3, bh & 7, qb, tid, lane, wave); __syncthreads(); }
        }
    }
#ifdef PROBE_PH
    if (PROBE_PH == 22) pt1 = __builtin_amdgcn_s_memrealtime();
#endif
    SEAM(2); PSTAMP(3);
    if (IN(3)) { PHASE_ARGS(); FRESH(); for (int t = blockIdx.x; t < NBATCH * NSEGP + DBATCH; t += G) rnn_tile<true>(a, lds, t, tid_, lane_, wave); }
    SEAM(3); PSTAMP(4);
    if (IN(4)) { PHASE_ARGS();
        { pg8::Gemm g{(const bf16_t*)(ws + WS_Q), (const bf16_t*)(ws + WS_WA), MP, DM, DA}; pg8::StaticOrder S; S.init(MP, DM, G, (int)blockIdx.x);
          EpiUp<0> E{(const bf16_t*)(ws + WS_SA), (bf16_t*)(ws + WS_K)}; pg8::gemm_phase<EpiUp<0>, pg8::StaticOrder, true, true>(lds, g, S, E);
          small_gemm<EpiUp<0>>((const bf16_t*)(ws + WS_Q), (const bf16_t*)(ws + WS_WA), DM, DA, E, lane, wave); }
        { pg8::Gemm g{(const bf16_t*)(ws + WS_GG), (const bf16_t*)(ws + WS_WR), MP, DM, DR}; pg8::StaticOrder S; S.init(MP, DM, G, (int)blockIdx.x);
          EpiUp<1> E{(const bf16_t*)(ws + WS_SR), (bf16_t*)(ws + WS_K)}; pg8::gemm_phase<EpiUp<1>, pg8::StaticOrder, true, true>(lds, g, S, E);
          small_gemm<EpiUp<1>>((const bf16_t*)(ws + WS_GG), (const bf16_t*)(ws + WS_WR), DM, DR, E, lane, wave); }
    }
    SEAM(4); PSTAMP(5);
    if (IN(5)) { PHASE_ARGS();
        pg8::Gemm g{(const bf16_t*)(ws + WS_K), (const bf16_t*)(ws + WS_WO), MP, DM, DM}; pg8::StaticOrder S; S.init(MP, DM, G, (int)blockIdx.x);
        EpiOut E{(const bf16_t*)(ws + WS_XB), (bf16_t*)(ws + WS_SA)}; pg8::gemm_phase<EpiOut, pg8::StaticOrder, true, true>(lds, g, S, E);
        small_gemm<EpiOut>((const bf16_t*)(ws + WS_K), (const bf16_t*)(ws + WS_WO), DM, DM, E, lane, wave);
    }
    SEAM(5); PSTAMP(6);
    if (IN(6)) { PHASE_ARGS(); FRESH(); ln1_phase(a, lane_, wave); }
    SEAM(6); PSTAMP(7);
    if (IN(7)) { PHASE_ARGS();
        pg8::Gemm g{(const bf16_t*)(ws + WS_XB), (const bf16_t*)(ws + WS_WQ), MP, NQ, DM}; pg8::StaticOrder S; S.init(MP, NQ, G, (int)blockIdx.x);
        EpiQy E{(bf16_t*)(ws + WS_Q)}; pg8::gemm_phase<EpiQy, pg8::StaticOrder, true, true>(lds, g, S, E);
        small_gemm<EpiQy>((const bf16_t*)(ws + WS_XB), (const bf16_t*)(ws + WS_WQ), NQ, DM, E, lane, wave);
    }
    SEAM(7); PSTAMP(8);
    if (IN(8)) { PHASE_ARGS(); FRESH(); topk_phase(a, lds, tid_, lane_, wave); }
    SEAM(8); PSTAMP(9);
    if (IN(9)) { PHASE_ARGS(); FRESH(); gather_phase(a, lds, tid_, lane_, wave); }
#ifdef PROBE_PH
    if (PROBE_PH == 9) pt1 = __builtin_amdgcn_s_memrealtime();
#ifndef PROBE_BLK
#define PROBE_BLK 0
#endif
    if (blockIdx.x == PROBE_BLK && tid == 0) { const unsigned long long te = __builtin_amdgcn_s_memrealtime(), want = 2ull * (pt1 - pt0); while (__builtin_amdgcn_s_memrealtime() - te < want) __builtin_amdgcn_s_sleep(16); }
#endif
#undef a
#undef IN
#undef SEAM
}

#ifndef N_LAUNCHES
#define N_LAUNCHES 1
#endif
extern "C" void kernel_launch(void* const* d_in, const int* in_sizes, int n_in, void* d_out, int out_size, void* d_ws, size_t ws_size, hipStream_t stream) {
    static int grid = 0;
    if (grid == 0) {
        if (n_in != 28 || (size_t)out_size != OUT_TOTAL || ws_size < WS_END) { fprintf(stderr, "kernel_launch: unexpected problem: n_in %d out %d ws %zu\n", n_in, out_size, ws_size); grid = -1; return; }
        int dev = 0, cus = 0, per_cu = 0;
        hipGetDevice(&dev); hipDeviceGetAttribute(&cus, hipDeviceAttributeMultiprocessorCount, dev);
        if (hipFuncSetAttribute((const void*)fox_peer_fwd, hipFuncAttributeMaxDynamicSharedMemorySize, LDS_BYTES) != hipSuccess) { fprintf(stderr, "kernel_launch: hipFuncSetAttribute failed\n"); grid = -1; return; }
        if (hipOccupancyMaxActiveBlocksPerMultiprocessor(&per_cu, (const void*)fox_peer_fwd, 512, LDS_BYTES) != hipSuccess || per_cu < 1) { fprintf(stderr, "kernel_launch: occupancy query gave %d\n", per_cu); per_cu = 1; }
        (void)hipGetLastError();
        grid = cus * (per_cu < 1 ? 1 : per_cu);
    }
    if (grid < 0) return;
    if (hipMemsetAsync((char*)d_ws + WS_CTL, 0, 16384, stream) != hipSuccess) { fprintf(stderr, "kernel_launch: memset failed\n"); return; }
    Args a{};
    for (int i = 0; i < 28; ++i) a.in[i] = (const float*)d_in[i];
    a.out = (float*)d_out; a.ws = (unsigned char*)d_ws;
#if N_LAUNCHES == 1
    a.ph_lo = 0; a.ph_hi = NPH;
    void* args[] = {&a};
    hipError_t e = hipLaunchCooperativeKernel((const void*)fox_peer_fwd, dim3(grid), dim3(512), args, LDS_BYTES, stream);
    if (e != hipSuccess) fprintf(stderr, "cooperative launch failed: %s (grid %d)\n", hipGetErrorString(e), grid);
#else
    for (int p = 0; p < NPH; ++p) { a.ph_lo = p; a.ph_hi = p + 1; hipLaunchKernelGGL(fox_peer_fwd, dim3(grid), dim3(512), LDS_BYTES, stream, a); }
#endif
}
```
